# Optimizing an MI355X kernel written in HIP

```python
import math
import jax, jax.numpy as jnp
from jax import lax
import numpy as np

D_MODEL = 2048
BATCH = 2
SEQ = 8192
DEPTH = 2
DEC_BATCH = 16
DEC_SEQ = 64
PAST_LEN = 2048

CHUNK = 64
Q_BLOCK = 128
EPS = 1e-6

H_A = 4
DK_A = 128
DV_A = 128
H_B = 4
DK_B = 64
DV_B = 128
RET_THETA_BASE = 10000.0
H_C = 4
DH_C = 128
DV_C = 256
D_FF = 4 * D_MODEL

W_A = H_A * DV_A
W_B = H_B * DV_B
W_C = H_C * DV_C
MIX_WIDTH = W_A + W_B + W_C

IN_SIZES = (H_A * DK_A, H_A * DK_A, H_A * DV_A, H_A * DV_A,
            H_B * DK_B, H_B * DK_B, H_B * DV_B, H_B * DV_B,
            H_C * 2 * DH_C, H_C * 2 * DH_C, H_C * DV_C)
IN_WIDTH = sum(IN_SIZES)

kernel_name = "hybrid_hgrn2_retnet_diffattn_stream_step"

F32 = jnp.float32


def rms_unit(x):
    xf = x.astype(F32)
    return xf * lax.rsqrt(jnp.mean(xf * xf, axis=-1, keepdims=True) + EPS)


def rmsnorm(x, g):
    return (rms_unit(x) * g.astype(F32)).astype(x.dtype)


def split_projection(p):
    points = [int(v) for v in np.cumsum(IN_SIZES)[:-1]]
    return jnp.split(p, points, axis=-1)


def to_chunks(t, chunk):
    b, l, h, d = t.shape
    return jnp.moveaxis(t.reshape(b, l // chunk, chunk, h, d), 1, 0)


def from_chunks(t):
    n, b, c, h, d = t.shape
    return jnp.moveaxis(t, 0, 1).reshape(b, n * c, h, d)


def gla_chunked(q, k, v, logf, s0, chunk):
    causal = jnp.tril(jnp.ones((chunk, chunk), bool))

    def step(s, inp):
        qi, ki, vi, gi = inp
        bcum = jnp.cumsum(gi, axis=1)
        diff = bcum[:, :, None] - bcum[:, None, :]
        decay = jnp.exp(jnp.where(causal[None, :, :, None, None], diff, -jnp.inf))
        scores = jnp.einsum('bthk,btshk,bshk->bhts', qi, decay, ki)
        o_intra = jnp.einsum('bhts,bshv->bthv', scores, vi)
        o_inter = jnp.einsum('bthk,bhkv->bthv', qi * jnp.exp(bcum), s)
        btot = bcum[:, -1]
        kdec = ki * jnp.exp(btot[:, None] - bcum)
        s_new = jnp.exp(btot)[..., None] * s + jnp.einsum('bshk,bshv->bhkv', kdec, vi)
        return s_new, o_intra + o_inter

    xs = tuple(to_chunks(t.astype(F32), chunk) for t in (q, k, v, logf))
    s_fin, o = lax.scan(step, s0.astype(F32), xs)
    return from_chunks(o), s_fin


def retention_chunked(q, k, v, log_gamma, s0, chunk):
    idx = jnp.arange(chunk, dtype=F32)
    rel = idx[:, None] - idx[None, :]
    dmat = jnp.where(rel[None] >= 0,
                     jnp.exp(jnp.maximum(rel, 0.0)[None] * log_gamma[:, None, None]), 0.0)
    inner = jnp.exp((idx + 1.0)[None, :] * log_gamma[:, None]).T[None, :, :, None]
    tail = jnp.exp((chunk - 1.0 - idx)[None, :] * log_gamma[:, None])
    full = jnp.exp(chunk * log_gamma)[None, :, None, None]

    def step(s, inp):
        qi, ki, vi = inp
        scores = jnp.einsum('bthk,bshk->bhts', qi, ki) * dmat[None]
        o_intra = jnp.einsum('bhts,bshv->bthv', scores, vi)
        o_inter = jnp.einsum('bthk,bhkv->bthv', qi, s) * inner
        s_new = full * s + jnp.einsum('bshk,hs,bshv->bhkv', ki, tail, vi)
        return s_new, o_intra + o_inter

    xs = tuple(to_chunks(t.astype(F32), chunk) for t in (q, k, v))
    s_fin, o = lax.scan(step, s0.astype(F32), xs)
    return from_chunks(o), s_fin


def rotate(x, pos):
    half = x.shape[-1] // 2
    inv = 1.0 / (RET_THETA_BASE ** jnp.linspace(0.0, 1.0, half, dtype=F32))
    ang = pos[:, None] * inv[None]
    cos = jnp.cos(ang)[None, :, None]
    sin = jnp.sin(ang)[None, :, None]
    x1, x2 = x[..., :half], x[..., half:]
    return jnp.concatenate([x1 * cos - x2 * sin, x1 * sin + x2 * cos], axis=-1)


def diff_attention_core(q, k, v, lam, mask):
    logits = jnp.einsum('bqhcd,bkhcd->bhcqk', q, k).astype(F32) * (DH_C ** -0.5)
    if mask is not None:
        logits = jnp.where(mask, logits, -jnp.inf)
    p = jax.nn.softmax(logits, axis=-1)
    w = p[:, :, 0] - lam * p[:, :, 1]
    return jnp.einsum('bhqk,bkhv->bqhv', w, v.astype(F32))


def diff_attention_prompt(q, k, v, lam):
    b, s = q.shape[0], q.shape[1]
    nblk = s // Q_BLOCK
    kchunk = jnp.arange(s) // CHUNK
    qb = jnp.moveaxis(q.reshape(b, nblk, Q_BLOCK, H_C, 2, DH_C), 1, 0)

    def block(args):
        qi, bi = args
        qchunk = (bi * Q_BLOCK + jnp.arange(Q_BLOCK)) // CHUNK
        mask = kchunk[None, :] <= qchunk[:, None]
        return diff_attention_core(qi, k, v, lam, mask)

    o = lax.map(block, (qb, jnp.arange(nblk)))
    return jnp.moveaxis(o, 0, 1).reshape(b, s, H_C, DV_C)


def trunk_layer(x, pos, s_a, s_b, past_k, past_v, chunk, first_layer, lb, lam, lam_init,
                w_in, w_out, w_up, w_down, g_pre_mix, g_post_mix, g_pre_mlp, g_post_mlp,
                g_hgrn_out, g_diff_out):
    b, L, _ = x.shape
    h = rmsnorm(x, g_pre_mix)
    proj = jnp.einsum('bld,de->ble', h, w_in)
    a_q, a_f, a_i, a_g, b_q, b_k, b_v, b_g, c_q, c_k, c_v = split_projection(proj)

    def heads(t, d):
        return t.astype(F32).reshape(b, L, -1, d)

    a_z = a_f.astype(F32)
    if first_layer:
        a_logf = jax.nn.log_sigmoid(a_z)
    else:
        a_logf = jnp.log(lb + (1.0 - lb) * jax.nn.sigmoid(a_z))
    a_key = -jnp.expm1(a_logf)
    a_qs = jax.nn.silu(a_q.astype(F32)) * (DK_A ** -0.5)
    o_a, s_a_new = gla_chunked(heads(a_qs, DK_A), heads(a_key, DK_A), heads(a_i, DV_A),
                               heads(a_logf, DK_A), s_a, chunk)
    o_a = rms_unit(o_a) * g_hgrn_out.astype(F32) * jax.nn.silu(heads(a_g, DV_A))

    log_gamma = jnp.log1p(-jnp.power(2.0, -5.0 - jnp.arange(H_B, dtype=F32)))
    bq = rotate(heads(b_q, DK_B), pos)
    bk = rotate(heads(b_k, DK_B), pos) * (DK_B ** -0.5)
    o_b, s_b_new = retention_chunked(bq, bk, heads(b_v, DV_B), log_gamma, s_b, chunk)
    o_b = rms_unit(o_b) * jax.nn.silu(heads(b_g, DV_B))

    cq = c_q.reshape(b, L, H_C, 2, DH_C)
    ck = c_k.reshape(b, L, H_C, 2, DH_C)
    cv = c_v.reshape(b, L, H_C, DV_C)
    if past_k is None:
        o_c = diff_attention_prompt(cq, ck, cv, lam)
    else:
        keys = jnp.concatenate([past_k.reshape(b, -1, H_C, 2, DH_C).astype(ck.dtype), ck], axis=1)
        vals = jnp.concatenate([past_v.astype(cv.dtype), cv], axis=1)
        o_c = diff_attention_core(cq, keys, vals, lam, None)
    o_c = rms_unit(o_c) * g_diff_out.astype(F32) * (1.0 - lam_init)

    mix = jnp.concatenate([o_a.reshape(b, L, W_A), o_b.reshape(b, L, W_B),
                           o_c.reshape(b, L, W_C)], axis=-1).astype(x.dtype)
    x = x + rmsnorm(jnp.einsum('ble,ed->bld', mix, w_out), g_post_mix)

    hm = rmsnorm(x, g_pre_mlp)
    u = jnp.square(jax.nn.relu(jnp.einsum('bld,df->blf', hm, w_up)))
    x = x + rmsnorm(jnp.einsum('blf,fd->bld', u, w_down), g_post_mlp)
    return x, s_a_new, s_b_new, ck.reshape(b, L, H_C, 2 * DH_C), cv


def setup_inputs(seed: int = 0) -> dict:
    key = jax.random.key(seed)
    ks = jax.random.split(key, 24)

    def nrm(k, shape, scale):
        return jax.random.normal(k, shape, F32) * scale

    def gain(k, shape):
        return 1.0 + 0.05 * jax.random.normal(k, shape, F32)

    return {
        "x_prompt": nrm(ks[0], (BATCH, SEQ, D_MODEL), 1.0),
        "x_sample": nrm(ks[1], (DEC_BATCH, DEC_SEQ, D_MODEL), 1.0),
        "state_hgrn": nrm(ks[2], (DEPTH, DEC_BATCH, H_A, DK_A, DV_A), 0.5),
        "state_ret": nrm(ks[3], (DEPTH, DEC_BATCH, H_B, DK_B, DV_B), 0.5),
        "cache_k": nrm(ks[4], (DEPTH, DEC_BATCH, PAST_LEN, H_C, 2 * DH_C), 1.0),
        "cache_v": nrm(ks[5], (DEPTH, DEC_BATCH, PAST_LEN, H_C, DV_C), 1.0),
        "w_in": nrm(ks[6], (DEPTH, D_MODEL, IN_WIDTH), D_MODEL ** -0.5),
        "w_out": nrm(ks[7], (DEPTH, MIX_WIDTH, D_MODEL), MIX_WIDTH ** -0.5),
        "w_up": nrm(ks[8], (DEPTH, D_MODEL, D_FF), D_MODEL ** -0.5),
        "w_down": nrm(ks[9], (DEPTH, D_FF, D_MODEL), D_FF ** -0.5),
        "g_pre_mix": gain(ks[10], (DEPTH, D_MODEL)),
        "g_post_mix": gain(ks[11], (DEPTH, D_MODEL)),
        "g_pre_mlp": gain(ks[12], (DEPTH, D_MODEL)),
        "g_post_mlp": gain(ks[13], (DEPTH, D_MODEL)),
        "hgrn_lb_logits": nrm(ks[14], (DEPTH, H_A * DK_A), 0.5),
        "g_hgrn_out": gain(ks[15], (DEPTH, DV_A)),
        "lambda_q1": nrm(ks[16], (DEPTH, DH_C), 0.1),
        "lambda_k1": nrm(ks[17], (DEPTH, DH_C), 0.1),
        "lambda_q2": nrm(ks[18], (DEPTH, DH_C), 0.1),
        "lambda_k2": nrm(ks[19], (DEPTH, DH_C), 0.1),
        "g_diff_out": gain(ks[20], (DEPTH, DV_C)),
    }


def reference(x_prompt, x_sample, state_hgrn, state_ret, cache_k, cache_v,
              w_in, w_out, w_up, w_down, g_pre_mix, g_post_mix, g_pre_mlp, g_post_mlp,
              hgrn_lb_logits, g_hgrn_out, lambda_q1, lambda_k1, lambda_q2, lambda_k2, g_diff_out):
    b_p, seq_p = x_prompt.shape[0], x_prompt.shape[1]
    n_new = x_sample.shape[1]
    past_len = cache_k.shape[2]
    pos_p = jnp.arange(seq_p, dtype=F32)
    pos_s = past_len + jnp.arange(n_new, dtype=F32)

    lb_soft = jax.nn.softmax(hgrn_lb_logits.astype(F32), axis=0)
    lower_bounds = jnp.cumsum(lb_soft, axis=0) - lb_soft[0]

    s_a0 = jnp.zeros((b_p, H_A, DK_A, DV_A), F32)
    s_b0 = jnp.zeros((b_p, H_B, DK_B, DV_B), F32)

    hp, hs = x_prompt, x_sample
    sa_p, sa_s, sb_p, sb_s, k_p, k_s, v_p, v_s = [], [], [], [], [], [], [], []
    for l in range(DEPTH):
        lam_init = 0.8 - 0.6 * math.exp(-0.3 * l)
        lam = (jnp.exp(jnp.sum(lambda_q1[l].astype(F32) * lambda_k1[l].astype(F32)))
               - jnp.exp(jnp.sum(lambda_q2[l].astype(F32) * lambda_k2[l].astype(F32))) + lam_init)
        hp, a1, b1, kr1, vr1 = trunk_layer(
            hp, pos_p, s_a0, s_b0, None, None, CHUNK, l == 0, lower_bounds[l], lam, lam_init,
            w_in[l], w_out[l], w_up[l], w_down[l], g_pre_mix[l], g_post_mix[l], g_pre_mlp[l],
            g_post_mlp[l], g_hgrn_out[l], g_diff_out[l])
        hs, a2, b2, kr2, vr2 = trunk_layer(
            hs, pos_s, state_hgrn[l], state_ret[l], cache_k[l], cache_v[l], n_new, l == 0,
            lower_bounds[l], lam, lam_init,
            w_in[l], w_out[l], w_up[l], w_down[l], g_pre_mix[l], g_post_mix[l], g_pre_mlp[l],
            g_post_mlp[l], g_hgrn_out[l], g_diff_out[l])
        sa_p.append(a1); sb_p.append(b1); k_p.append(kr1); v_p.append(vr1)
        sa_s.append(a2); sb_s.append(b2); k_s.append(kr2); v_s.append(vr2)

    return (hp, hs, jnp.stack(sa_p), jnp.stack(sa_s), jnp.stack(sb_p), jnp.stack(sb_s),
            jnp.stack(k_p), jnp.stack(k_s), jnp.stack(v_p), jnp.stack(v_s))
```

```cpp
#include <hip/hip_runtime.h>
#include <cstdio>
#include <cstdint>
namespace pg8 {
#define PG8_LAS __attribute__((address_space(3)))
typedef unsigned short bf16_t;
typedef short bf16x8 __attribute__((ext_vector_type(8)));
typedef float f32x4 __attribute__((ext_vector_type(4)));
typedef unsigned u32x4 __attribute__((ext_vector_type(4)));
constexpr int BM = 256, BK = 64, HALF = 128, HTB = HALF * BK * 2  , STAGE_BYTES = 8 * HTB, NXCD = 8, WGM = 8;

__host__ __device__ __forceinline__ int lds_byte(int r, int c) { const int st = (r >> 4) * 2 + (c >> 5), rr = r & 15, cc = c & 31, ob = rr * 64 + cc * 2; return st * 1024 + (ob ^ (((ob >> 9) & 1) << 5)); }
__host__ __device__ __forceinline__ void stage_rc(int b, int& R, int& C) { const int st = b / 1024, sb = b % 1024, swz = sb ^ (((sb >> 9) & 1) << 5); R = (st >> 1) * 16 + swz / 64; C = (st & 1) * 32 + (swz % 64) / 2; }
__host__ __device__ __forceinline__ int perm32(int rho) { const int n = rho >> 4, i = rho & 15; return 8 * (i >> 2) + 4 * n + (i & 3); }

struct Unit { int pm, pn; };
struct Gemm { const bf16_t* A; const bf16_t* Bt; int M, N, K; };

struct StaticOrder {
    int nM, nN, nwg, G, c;
    __host__ __device__ void init(int M, int N, int G_, int c_) { nM = M / BM; nN = N / BM; nwg = nM * nN; G = G_; c = c_; }
    __host__ __device__ bool next(int i, Unit& u) const {
        const long L = (long)i * G + c; if (L >= nwg) return false;
        int wgid = (int)L; { const int q = nwg / NXCD, r = nwg % NXCD, xcd = wgid % NXCD, off = wgid / NXCD; wgid = (xcd < r ? xcd * (q + 1) : r * (q + 1) + (xcd - r) * q) + off; }
        const int nig = WGM * nN, gid = wgid / nig, fm = gid * WGM, gsz = (nM - fm) < WGM ? (nM - fm) : WGM;
        u.pm = fm + ((wgid % nig) % gsz); u.pn = (wgid % nig) / gsz; return true;
    }
    __device__ __forceinline__ void a_ready(const Unit&) const {}
    __device__ __forceinline__ void done(const Unit&) const {}
};

__device__ __forceinline__ unsigned cvt_pk_bf16(float lo, float hi) { unsigned r; asm volatile("v_cvt_pk_bf16_f32 %0, %1, %2" : "=v"(r) : "v"(lo), "v"(hi)); return r; }
typedef float f32x2 __attribute__((ext_vector_type(2)));
constexpr int EP_MP = 16384;
struct InProjDst {
    bf16_t *aq, *ai, *ag, *bq, *bk, *bv, *bg, *cq, *ck, *cv; float* logf;
    float *kout_p, *kout_s, *vout_p, *vout_s;
    const float* lb;
    int first, pad;
};
__device__ __forceinline__ float silu_f(float x) { return x / (1.0f + __expf(-x)); }
__device__ __forceinline__ float hgrn_logf(float z, float lb, int first) {
    const float e = __expf(-fabsf(z)), ope = 1.0f + e;
    if (first) return fminf(z, 0.f) - __logf(ope);
    const float sig = (z >= 0.f ? 1.0f : e) / ope;
    return __logf(lb + (1.0f - lb) * sig);
}
struct EpiInProj {
    static constexpr bool PERM = true, AFTER_DRAIN = false;
    InProjDst d;
    __device__ __forceinline__ void operator()(const f32x4 (&acc)[2][2][4][2], const Unit& u, int wr, int wc, int fr, int fq) const {
        const int pn = u.pn, row0 = u.pm * BM + wr * 64 + fr, cw = wc * 32 + 8 * fq;
        bf16_t* dst = nullptr; float* fdst = nullptr; int ld = 512, c0 = 0, mode = 0;
        const bool samp = u.pm >= (EP_MP / BM);
        if (pn < 2)        { dst = d.aq; ld = 512;  c0 = pn * 256;        mode = 1; }
        else if (pn < 4)   {             ld = 512;  c0 = (pn - 2) * 256;  mode = 2; }
        else if (pn < 6)   { dst = d.ai; ld = 512;  c0 = (pn - 4) * 256; }
        else if (pn < 8)   { dst = d.ag; ld = 512;  c0 = (pn - 6) * 256; }
        else if (pn == 8)  { dst = d.bq; ld = 256;  c0 = 0; }
        else if (pn == 9)  { dst = d.bk; ld = 256;  c0 = 0; }
        else if (pn < 12)  { dst = d.bv; ld = 512;  c0 = (pn - 10) * 256; }
        else if (pn < 14)  { dst = d.bg; ld = 512;  c0 = (pn - 12) * 256; }
        else if (pn < 18)  { dst = d.cq; ld = 1024; c0 = (pn - 14) * 256; }
        else if (pn < 22)  { dst = d.ck; ld = 1024; c0 = (pn - 18) * 256; mode = 3; fdst = samp ? d.kout_s : d.kout_p; }
        else               { dst = d.cv; ld = 1024; c0 = (pn - 22) * 256; mode = 3; fdst = samp ? d.vout_s : d.vout_p; }
        const int rsub = samp ? EP_MP : 0;
#pragma unroll
        for (int ai = 0; ai < 2; ++ai)
#pragma unroll
            for (int m = 0; m < 4; ++m) {
                const int row = row0 + ai * HALF + m * 16;
#pragma unroll
                for (int bj = 0; bj < 2; ++bj) {
                    const int col = c0 + cw + bj * HALF;
                    f32x4 v0 = acc[ai][bj][m][0], v1 = acc[ai][bj][m][1];
                    if (mode == 2) {
                        f32x4 l0 = {0.f, 0.f, 0.f, 0.f}, l1 = {0.f, 0.f, 0.f, 0.f};
                        if (!d.first) { l0 = *(const f32x4*)(d.lb + col); l1 = *(const f32x4*)(d.lb + col + 4); }
                        f32x4 o0, o1;
#pragma unroll
                        for (int e = 0; e < 4; ++e) { o0[e] = hgrn_logf(v0[e], l0[e], d.first); o1[e] = hgrn_logf(v1[e], l1[e], d.first); }
                        float* p = d.logf + (size_t)row * 512 + col;
                        *(f32x4*)p = o0; *(f32x4*)(p + 4) = o1;
                    } else {
                        if (mode == 1) {
                            const float sc = 0.08838834764831845f;
#pragma unroll
                            for (int e = 0; e < 4; ++e) { v0[e] = silu_f(v0[e]) * sc; v1[e] = silu_f(v1[e]) * sc; }
                        }
                        if (mode == 3) { float* p = fdst + (size_t)(row - rsub) * 1024 + col; *(f32x4*)p = v0; *(f32x4*)(p + 4) = v1; }
                        u32x4 w; w.x = cvt_pk_bf16(v0[0], v0[1]); w.y = cvt_pk_bf16(v0[2], v0[3]); w.z = cvt_pk_bf16(v1[0], v1[1]); w.w = cvt_pk_bf16(v1[2], v1[3]);
                        *(u32x4*)(dst + (size_t)row * ld + col) = w;
                    }
                }
            }
    }
};
struct EpiF32 {
    static constexpr bool PERM = false, AFTER_DRAIN = false;
    float* O; int ldc;
    __device__ __forceinline__ void operator()(const f32x4 (&acc)[2][2][4][2], const Unit& u, int wr, int wc, int fr, int fq) const {
        const int row0 = u.pm * BM + wr * 64 + fr, col0 = u.pn * BM + wc * 32 + 4 * fq;
#pragma unroll
        for (int ai = 0; ai < 2; ++ai)
#pragma unroll
            for (int m = 0; m < 4; ++m) { float* rowp = O + (size_t)(row0 + ai * HALF + m * 16) * ldc + col0;
#pragma unroll
                for (int bj = 0; bj < 2; ++bj)
#pragma unroll
                    for (int n = 0; n < 2; ++n) *(f32x4*)(rowp + bj * HALF + n * 16) = acc[ai][bj][m][n]; }
    }
};
struct EpiRelu2 {
    static constexpr bool PERM = true, AFTER_DRAIN = false;
    bf16_t* O; int ldc;
    __device__ __forceinline__ void operator()(const f32x4 (&acc)[2][2][4][2], const Unit& u, int wr, int wc, int fr, int fq) const {
        const int row0 = u.pm * BM + wr * 64 + fr, col0 = u.pn * BM + wc * 32 + 8 * fq;
#pragma unroll
        for (int ai = 0; ai < 2; ++ai)
#pragma unroll
            for (int m = 0; m < 4; ++m) { bf16_t* rowp = O + (size_t)(row0 + ai * HALF + m * 16) * ldc + col0;
#pragma unroll
                for (int bj = 0; bj < 2; ++bj) { f32x4 v0 = acc[ai][bj][m][0], v1 = acc[ai][bj][m][1];
#pragma unroll
                    for (int e = 0; e < 4; ++e) { const float a = fmaxf(v0[e], 0.f), b = fmaxf(v1[e], 0.f); v0[e] = a * a; v1[e] = b * b; }
                    u32x4 w; w.x = cvt_pk_bf16(v0[0], v0[1]); w.y = cvt_pk_bf16(v0[2], v0[3]); w.z = cvt_pk_bf16(v1[0], v1[1]); w.w = cvt_pk_bf16(v1[2], v1[3]);
                    *(u32x4*)(rowp + bj * HALF) = w; } }
    }
};
template <class Epi, class Sched, bool ALIGN_EPI = false, bool SP2 = false>
__device__ __forceinline__ void gemm_phase(PG8_LAS unsigned char* lds, const Gemm g, const Sched& S, const Epi& E) {
    int tid_ = threadIdx.x; asm volatile("" : "+v"(tid_));
    const int tid = tid_, wid = __builtin_amdgcn_readfirstlane(tid >> 6), lane = tid & 63, wr = wid >> 2, wc = wid & 3, fr = lane & 15, fq = lane >> 4;
    const int K = g.K, nt = K / BK;
    unsigned voffA[2], voffB[2];
#pragma unroll
    for (int i = 0; i < 2; ++i) { int R, C; stage_rc(tid * 16 + i * 8192, R, C); const int Rb = Epi::PERM ? ((R & ~31) + perm32(R & 31)) : R;
        voffA[i] = (unsigned)(R * K + C) * 2u; voffB[i] = (unsigned)(Rb * K + C) * 2u; }
    const size_t kstep = (size_t)(BK * 2);
    const size_t hstep = (size_t)HALF * K * 2;
    const size_t tstep = 2 * hstep;
    const unsigned ldsw = (unsigned)wid * 1024u;
    const int aoff = lds_byte(wr * 64 + fr, fq * 8), boff = lds_byte(wc * 32 + fr, fq * 8);
#define PG8_SA(b, h) (((b) * 2 + (h)) * HTB)
#define PG8_SB(b, h) ((4 + (b) * 2 + (h)) * HTB)
#define PG8_STAGE(bufoff, gbase, voff) do { _Pragma("unroll") for (int _i = 0; _i < 2; ++_i) \
        __builtin_amdgcn_global_load_lds((const unsigned*)((const char*)(gbase) + (voff)[_i]), (PG8_LAS unsigned*)(lds + (bufoff) + ldsw + _i * 8192), 16, 0, 0); } while (0)
#define PG8_LDA(dst, b, h) do { _Pragma("unroll") for (int m = 0; m < 4; ++m) _Pragma("unroll") for (int k = 0; k < 2; ++k) dst[m][k] = *(const PG8_LAS bf16x8*)(lds + PG8_SA(b, h) + aoff + m * 2048 + k * 1024); } while (0)
#define PG8_LDB(dst, b, h) do { _Pragma("unroll") for (int n = 0; n < 2; ++n) _Pragma("unroll") for (int k = 0; k < 2; ++k) dst[n][k] = *(const PG8_LAS bf16x8*)(lds + PG8_SB(b, h) + boff + n * 2048 + k * 1024); } while (0)
#define PG8_MMA(ai, bj, At, Bt) do { __builtin_amdgcn_s_setprio(1); _Pragma("unroll") for (int m = 0; m < 4; ++m) _Pragma("unroll") for (int n = 0; n < 2; ++n) _Pragma("unroll") for (int k = 0; k < 2; ++k) \
        acc[ai][bj][m][n] = __builtin_amdgcn_mfma_f32_16x16x32_bf16(Bt[n][k], At[m][k], acc[ai][bj][m][n], 0, 0, 0); __builtin_amdgcn_s_setprio(0); } while (0)
#define PG8_WAIT_V(n) asm volatile("s_waitcnt vmcnt(" #n ")" ::: "memory")
#define PG8_WAIT_L(n) asm volatile("s_waitcnt lgkmcnt(" #n ")" ::: "memory")
#define PG8_BAR __builtin_amdgcn_s_barrier()
#define PG8_SCHED __builtin_amdgcn_sched_barrier(0)
    Unit cur, nxt; int ui = 0;
    if (!S.next(0, cur)) return;
    f32x4 acc[2][2][4][2];
#pragma unroll
    for (int a = 0; a < 2; ++a)
#pragma unroll
        for (int b = 0; b < 2; ++b)
#pragma unroll
            for (int m = 0; m < 4; ++m)
#pragma unroll
                for (int n = 0; n < 2; ++n) acc[a][b][m][n] = (f32x4){0.f, 0.f, 0.f, 0.f};
    bf16x8 At[4][2], B0[2][2], B1[2][2];
    const char* cA = (const char*)g.A + (size_t)cur.pm * tstep; const char* cB = (const char*)g.Bt + (size_t)cur.pn * tstep;
    S.a_ready(cur);
    if constexpr (SP2) {
        PG8_STAGE(PG8_SB(0, 0), cB, voffB); PG8_STAGE(PG8_SB(0, 1), cB + hstep, voffB); PG8_STAGE(PG8_SA(0, 0), cA, voffA); PG8_STAGE(PG8_SA(0, 1), cA + hstep, voffA);
        if (wr == 1) PG8_BAR;
        PG8_WAIT_V(2); PG8_BAR;
        PG8_STAGE(PG8_SB(1, 0), cB + kstep, voffB); PG8_STAGE(PG8_SA(1, 0), cA + kstep, voffA); PG8_STAGE(PG8_SB(1, 1), cB + hstep + kstep, voffB);
        PG8_WAIT_V(6); PG8_BAR;
    } else {
        PG8_STAGE(PG8_SB(0, 0), cB, voffB); PG8_STAGE(PG8_SA(0, 0), cA, voffA); PG8_STAGE(PG8_SB(0, 1), cB + hstep, voffB); PG8_STAGE(PG8_SA(0, 1), cA + hstep, voffA);
        if (wr == 1) PG8_BAR;
        PG8_WAIT_V(4); PG8_BAR;
        PG8_STAGE(PG8_SB(1, 0), cB + kstep, voffB); PG8_STAGE(PG8_SA(1, 0), cA + kstep, voffA); PG8_STAGE(PG8_SB(1, 1), cB + hstep + kstep, voffB);
        PG8_WAIT_V(6); PG8_BAR;
    }
    for (;;) {
        const bool has_next = S.next(ui + 1, nxt);
        const char* nA = has_next ? (const char*)g.A + (size_t)nxt.pm * tstep : cA; const char* nB = has_next ? (const char*)g.Bt + (size_t)nxt.pn * tstep : cB;
        for (int t = 0; t < nt; t += 2) {
            const bool last = (t == nt - 2);
            const char* a1 = cA + (size_t)(t + 1) * kstep;
            const char* a2 = last ? nA : cA + (size_t)(t + 2) * kstep; const char* b2 = last ? nB : cB + (size_t)(t + 2) * kstep;
            const char* a3 = a2 + kstep; const char* b3 = b2 + kstep;
            if (last && has_next) S.a_ready(nxt);
            if constexpr (SP2) {
            PG8_LDB(B0, 0, 0); PG8_LDB(B1, 0, 1); PG8_SCHED; PG8_LDA(At, 0, 0); PG8_STAGE(PG8_SA(1, 1), a1 + hstep, voffA);
            PG8_WAIT_V(8); PG8_WAIT_L(0); PG8_BAR; PG8_MMA(0, 0, At, B0); PG8_MMA(0, 1, At, B1); PG8_BAR; PG8_SCHED;
            PG8_LDA(At, 0, 1); PG8_STAGE(PG8_SB(0, 0), b2, voffB); PG8_STAGE(PG8_SB(0, 1), b2 + hstep, voffB); PG8_STAGE(PG8_SA(0, 0), a2, voffA);
            PG8_WAIT_V(8); PG8_WAIT_L(0); PG8_BAR; PG8_MMA(1, 0, At, B0); PG8_MMA(1, 1, At, B1); PG8_BAR; PG8_SCHED;
            PG8_LDB(B0, 1, 0); PG8_LDB(B1, 1, 1); PG8_SCHED; PG8_LDA(At, 1, 0); PG8_STAGE(PG8_SA(0, 1), a2 + hstep, voffA);
            PG8_WAIT_V(8); PG8_WAIT_L(0); PG8_BAR; PG8_MMA(0, 0, At, B0); PG8_MMA(0, 1, At, B1); PG8_BAR; PG8_SCHED;
            PG8_LDA(At, 1, 1); PG8_STAGE(PG8_SB(1, 0), b3, voffB); PG8_STAGE(PG8_SB(1, 1), b3 + hstep, voffB); PG8_STAGE(PG8_SA(1, 0), a3, voffA);
            PG8_WAIT_V(8); PG8_WAIT_L(0); PG8_BAR; PG8_MMA(1, 0, At, B0); PG8_MMA(1, 1, At, B1); PG8_BAR; PG8_SCHED;
            } else {
            PG8_LDB(B0, 0, 0); PG8_SCHED; PG8_LDA(At, 0, 0); PG8_STAGE(PG8_SA(1, 1), a1 + hstep, voffA);
            PG8_WAIT_L(8); PG8_BAR; PG8_WAIT_L(0); PG8_MMA(0, 0, At, B0); PG8_BAR; PG8_SCHED;
            PG8_LDB(B1, 0, 1); PG8_STAGE(PG8_SB(0, 0), b2, voffB);
            PG8_BAR; PG8_WAIT_L(0); PG8_MMA(0, 1, At, B1); PG8_BAR;
            PG8_LDA(At, 0, 1); PG8_STAGE(PG8_SA(0, 0), a2, voffA);
            PG8_BAR; PG8_WAIT_L(0); PG8_MMA(1, 0, At, B0); PG8_BAR; PG8_SCHED;
            PG8_STAGE(PG8_SB(0, 1), b2 + hstep, voffB);
            PG8_WAIT_V(6); PG8_BAR; PG8_MMA(1, 1, At, B1); PG8_BAR;
            PG8_LDB(B0, 1, 0); PG8_SCHED; PG8_LDA(At, 1, 0); PG8_STAGE(PG8_SA(0, 1), a2 + hstep, voffA);
            PG8_WAIT_L(8); PG8_BAR; PG8_WAIT_L(0); PG8_MMA(0, 0, At, B0); PG8_BAR; PG8_SCHED;
            PG8_LDB(B1, 1, 1); PG8_STAGE(PG8_SB(1, 0), b3, voffB);
            PG8_BAR; PG8_WAIT_L(0); PG8_MMA(0, 1, At, B1); PG8_BAR;
            PG8_LDA(At, 1, 1); PG8_STAGE(PG8_SA(1, 0), a3, voffA);
            PG8_BAR; PG8_WAIT_L(0); PG8_MMA(1, 0, At, B0); PG8_BAR; PG8_SCHED;
            PG8_STAGE(PG8_SB(1, 1), b3 + hstep, voffB);
            PG8_WAIT_V(6); PG8_BAR; PG8_MMA(1, 1, At, B1); PG8_BAR;
            }
        }
        if constexpr (ALIGN_EPI) { if (wr == 0) PG8_BAR; }
        if constexpr (!Epi::AFTER_DRAIN) { E(acc, cur, wr, wc, fr, fq); S.done(cur); }
        if (!has_next) break;
#pragma unroll
        for (int a = 0; a < 2; ++a)
#pragma unroll
            for (int b = 0; b < 2; ++b)
#pragma unroll
                for (int m = 0; m < 4; ++m)
#pragma unroll
                    for (int n = 0; n < 2; ++n) acc[a][b][m][n] = (f32x4){0.f, 0.f, 0.f, 0.f};
        cur = nxt; cA = nA; cB = nB; ++ui;
        if constexpr (ALIGN_EPI) { if (wr == 1) PG8_BAR; }
    }
    PG8_WAIT_V(0);
    if constexpr (!ALIGN_EPI) { if (wr == 0) PG8_BAR; }
    PG8_BAR;
    if constexpr (Epi::AFTER_DRAIN) { E.fused(acc, cur, wr, wc, fr, fq, lds, wid, lane); S.done(cur); }
#undef PG8_SA
#undef PG8_SB
#undef PG8_STAGE
#undef PG8_LDA
#undef PG8_LDB
#undef PG8_MMA
#undef PG8_WAIT_V
#undef PG8_WAIT_L
#undef PG8_BAR
#undef PG8_SCHED
}
}
namespace att {
typedef unsigned short bf16;
constexpr int   D = 128, NW = 8, QBLK = 32, KVBLK = 64;
constexpr float SCALE = 0.088388347648318440f;
constexpr float THR = 8.f;
constexpr int SDEPTH = 2;
constexpr int LDQ = 1024, LDK = 1024, LDO = 2048;
constexpr size_t SHM_V = KVBLK * D * 2, SHM_K = KVBLK * D * 2, SHM_ATTN = 2 * SHM_V + 2 * SHM_K + NW * 64 * 4;
using bf16x8 = __attribute__((ext_vector_type(8))) short;
using s16x4  = __attribute__((ext_vector_type(4))) short;
using f32x16 = __attribute__((ext_vector_type(16))) float;
using f32x8  = __attribute__((ext_vector_type(8))) float;
using u32x4  = __attribute__((ext_vector_type(4))) unsigned;
#define KSWZ(row, colB) ((row) * 256 + ((colB) ^ (((row) & 7) << 4)))
#define SBAR() __builtin_amdgcn_sched_barrier(0)
__device__ __forceinline__ int crow(int r, int hi) { return (r & 3) + 8 * (r >> 2) + 4 * hi; }
__device__ __forceinline__ unsigned cvtpk(float lo, float hi) {
  unsigned r; asm volatile("v_cvt_pk_bf16_f32 %0, %1, %2" : "=v"(r) : "v"(lo), "v"(hi)); return r;
}
template <typename TIn> struct Stage;
template <> struct Stage<bf16>  { using T = bf16x8;
  __device__ static __forceinline__ T ld8(const bf16* p) { return *reinterpret_cast<const bf16x8*>(p); }
  __device__ static __forceinline__ bf16x8 tobf(T x) { return x; } };
template <> struct Stage<float> { using T = f32x8;
  __device__ static __forceinline__ T ld8(const float* p) { return *reinterpret_cast<const f32x8*>(p); }
  __device__ static __forceinline__ bf16x8 tobf(T x) {
    u32x4 w = {cvtpk(x[0], x[1]), cvtpk(x[2], x[3]), cvtpk(x[4], x[5]), cvtpk(x[6], x[7])}; return *reinterpret_cast<bf16x8*>(&w); } };

__device__ __forceinline__ void partialSM(f32x16& p0, f32x16& p1, float& m_reg, float& mn, float& alpha) {
  constexpr float C = SCALE * 1.4426950408889634f;
  float pmax = p0[0]; for (int r = 1; r < 16; ++r) pmax = fmaxf(pmax, p0[r]); for (int r = 0; r < 16; ++r) pmax = fmaxf(pmax, p1[r]);
  { auto rr = __builtin_amdgcn_permlane32_swap(__float_as_uint(pmax), __float_as_uint(pmax), false, false);
    pmax = fmaxf(__uint_as_float(rr[0]), __uint_as_float(rr[1])); }
  if (__builtin_expect(__all(pmax - m_reg <= THR / SCALE), 1)) { mn = m_reg; alpha = 1.f; }
  else { mn = fmaxf(m_reg, pmax); alpha = __builtin_amdgcn_exp2f((m_reg - mn) * C); m_reg = mn; }
  float mnC = -mn * C;
  for (int r = 0; r < 16; ++r) p0[r] = fmaf(p0[r], C, mnC); for (int r = 0; r < 16; ++r) p1[r] = fmaf(p1[r], C, mnC);
  for (int r = 0; r < 16; ++r) p0[r] = __builtin_amdgcn_exp2f(p0[r]);
}
__device__ __forceinline__ void finishSM(f32x16& p0, f32x16& p1, float alpha, float& l_reg, bf16x8& pa0, bf16x8& pa1, bf16x8& pa2, bf16x8& pa3) {
  for (int r = 0; r < 16; ++r) p1[r] = __builtin_amdgcn_exp2f(p1[r]);
  float ps = 0; for (int r = 0; r < 16; ++r) ps += p0[r]; for (int r = 0; r < 16; ++r) ps += p1[r];
  { auto rr = __builtin_amdgcn_permlane32_swap(__float_as_uint(ps), __float_as_uint(ps), false, false);
    ps = __uint_as_float(rr[0]) + __uint_as_float(rr[1]); }
  l_reg = l_reg * alpha + ps;
#define PK4(P, BASE, OUT) do { unsigned a0 = cvtpk(P[BASE + 0], P[BASE + 1]), a1 = cvtpk(P[BASE + 2], P[BASE + 3]);   \
    unsigned b0 = cvtpk(P[BASE + 4], P[BASE + 5]), b1 = cvtpk(P[BASE + 6], P[BASE + 7]);                              \
    auto r0 = __builtin_amdgcn_permlane32_swap(a0, b0, false, false); auto r1 = __builtin_amdgcn_permlane32_swap(a1, b1, false, false); \
    u32x4 w = {r0[0], r1[0], r0[1], r1[1]}; OUT = *reinterpret_cast<bf16x8*>(&w); } while (0)
  PK4(p0, 0, pa0); PK4(p0, 8, pa1); PK4(p1, 0, pa2); PK4(p1, 8, pa3);
#undef PK4
}
__device__ __forceinline__ void qkt(f32x16& p0, f32x16& p1, const bf16* Ks, const bf16x8* qr, int r32, int hi) {
  p0 = f32x16{}; p1 = f32x16{};
  for (int d0 = 0; d0 < 8; ++d0) { int cb = (d0 * 16 + hi * 8) * 2;
    bf16x8 b0 = *reinterpret_cast<const bf16x8*>((const char*)Ks + KSWZ(r32, cb));
    bf16x8 b1 = *reinterpret_cast<const bf16x8*>((const char*)Ks + KSWZ(32 + r32, cb));
    p0 = __builtin_amdgcn_mfma_f32_32x32x16_bf16(b0, qr[d0], p0, 0, 0, 0);
    p1 = __builtin_amdgcn_mfma_f32_32x32x16_bf16(b1, qr[d0], p1, 0, 0, 0); }
}
__device__ __forceinline__ int v_st(int k, int c) { const int kk = (k & ~0xC) | ((k & 4) << 1) | ((k & 8) >> 1); return ((kk >> 3) * 4 + (c >> 5)) * 512 + ((kk & 7) * 32 + (c & 31)) * 2; }
__device__ __forceinline__ int v_rd_base(int lane) { return ((lane & 3) << 3) | (((lane >> 2) & 3) << 6) | (((lane >> 4) & 1) << 5) | (((lane >> 5) & 1) << 8); }
constexpr int v_rd_off(int d0, int ks, int half) { return d0 * 512 + ks * 4096 + half * 2048; }
template <int OFF> __device__ __forceinline__ s16x4 tr_read(int vb) {
  s16x4 r; asm volatile("ds_read_b64_tr_b16 %0, %1 offset:%2" : "=&v"(r) : "v"(vb), "i"(OFF) : "memory"); return r;
}
template <int D0> __device__ __forceinline__ void pv_one(f32x16& od, int vb, bf16x8 pa0, bf16x8 pa1, bf16x8 pa2, bf16x8 pa3) {
  const s16x4 l0 = tr_read<v_rd_off(D0, 0, 0)>(vb), h0 = tr_read<v_rd_off(D0, 0, 1)>(vb), l1 = tr_read<v_rd_off(D0, 1, 0)>(vb), h1 = tr_read<v_rd_off(D0, 1, 1)>(vb);
  const s16x4 l2 = tr_read<v_rd_off(D0, 2, 0)>(vb), h2 = tr_read<v_rd_off(D0, 2, 1)>(vb), l3 = tr_read<v_rd_off(D0, 3, 0)>(vb), h3 = tr_read<v_rd_off(D0, 3, 1)>(vb);
  asm volatile("s_waitcnt lgkmcnt(0)" ::: "memory"); SBAR();
#define PK(L, H) (bf16x8){L[0], L[1], L[2], L[3], H[0], H[1], H[2], H[3]}
  od = __builtin_amdgcn_mfma_f32_32x32x16_bf16(pa0, PK(l0, h0), od, 0, 0, 0);
  od = __builtin_amdgcn_mfma_f32_32x32x16_bf16(pa1, PK(l1, h1), od, 0, 0, 0);
  od = __builtin_amdgcn_mfma_f32_32x32x16_bf16(pa2, PK(l2, h2), od, 0, 0, 0);
  od = __builtin_amdgcn_mfma_f32_32x32x16_bf16(pa3, PK(l3, h3), od, 0, 0, 0);
#undef PK
}
__device__ __forceinline__ void pv_d0(f32x16* o, int vb, bf16x8 pa0, bf16x8 pa1, bf16x8 pa2, bf16x8 pa3) {
  pv_one<0>(o[0], vb, pa0, pa1, pa2, pa3); pv_one<1>(o[1], vb, pa0, pa1, pa2, pa3); pv_one<2>(o[2], vb, pa0, pa1, pa2, pa3); pv_one<3>(o[3], vb, pa0, pa1, pa2, pa3);
}

struct KVSrc { const bf16* k0; const bf16* v0; const bf16* k1; const bf16* v1; int nt0, ntreal; };
__device__ __forceinline__ void mask_tile(f32x16& p0, f32x16& p1) {
#pragma unroll
  for (int r = 0; r < 16; ++r) { p0[r] = -1e30f; p1[r] = -1e30f; }
}
__device__ __forceinline__ void attn_body(const bf16* __restrict__ Qwv, const KVSrc src, float* __restrict__ Owv, const int NT, const int lim, char* lds) {
  using St = Stage<bf16>;
  int tid_ = threadIdx.x; asm volatile("" : "+v"(tid_));
  const int tid = tid_, wid = tid >> 6, lane = tid & 63, r32 = lane & 31, hi = lane >> 5;
  bf16* V_lds = (bf16*)lds; bf16* K_lds = (bf16*)(lds + 2 * SHM_V);
  float* ws = (float*)(lds + 2 * SHM_V + 2 * SHM_K) + wid * 64; float* li_l = ws; float* al_l = ws + 32;
  float m_reg = -1e30f, l_reg = 0; f32x16 o[4] = {}; bf16x8 qr[8];
  const bf16* Qw = Qwv + (long)r32 * LDQ + hi * 8;
#pragma unroll
  for (int d0 = 0; d0 < 8; ++d0) qr[d0] = St::ld8(Qw + d0 * 16);
  const int sr = tid >> 4, sc = (tid & 15) * 8, vst0 = v_st(sr, sc), vst1 = v_st(32 + sr, sc);
  const int vb0 = (int)(uintptr_t)V_lds + v_rd_base(lane);
  struct { typename St::T vs0, vs1, ks0, ks1; } sr_[SDEPTH];
#define SLOAD(i, t) do { int tt_ = (t) < src.ntreal ? (t) : src.ntreal - 1; const bf16* kp_; const bf16* vp_; \
    if (tt_ < src.nt0) { kp_ = src.k0 + (long)tt_ * (KVBLK * LDK); vp_ = src.v0 + (long)tt_ * (KVBLK * LDK); } \
    else { kp_ = src.k1 + (long)(tt_ - src.nt0) * (KVBLK * LDK); vp_ = src.v1 + (long)(tt_ - src.nt0) * (KVBLK * LDK); } \
    sr_[i].vs0 = St::ld8(&vp_[(long)sr * LDK + sc]); sr_[i].vs1 = St::ld8(&vp_[(long)(32 + sr) * LDK + sc]); \
    sr_[i].ks0 = St::ld8(&kp_[(long)sr * LDK + sc]); sr_[i].ks1 = St::ld8(&kp_[(long)(32 + sr) * LDK + sc]); } while (0)
#define SWRITE(b, i) do { *(bf16x8*)((char*)V_lds + (b) * SHM_V + vst0) = St::tobf(sr_[i].vs0);          \
    *(bf16x8*)((char*)V_lds + (b) * SHM_V + vst1) = St::tobf(sr_[i].vs1); int kc = sc * 2;               \
    *(bf16x8*)((char*)K_lds + (b) * SHM_K + KSWZ(sr, kc)) = St::tobf(sr_[i].ks0);                       \
    *(bf16x8*)((char*)K_lds + (b) * SHM_K + KSWZ(32 + sr, kc)) = St::tobf(sr_[i].ks1); } while (0)
#define SWAIT() do { if constexpr (SDEPTH == 2) asm volatile("s_waitcnt vmcnt(4)" ::: "memory"); else asm volatile("s_waitcnt vmcnt(0)" ::: "memory"); } while (0)
#define RESC(a) do { if (__any((a) < 1.f)) { if (hi == 0) al_l[r32] = (a); asm volatile("s_waitcnt lgkmcnt(0)" ::: "memory"); \
    for (int d = 0; d < 4; ++d) for (int r = 0; r < 16; ++r) o[d][r] *= al_l[crow(r, hi)]; } } while (0)
  f32x16 pA0, pA1, pB0, pB1; float mnA, mnB, alA, alB; bf16x8 pa0, pa1, pa2, pa3;
  constexpr int SE = 0, SO = SDEPTH - 1;
  SLOAD(SE, 0); asm volatile("s_waitcnt vmcnt(0)" ::: "memory"); SWRITE(0, SE); __syncthreads();
  qkt(pA0, pA1, K_lds, qr, r32, hi); partialSM(pA0, pA1, m_reg, mnA, alA);
  SLOAD(SO, 1); if constexpr (SDEPTH == 2) { if (2 < NT) SLOAD(SE, 2); }
  SWAIT(); SWRITE(1, SO); __syncthreads();
  for (int j = 1; j + 1 < NT; j += 2) {
    SBAR(); qkt(pB0, pB1, (bf16*)((char*)K_lds + SHM_K), qr, r32, hi); if (j > lim) mask_tile(pB0, pB1);
    finishSM(pA0, pA1, alA, l_reg, pa0, pa1, pa2, pa3); SBAR();
    SLOAD(SO, j + SDEPTH); SBAR();
    pv_d0(o, vb0, pa0, pa1, pa2, pa3); partialSM(pB0, pB1, m_reg, mnB, alB);
    __syncthreads(); SWAIT(); SWRITE(0, SE);
    RESC(alB); __syncthreads();
    SBAR(); qkt(pA0, pA1, K_lds, qr, r32, hi); if (j + 1 > lim) mask_tile(pA0, pA1);
    finishSM(pB0, pB1, alB, l_reg, pa0, pa1, pa2, pa3); SBAR();
    if (SDEPTH == 1 || j + 3 < NT) SLOAD(SE, j + 1 + SDEPTH); SBAR();
    pv_d0(o, vb0 + (int)SHM_V, pa0, pa1, pa2, pa3); partialSM(pA0, pA1, m_reg, mnA, alA);
    __syncthreads(); SWAIT(); SWRITE(1, SO);
    RESC(alA); __syncthreads();
  }
  SBAR(); qkt(pB0, pB1, (bf16*)((char*)K_lds + SHM_K), qr, r32, hi); if (NT - 1 > lim) mask_tile(pB0, pB1);
  finishSM(pA0, pA1, alA, l_reg, pa0, pa1, pa2, pa3); SBAR();
  pv_d0(o, vb0, pa0, pa1, pa2, pa3); partialSM(pB0, pB1, m_reg, mnB, alB);
  __syncthreads(); RESC(alB);
  finishSM(pB0, pB1, alB, l_reg, pa0, pa1, pa2, pa3); SBAR();
  pv_d0(o, vb0 + (int)SHM_V, pa0, pa1, pa2, pa3);
  if (hi == 0) li_l[r32] = l_reg; asm volatile("s_waitcnt lgkmcnt(0)" ::: "memory");
  float rli[16];
#pragma unroll
  for (int r = 0; r < 16; ++r) rli[r] = __builtin_amdgcn_rcpf(li_l[crow(r, hi)]);
  if (Owv != nullptr) {
#pragma unroll
    for (int r = 0; r < 16; ++r) { int orow = crow(r, hi);
      for (int d0 = 0; d0 < 4; ++d0) Owv[(long)orow * LDO + d0 * 32 + r32] = o[d0][r] * rli[r]; }
  }
  asm volatile("s_waitcnt vmcnt(0)" ::: "memory");
#undef SLOAD
#undef SWRITE
#undef SWAIT
#undef RESC
}
#undef KSWZ
#undef SBAR
}
constexpr int NWAVES = 8;
#ifndef MK_N_LAUNCHES
#define MK_N_LAUNCHES 21
#endif
constexpr int DM = 2048, MP = 16384, MS = 1024, M = MP + MS, NIN = 6656, DFF = 8192, DEPTH = 2, SEQ = 8192, PAST = 2048;
constexpr int NCHUNK = M / 64;
constexpr float EPS = 1e-6f;
constexpr int PH_PER_LAYER = 10, NPHASE = 1 + DEPTH * PH_PER_LAYER;
constexpr int N_LAUNCHES = (MK_N_LAUNCHES == 1) ? 1 : NPHASE;
constexpr size_t O_YP = 0, O_YS = O_YP + (size_t)MP * DM, O_HP = O_YS + (size_t)MS * DM, O_HS = O_HP + (size_t)DEPTH * 2 * 4 * 128 * 128,
                 O_RP = O_HS + (size_t)DEPTH * 16 * 4 * 128 * 128, O_RS = O_RP + (size_t)DEPTH * 2 * 4 * 64 * 128, O_KP = O_RS + (size_t)DEPTH * 16 * 4 * 64 * 128,
                 O_KS = O_KP + (size_t)DEPTH * MP * 1024, O_VP = O_KS + (size_t)DEPTH * MS * 1024, O_VS = O_VP + (size_t)DEPTH * MP * 1024, O_END = O_VS + (size_t)DEPTH * MS * 1024;
constexpr size_t MiB = 1u << 20;
constexpr size_t WS_CTL = 0, CTL_ZERO_BYTES = 1 * MiB;
constexpr size_t WS_SCAL = 1 * MiB;
constexpr size_t WS_ROT = 2 * MiB;
constexpr size_t WS_WIN = 4 * MiB, WIN_BYTES = (size_t)NIN * DM * 2;
constexpr size_t WS_WOUT = WS_WIN + 2 * WIN_BYTES, WOUT_BYTES = (size_t)DM * DM * 2;
constexpr size_t WS_WUP = WS_WOUT + 2 * WOUT_BYTES, WUP_BYTES = (size_t)DFF * DM * 2;
constexpr size_t WS_WDN = WS_WUP + 2 * WUP_BYTES, WDN_BYTES = (size_t)DM * DFF * 2;
constexpr size_t WS_H = WS_WDN + 2 * WDN_BYTES;
constexpr size_t WS_R1 = WS_H + (size_t)M * DM * 2;
constexpr size_t R1_AQ = 0, R1_LOGF = R1_AQ + (size_t)M * 512 * 2, R1_AI = R1_LOGF + (size_t)M * 512 * 4, R1_AG = R1_AI + (size_t)M * 512 * 2,
                 R1_BQ = R1_AG + (size_t)M * 512 * 2, R1_BK = R1_BQ + (size_t)M * 256 * 2, R1_BV = R1_BK + (size_t)M * 256 * 2, R1_BG = R1_BV + (size_t)M * 512 * 2,
                 R1_CQ = R1_BG + (size_t)M * 512 * 2, R1_CK = R1_CQ + (size_t)M * 1024 * 2, R1_CV = R1_CK + (size_t)M * 1024 * 2, R1_MIX = R1_CV + (size_t)M * 1024 * 2,
                 R1_END = R1_MIX + (size_t)M * DM * 2;
static_assert((size_t)M * DFF * 2 <= R1_END, "U overlays R1");
constexpr size_t WS_Y = WS_R1 + R1_END;
constexpr size_t WS_DSA = WS_Y + (size_t)M * DM * 4;
constexpr size_t WS_DSB = WS_DSA + (size_t)NCHUNK * 4 * 16384 * 4;
constexpr size_t WS_DEC = WS_DSB + (size_t)NCHUNK * 4 * 8192 * 4;
constexpr size_t WS_CK = WS_DEC + 1 * MiB;
constexpr size_t WS_CV = WS_CK + (size_t)16 * PAST * 1024 * 2;
constexpr size_t WS_END = WS_CV + (size_t)16 * PAST * 1024 * 2;
static_assert((size_t)NCHUNK * 4 * 128 * 4 <= 1 * MiB, "decay table");
constexpr int CW_TMO = 0, CW_BAR = 4096;

constexpr int RING_OFF = 0, RING_BYTES = 131072;
constexpr int LDSCTL_OFF = RING_BYTES, MISC_OFF = LDSCTL_OFF + 320;
constexpr int LDS_BYTES = 147456;
static_assert(MISC_OFF + 128 <= LDS_BYTES, "LDS map");

#define GAS __attribute__((address_space(1)))
#define LAS __attribute__((address_space(3)))
typedef unsigned short bf16;
typedef unsigned v4u __attribute__((ext_vector_type(4)));
typedef unsigned v2u __attribute__((ext_vector_type(2)));
typedef float f32x4 __attribute__((ext_vector_type(4)));
typedef float f32x16 __attribute__((ext_vector_type(16)));
typedef short bf16x8 __attribute__((ext_vector_type(8)));
typedef GAS unsigned gu32;
#define RLX_AGENT __ATOMIC_RELAXED, __HIP_MEMORY_SCOPE_AGENT
#define LDS_WAIT() asm volatile("s_waitcnt lgkmcnt(0)" ::: "memory")
#define VM_WAIT() asm volatile("s_waitcnt vmcnt(0)" ::: "memory")
__device__ __forceinline__ unsigned f2bf(float f) { unsigned u = __builtin_bit_cast(unsigned, f); return (u + 0x7fffu + ((u >> 16) & 1u)) >> 16; }
__device__ __forceinline__ unsigned pk2(float lo, float hi) { return f2bf(lo) | (f2bf(hi) << 16); }
__device__ __forceinline__ float bf2f(unsigned short b) { return __builtin_bit_cast(float, (unsigned)b << 16); }
#define XB_TMO      128
#define XB_XCNT(j)  (256  + 64 * (j))
#define XB_XSUB(j)  (1280 + 64 * (j))
#define XB_XGEN(j)  (2304 + 64 * (j))
#define XB_TOP      3328
#define XB_TOPGEN   3392
#define XCD_BAR_WORDS 3456
#define XB_SPIN_CAP (1u << 18)

__device__ __forceinline__ unsigned xb_ld(unsigned* p)              { return __hip_atomic_load(p, __ATOMIC_RELAXED, __HIP_MEMORY_SCOPE_AGENT); }
__device__ __forceinline__ unsigned xb_add(unsigned* p, unsigned v) { return __hip_atomic_fetch_add(p, v, __ATOMIC_RELAXED, __HIP_MEMORY_SCOPE_AGENT); }
__device__ __forceinline__ unsigned xb_xcc_id() { return (unsigned)__builtin_amdgcn_s_getreg((3 << 11) | 20) & 0xFu; }
#define XB_SPIN(cond, bar) do { unsigned _sp = 0; while (cond) { __builtin_amdgcn_s_sleep(1); \
    if ((++_sp & 255u) == 0u) { if (xb_ld(&(bar)[XB_TMO])) break; if (_sp > XB_SPIN_CAP) { atomicAdd(&(bar)[XB_TMO], 1u); break; } } } } while (0)

struct XcdBarrier {
    unsigned* bar; unsigned x;
    volatile LAS unsigned* st;
};

__device__ __forceinline__ XcdBarrier xcd_barrier_post(unsigned* bar, volatile LAS unsigned* st) {
    XcdBarrier b; b.bar = bar; b.x = xb_xcc_id(); b.st = st;
    if (threadIdx.x == 0) (void)xb_add(&bar[XB_XCNT(b.x)], 1u);
    return b;
}
__device__ __forceinline__ void xcd_barrier_complete(unsigned* bar, unsigned x, unsigned& nloc, unsigned& nx) {
    const unsigned G = gridDim.x * gridDim.y * gridDim.z;
    unsigned sum, cnt, mine, sp = 0u;
    for (;;) {
        sum = 0u; cnt = 0u; mine = 0u;
#pragma unroll
        for (unsigned j = 0; j < 16; ++j) { const unsigned c = xb_ld(&bar[XB_XCNT(j)]); sum += c; cnt += (c > 0u) ? 1u : 0u; mine = (j == x) ? c : mine; }
        if (sum == G) break;
        __builtin_amdgcn_s_sleep(1);
        if ((++sp & 255u) == 0u) { if (xb_ld(&bar[XB_TMO])) break; if (sp > XB_SPIN_CAP) { atomicAdd(&bar[XB_TMO], 1u); break; } }
    }
    nloc = mine > 0u ? mine : 1u; nx = cnt > 0u ? cnt : 1u;
}

__device__ __forceinline__ void xcd_barrier(const XcdBarrier& b) {
    asm volatile("s_waitcnt vmcnt(0)" ::: "memory");
    __syncthreads();
    if (threadIdx.x == 0) {
        unsigned* bar = b.bar;
        __builtin_amdgcn_s_waitcnt(0);
        unsigned nloc = b.st[0], nx = b.st[1];
        if (nloc == 0u) { xcd_barrier_complete(bar, b.x, nloc, nx); b.st[0] = nloc; b.st[1] = nx; }
        const unsigned old = xb_add(&bar[XB_XSUB(b.x)], 1u);
        const unsigned gen = old / nloc;
        if (old + 1u == (gen + 1u) * nloc) {
            __builtin_amdgcn_fence(__ATOMIC_RELEASE, "agent");
            asm volatile("s_waitcnt vmcnt(0)" ::: "memory");
            const unsigned og = xb_add(&bar[XB_TOP], 1u);
            const unsigned tg = og / nx;
            if (og + 1u == (tg + 1u) * nx) xb_add(&bar[XB_TOPGEN], 1u);
            else XB_SPIN(xb_ld(&bar[XB_TOPGEN]) == tg, bar);
            __builtin_amdgcn_fence(__ATOMIC_ACQUIRE, "agent");
            xb_add(&bar[XB_XGEN(b.x)], 1u);
            asm volatile("s_waitcnt vmcnt(0)" ::: "memory");
        } else {
            XB_SPIN(xb_ld(&bar[XB_XGEN(b.x)]) == gen, bar);
            __builtin_amdgcn_fence(__ATOMIC_ACQUIRE, "agent");
            asm volatile("s_waitcnt vmcnt(0)" ::: "memory");
        }
    }
    __syncthreads();
}
struct Args { const float* in[21]; float* out; unsigned char* ws; int ph_lo, ph_hi, li, pad; };
struct Frame {
    LAS unsigned char* lds;
    volatile LAS unsigned* MISC;
    gu32* ctl;
    int tid, lane, wave, G, bid;
    float* out; unsigned char* ws;
};
__device__ __forceinline__ float wave_sum(float v) {
#pragma unroll
    for (int o = 1; o < 64; o <<= 1) v += __shfl_xor(v, o);
    return v;
}
__device__ __forceinline__ float silu(float x) { return x / (1.0f + __expf(-x)); }
__device__ __forceinline__ int crow(int r, int hi) { return (r & 3) + 8 * (r >> 2) + 4 * hi; }

__device__ __forceinline__ void p0_transpose_item(const float* W, int K, int N, bf16* WT, LAS float* scr, int item, int lane) {
    const int nblk = N / 32, kb = item / nblk, nb = item % nblk, k0 = 64 * kb, n0 = 32 * nb;
#pragma unroll 8
    for (int i = 0; i < 32; ++i) { const int kk = 2 * i + (lane >> 5); scr[kk * 33 + (lane & 31)] = W[(size_t)(k0 + kk) * N + n0 + (lane & 31)]; }
    LDS_WAIT(); asm volatile("" ::: "memory");
    const int c = lane & 7;
#pragma unroll
    for (int j = 0; j < 4; ++j) { const int n = (lane >> 3) + 8 * j; const LAS float* s = scr + (8 * c) * 33 + n;
        v4u o; o.x = pk2(s[0 * 33], s[1 * 33]); o.y = pk2(s[2 * 33], s[3 * 33]); o.z = pk2(s[4 * 33], s[5 * 33]); o.w = pk2(s[6 * 33], s[7 * 33]);
        *(GAS v4u*)(WT + (size_t)(n0 + n) * K + k0 + 8 * c) = o; }
    LDS_WAIT(); asm volatile("" ::: "memory");
}
__device__ __forceinline__ const float* xrow_in(const Args& A, int m) { return m < MP ? A.in[0] + (size_t)m * DM : A.in[1] + (size_t)(m - MP) * DM; }

__device__ __forceinline__ void norm_row_to_bf16(const float* xr, const float* g, bf16* orow, int lane) {
    const GAS f32x4* xp = (const GAS f32x4*)xr + lane; const GAS f32x4* gp = (const GAS f32x4*)g + lane;
    f32x4 v[8]; float s = 0.f;
#pragma unroll
    for (int j = 0; j < 8; ++j) { v[j] = xp[64 * j]; s += (v[j].x * v[j].x + v[j].y * v[j].y) + (v[j].z * v[j].z + v[j].w * v[j].w); }
    const float rinv = 1.0f / sqrtf(wave_sum(s) * (1.0f / DM) + EPS);
    GAS v2u* o8 = (GAS v2u*)orow + lane;
#pragma unroll
    for (int j = 0; j < 8; ++j) { const f32x4 gg = gp[64 * j]; v2u w; w.x = pk2(v[j].x * rinv * gg.x, v[j].y * rinv * gg.y); w.y = pk2(v[j].z * rinv * gg.z, v[j].w * rinv * gg.w); o8[64 * j] = w; }
}
__device__ __forceinline__ void resid_norm_row(const float* yr, const float* xi, const float* g1, float* xo, const float* g2, bf16* hrow, int lane) {
    const GAS f32x4* yp = (const GAS f32x4*)yr + lane; const GAS f32x4* xp = (const GAS f32x4*)xi + lane; const GAS f32x4* gp = (const GAS f32x4*)g1 + lane;
    f32x4 v[8]; float s = 0.f;
#pragma unroll
    for (int j = 0; j < 8; ++j) { v[j] = yp[64 * j]; s += (v[j].x * v[j].x + v[j].y * v[j].y) + (v[j].z * v[j].z + v[j].w * v[j].w); }
    const float rinv = 1.0f / sqrtf(wave_sum(s) * (1.0f / DM) + EPS);
    float s2 = 0.f; GAS f32x4* op = (GAS f32x4*)xo + lane;
#pragma unroll
    for (int j = 0; j < 8; ++j) { const f32x4 gg = gp[64 * j], xx = xp[64 * j]; f32x4 r;
        r.x = xx.x + v[j].x * rinv * gg.x; r.y = xx.y + v[j].y * rinv * gg.y; r.z = xx.z + v[j].z * rinv * gg.z; r.w = xx.w + v[j].w * rinv * gg.w;
        v[j] = r; op[64 * j] = r; s2 += (r.x * r.x + r.y * r.y) + (r.z * r.z + r.w * r.w); }
    if (g2 != nullptr) {
        const float rinv2 = 1.0f / sqrtf(wave_sum(s2) * (1.0f / DM) + EPS);
        const GAS f32x4* g2p = (const GAS f32x4*)g2 + lane; GAS v2u* o8 = (GAS v2u*)hrow + lane;
#pragma unroll
        for (int j = 0; j < 8; ++j) { const f32x4 gg = g2p[64 * j]; v2u w; w.x = pk2(v[j].x * rinv2 * gg.x, v[j].y * rinv2 * gg.y); w.y = pk2(v[j].z * rinv2 * gg.z, v[j].w * rinv2 * gg.w); o8[64 * j] = w; }
    }
}
__device__ __forceinline__ void convert_cache(const Frame& F, const Args& A, int l) {
    const size_t n8 = (size_t)16 * PAST * 1024 / 8;
    const float* ck = A.in[4] + (size_t)l * 16 * PAST * 1024; const float* cv = A.in[5] + (size_t)l * 16 * PAST * 1024;
    bf16* ok = (bf16*)(F.ws + WS_CK); bf16* ov = (bf16*)(F.ws + WS_CV);
    for (size_t i = (size_t)F.bid * 512 + F.tid; i < 2 * n8; i += (size_t)F.G * 512) {
        const bool isk = i < n8; const size_t j = isk ? i : i - n8;
        const f32x4 a = *(const GAS f32x4*)((isk ? ck : cv) + j * 8), b = *(const GAS f32x4*)((isk ? ck : cv) + j * 8 + 4);
        v4u w; w.x = pk2(a.x, a.y); w.y = pk2(a.z, a.w); w.z = pk2(b.x, b.y); w.w = pk2(b.z, b.w);
        *(GAS v4u*)((isk ? ok : ov) + j * 8) = w;
    }
}
__device__ __forceinline__ void phase_prologue(Frame& F, const Args& A) {
    LAS float* scr = (LAS float*)(F.lds + RING_OFF + F.wave * 16384);
    const int gw = F.bid * NWAVES + F.wave, NGW = F.G * NWAVES;
    constexpr int I_IN = (DM / 64) * (NIN / 32), I_OUT = (DM / 64) * (DM / 32), I_UP = (DM / 64) * (DFF / 32), I_DN = (DFF / 64) * (DM / 32);
    constexpr int I_L = I_IN + I_OUT + I_UP + I_DN;
    for (int it = gw; it < DEPTH * I_L; it += NGW) {
        const int l = it / I_L; int r = it % I_L;
        if (r < I_IN) { p0_transpose_item(A.in[6] + (size_t)l * DM * NIN, DM, NIN, (bf16*)(F.ws + WS_WIN + l * WIN_BYTES), scr, r, F.lane); continue; } r -= I_IN;
        if (r < I_OUT) { p0_transpose_item(A.in[7] + (size_t)l * DM * DM, DM, DM, (bf16*)(F.ws + WS_WOUT + l * WOUT_BYTES), scr, r, F.lane); continue; } r -= I_OUT;
        if (r < I_UP) { p0_transpose_item(A.in[8] + (size_t)l * DM * DFF, DM, DFF, (bf16*)(F.ws + WS_WUP + l * WUP_BYTES), scr, r, F.lane); continue; } r -= I_UP;
        p0_transpose_item(A.in[9] + (size_t)l * DFF * DM, DFF, DM, (bf16*)(F.ws + WS_WDN + l * WDN_BYTES), scr, r, F.lane);
    }
    float* rot = (float*)(F.ws + WS_ROT);
    for (int i = F.bid * 512 + F.tid; i < SEQ * 32; i += F.G * 512) {
        const int pos = i >> 5, k = i & 31;
        const double inv = exp(-((double)k / 31.0) * 9.210340371976184);
        double a = (double)pos * inv; a -= 6.283185307179586 * rint(a / 6.283185307179586);
        rot[pos * 64 + k] = (float)cos(a); rot[pos * 64 + 32 + k] = (float)sin(a);
    }
    if (F.bid == 0) {
        float* sc = (float*)(F.ws + WS_SCAL);
        if (F.wave < DEPTH) {
            const int l = F.wave;
            float a = A.in[16][l * 128 + F.lane] * A.in[17][l * 128 + F.lane] + A.in[16][l * 128 + 64 + F.lane] * A.in[17][l * 128 + 64 + F.lane];
            float b = A.in[18][l * 128 + F.lane] * A.in[19][l * 128 + F.lane] + A.in[18][l * 128 + 64 + F.lane] * A.in[19][l * 128 + 64 + F.lane];
            a = wave_sum(a); b = wave_sum(b);
            const float lam_init = 0.8f - 0.6f * expf(-0.3f * (float)l);
            if (F.lane == 0) sc[l] = expf(a) - expf(b) + lam_init;
        }
        { const float l0 = A.in[14][F.tid], l1 = A.in[14][512 + F.tid]; sc[16 + F.tid] = 1.0f / (1.0f + expf(l0 - l1)); }
    }
    convert_cache(F, A, 0);
    for (int m = gw; m < M; m += NGW) norm_row_to_bf16(xrow_in(A, m), A.in[10], (bf16*)(F.ws + WS_H) + (size_t)m * DM, F.lane);
}

template <int K> __device__ __forceinline__ void mma_tile(f32x16& acc, const LAS unsigned char* A, int lda, const LAS unsigned char* B, int ldb, int lane) {
    const int r = lane & 31, h = lane >> 5;
#pragma unroll
    for (int k0 = 0; k0 < K; k0 += 16) {
        const bf16x8 a = *(const LAS bf16x8*)(A + r * lda + (k0 + 8 * h) * 2);
        const bf16x8 b = *(const LAS bf16x8*)(B + r * ldb + (k0 + 8 * h) * 2);
        acc = __builtin_amdgcn_mfma_f32_32x32x16_bf16(a, b, acc, 0, 0, 0);
    }
}
constexpr int LD128 = 272, LD64 = 144;
__device__ __forceinline__ float ret_log_gamma(int head) { return log1pf(-exp2f(-5.0f - (float)head)); }
__device__ __forceinline__ int chunk_pos0(int chunk) { return chunk < 256 ? (chunk & 127) * 64 : PAST; }

__device__ __forceinline__ void hgrn_state_unit(Frame& F, int chunk, int head) {
    LAS unsigned char* lds = F.lds; const int tid = F.tid, lane = F.lane, w = F.wave;
    LAS float* LG = (LAS float*)lds; LAS float* BC = (LAS float*)(lds + 32768);
    LAS unsigned char* KDT = lds + 65536; LAS unsigned char* VT = lds + 65536 + 128 * LD64;
    const int row0 = chunk * 64, unit = chunk * 4 + head;
    const float* logf = (const float*)(F.ws + WS_R1 + R1_LOGF); const bf16* AI = (const bf16*)(F.ws + WS_R1 + R1_AI);
    for (int i = tid; i < 64 * 32; i += 512) { const int t = i >> 5, c4 = i & 31;
        *(LAS f32x4*)(LG + t * 128 + c4 * 4) = *(const GAS f32x4*)(logf + (size_t)(row0 + t) * 512 + head * 128 + c4 * 4); }
    __syncthreads();
    if (tid < 128) { float a = 0.f; for (int t = 0; t < 64; ++t) { a += LG[t * 128 + tid]; BC[t * 128 + tid] = a; } }
    __syncthreads();
    for (int i = tid; i < 128 * 32; i += 512) { const int k = i & 127, sp = i >> 7;
        const float bt = BC[63 * 128 + k];
        const float k0 = -expm1f(LG[(2 * sp) * 128 + k]) * __expf(bt - BC[(2 * sp) * 128 + k]);
        const float k1 = -expm1f(LG[(2 * sp + 1) * 128 + k]) * __expf(bt - BC[(2 * sp + 1) * 128 + k]);
        *(LAS unsigned*)(KDT + k * LD64 + sp * 4) = pk2(k0, k1); }
    { const int sp = tid >> 4, vg = tid & 15;
      const bf16x8 a = *(const GAS bf16x8*)(AI + (size_t)(row0 + 2 * sp) * 512 + head * 128 + vg * 8), b = *(const GAS bf16x8*)(AI + (size_t)(row0 + 2 * sp + 1) * 512 + head * 128 + vg * 8);
#pragma unroll
      for (int e = 0; e < 8; ++e) *(LAS unsigned*)(VT + (vg * 8 + e) * LD64 + sp * 4) = (unsigned)(unsigned short)a[e] | ((unsigned)(unsigned short)b[e] << 16); }
    if (tid < 128) ((float*)(F.ws + WS_DEC))[unit * 128 + tid] = __expf(BC[63 * 128 + tid]);
    __syncthreads();
    const int vt = w >> 1, kt0 = (w & 1) * 2, r32 = lane & 31, hi = lane >> 5;
    f32x16 acc0 = {}, acc1 = {};
    mma_tile<64>(acc0, VT + vt * 32 * LD64, LD64, KDT + kt0 * 32 * LD64, LD64, lane);
    mma_tile<64>(acc1, VT + vt * 32 * LD64, LD64, KDT + (kt0 + 1) * 32 * LD64, LD64, lane);
    float* dst = (float*)(F.ws + WS_DSA) + (size_t)unit * 16384;
#pragma unroll
    for (int i = 0; i < 16; ++i) { const int v = vt * 32 + crow(i, hi); dst[v * 128 + kt0 * 32 + r32] = acc0[i]; dst[v * 128 + (kt0 + 1) * 32 + r32] = acc1[i]; }
    __syncthreads();
}
__device__ __forceinline__ void ret_state_unit(Frame& F, int chunk, int head) {
    LAS unsigned char* lds = F.lds; const int tid = F.tid, lane = F.lane, w = F.wave;
    LAS unsigned char* KDT = lds; LAS unsigned char* VT = lds + 64 * LD64;
    const int row0 = chunk * 64, unit = chunk * 4 + head, pos0 = chunk_pos0(chunk);
    const bf16* BK = (const bf16*)(F.ws + WS_R1 + R1_BK); const bf16* BV = (const bf16*)(F.ws + WS_R1 + R1_BV); const float* rot = (const float*)(F.ws + WS_ROT);
    const float lg = ret_log_gamma(head);
    for (int i = tid; i < 32 * 32; i += 512) { const int k = i & 31, sp = i >> 5;
        float o1[2], o2[2];
#pragma unroll
        for (int e = 0; e < 2; ++e) { const int s = 2 * sp + e; const bf16* kr = BK + (size_t)(row0 + s) * 256 + head * 64;
            const float x1 = bf2f(kr[k]), x2 = bf2f(kr[k + 32]), c = rot[(pos0 + s) * 64 + k], sn = rot[(pos0 + s) * 64 + 32 + k];
            const float tl = 0.125f * __expf((float)(63 - s) * lg);
            o1[e] = (x1 * c - x2 * sn) * tl; o2[e] = (x1 * sn + x2 * c) * tl; }
        *(LAS unsigned*)(KDT + k * LD64 + sp * 4) = pk2(o1[0], o1[1]); *(LAS unsigned*)(KDT + (k + 32) * LD64 + sp * 4) = pk2(o2[0], o2[1]); }
    { const int sp = tid >> 4, vg = tid & 15;
      const bf16x8 a = *(const GAS bf16x8*)(BV + (size_t)(row0 + 2 * sp) * 512 + head * 128 + vg * 8), b = *(const GAS bf16x8*)(BV + (size_t)(row0 + 2 * sp + 1) * 512 + head * 128 + vg * 8);
#pragma unroll
      for (int e = 0; e < 8; ++e) *(LAS unsigned*)(VT + (vg * 8 + e) * LD64 + sp * 4) = (unsigned)(unsigned short)a[e] | ((unsigned)(unsigned short)b[e] << 16); }
    __syncthreads();
    const int vt = w >> 1, kt = w & 1, r32 = lane & 31, hi = lane >> 5;
    f32x16 acc = {};
    mma_tile<64>(acc, VT + vt * 32 * LD64, LD64, KDT + kt * 32 * LD64, LD64, lane);
    float* dst = (float*)(F.ws + WS_DSB) + (size_t)unit * 8192;
#pragma unroll
    for (int i = 0; i < 16; ++i) { const int v = vt * 32 + crow(i, hi); dst[v * 64 + kt * 32 + r32] = acc[i]; }
    __syncthreads();
}
__device__ __forceinline__ void phase_scan(Frame& F, const Args& A, int l) {
    float* dsa = (float*)(F.ws + WS_DSA); float* dsb = (float*)(F.ws + WS_DSB); const float* dec = (const float*)(F.ws + WS_DEC);
    constexpr int NA_P = 2 * 4 * 16384, NB_P = 2 * 4 * 8192, NA_S = 16 * 4 * 16384, NB_S = 16 * 4 * 8192;
    const int nthr = F.G * 512;
    for (int e = F.bid * 512 + F.tid; e < NA_P + NB_P + NA_S + NB_S; e += nthr) {
        if (e < NA_P) {
            const int b = e >> 16, head = (e >> 14) & 3, idx = e & 16383, k = idx & 127, v = idx >> 7;
            float S = 0.f;
            for (int c0 = 0; c0 < 128; c0 += 8) {
                float t[8], d[8];
#pragma unroll
                for (int j = 0; j < 8; ++j) { const int unit = (b * 128 + c0 + j) * 4 + head; t[j] = dsa[(size_t)unit * 16384 + idx]; d[j] = dec[unit * 128 + k]; }
#pragma unroll
                for (int j = 0; j < 8; ++j) { const int unit = (b * 128 + c0 + j) * 4 + head; dsa[(size_t)unit * 16384 + idx] = S; S = d[j] * S + t[j]; }
            }
            F.out[O_HP + ((size_t)(l * 2 + b) * 4 + head) * 16384 + k * 128 + v] = S;
        } else if (e < NA_P + NB_P) {
            const int x = e - NA_P, b = x >> 15, head = (x >> 13) & 3, idx = x & 8191, k = idx & 63, v = idx >> 6;
            const float g64 = __expf(64.0f * ret_log_gamma(head));
            float S = 0.f;
            for (int c0 = 0; c0 < 128; c0 += 8) {
                float t[8];
#pragma unroll
                for (int j = 0; j < 8; ++j) { const int unit = (b * 128 + c0 + j) * 4 + head; t[j] = dsb[(size_t)unit * 8192 + idx]; }
#pragma unroll
                for (int j = 0; j < 8; ++j) { const int unit = (b * 128 + c0 + j) * 4 + head; dsb[(size_t)unit * 8192 + idx] = S; S = g64 * S + t[j]; }
            }
            F.out[O_RP + ((size_t)(l * 2 + b) * 4 + head) * 8192 + k * 128 + v] = S;
        } else if (e < NA_P + NB_P + NA_S) {
            const int x = e - NA_P - NB_P, seq = x >> 16, head = (x >> 14) & 3, idx = x & 16383, k = idx & 127, v = idx >> 7;
            const int unit = (256 + seq) * 4 + head;
            const size_t so = ((size_t)(l * 16 + seq) * 4 + head) * 16384 + k * 128 + v;
            const float S0 = A.in[2][so], t = dsa[(size_t)unit * 16384 + idx];
            dsa[(size_t)unit * 16384 + idx] = S0;
            F.out[O_HS + so] = dec[unit * 128 + k] * S0 + t;
        } else {
            const int x = e - NA_P - NB_P - NA_S, seq = x >> 15, head = (x >> 13) & 3, idx = x & 8191, k = idx & 63, v = idx >> 6;
            const int unit = (256 + seq) * 4 + head;
            const size_t so = ((size_t)(l * 16 + seq) * 4 + head) * 8192 + k * 128 + v;
            const float S0 = A.in[3][so], t = dsb[(size_t)unit * 8192 + idx];
            dsb[(size_t)unit * 8192 + idx] = S0;
            F.out[O_RS + so] = __expf(64.0f * ret_log_gamma(head)) * S0 + t;
        }
    }
}
__device__ __forceinline__ void mixer_out_rows(Frame& F, const LAS float* OT, int row0, const bf16* gate  , const float* gain  , int head, int mixcol0) {
    const int t = F.tid >> 3, j = F.tid & 7;
    f32x4 o[4]; float ss = 0.f;
#pragma unroll
    for (int q = 0; q < 4; ++q) { o[q] = *(const LAS f32x4*)(OT + t * 132 + j * 16 + q * 4); ss += (o[q].x * o[q].x + o[q].y * o[q].y) + (o[q].z * o[q].z + o[q].w * o[q].w); }
    ss += __shfl_xor(ss, 1); ss += __shfl_xor(ss, 2); ss += __shfl_xor(ss, 4);
    const float rinv = 1.0f / sqrtf(ss * (1.0f / 128.0f) + EPS);
    const bf16* gr = gate + (size_t)(row0 + t) * 512 + head * 128 + j * 16;
    const bf16x8 g0 = *(const GAS bf16x8*)gr, g1 = *(const GAS bf16x8*)(gr + 8);
    float r[16];
#pragma unroll
    for (int q = 0; q < 4; ++q) { r[4 * q] = o[q].x; r[4 * q + 1] = o[q].y; r[4 * q + 2] = o[q].z; r[4 * q + 3] = o[q].w; }
#pragma unroll
    for (int e = 0; e < 16; ++e) { const float gt = bf2f((unsigned short)(e < 8 ? g0[e] : g1[e - 8])); const float gn = gain ? gain[j * 16 + e] : 1.0f; r[e] = r[e] * rinv * gn * silu(gt); }
    bf16* mp = (bf16*)(F.ws + WS_R1 + R1_MIX) + (size_t)(row0 + t) * DM + mixcol0 + head * 128 + j * 16;
    v4u w0, w1; w0.x = pk2(r[0], r[1]); w0.y = pk2(r[2], r[3]); w0.z = pk2(r[4], r[5]); w0.w = pk2(r[6], r[7]); w1.x = pk2(r[8], r[9]); w1.y = pk2(r[10], r[11]); w1.z = pk2(r[12], r[13]); w1.w = pk2(r[14], r[15]);
    *(GAS v4u*)mp = w0; *(GAS v4u*)(mp + 8) = w1;
}
__device__ __forceinline__ void hgrn_out_unit(Frame& F, const Args& A, int l, int chunk, int head) {
    LAS unsigned char* lds = F.lds; const int tid = F.tid, lane = F.lane, w = F.wave;
    LAS float* LG = (LAS float*)lds; LAS float* BC = (LAS float*)(lds + 32768);
    LAS unsigned char* STS = lds; LAS unsigned char* P = lds + 128 * LD128; LAS unsigned char* VT = P + 64 * LD64;
    LAS unsigned char* QT = lds + 65536; LAS unsigned char* KT = QT + 64 * LD128; LAS unsigned char* QD = KT + 64 * LD128;
    LAS float* OT = (LAS float*)(lds + 65536);
    static_assert(128 * LD128 + 64 * LD64 + 128 * LD64 <= 65536 && 64 * 132 * 4 <= 2 * 64 * LD128 && 65536 + 3 * 64 * LD128 <= RING_BYTES, "hgrn_out LDS map");
    const int row0 = chunk * 64, unit = chunk * 4 + head;
    const float* logf = (const float*)(F.ws + WS_R1 + R1_LOGF); const bf16* AQ = (const bf16*)(F.ws + WS_R1 + R1_AQ); const bf16* AI = (const bf16*)(F.ws + WS_R1 + R1_AI);
    for (int i = tid; i < 64 * 32; i += 512) { const int t = i >> 5, c4 = i & 31;
        *(LAS f32x4*)(LG + t * 128 + c4 * 4) = *(const GAS f32x4*)(logf + (size_t)(row0 + t) * 512 + head * 128 + c4 * 4); }
    __syncthreads();
    if (tid < 128) { float a = 0.f; for (int t = 0; t < 64; ++t) { a += LG[t * 128 + tid]; BC[t * 128 + tid] = a; } }
    __syncthreads();
    for (int i = tid; i < 64 * 16; i += 512) { const int t = i >> 4, kg = i & 15;
        const bf16x8 q8 = *(const GAS bf16x8*)(AQ + (size_t)(row0 + t) * 512 + head * 128 + kg * 8);
        unsigned qt[4], kt[4], qd[4]; float a[2], b[2], c[2];
#pragma unroll
        for (int e = 0; e < 8; ++e) { const int k = kg * 8 + e; const float lf = LG[t * 128 + k], bc = BC[t * 128 + k], rf = BC[31 * 128 + k], q = bf2f((unsigned short)q8[e]);
            a[e & 1] = q * __expf(fminf(bc - rf, 80.f)); b[e & 1] = -expm1f(lf) * __expf(fminf(rf - bc, 80.f)); c[e & 1] = q * __expf(bc);
            if (e & 1) { qt[e >> 1] = pk2(a[0], a[1]); kt[e >> 1] = pk2(b[0], b[1]); qd[e >> 1] = pk2(c[0], c[1]); } }
        *(LAS v4u*)(QT + t * LD128 + kg * 16) = (v4u){qt[0], qt[1], qt[2], qt[3]}; *(LAS v4u*)(KT + t * LD128 + kg * 16) = (v4u){kt[0], kt[1], kt[2], kt[3]}; *(LAS v4u*)(QD + t * LD128 + kg * 16) = (v4u){qd[0], qd[1], qd[2], qd[3]}; }
    __syncthreads();
    { const float* src = (const float*)(F.ws + WS_DSA) + (size_t)unit * 16384;
      for (int i = tid; i < 128 * 32; i += 512) { const int v = i >> 5, c4 = i & 31; const f32x4 s = *(const GAS f32x4*)(src + v * 128 + c4 * 4);
          *(LAS v2u*)(STS + v * LD128 + c4 * 8) = (v2u){pk2(s.x, s.y), pk2(s.z, s.w)}; } }
    { const int sp = tid >> 4, vg = tid & 15;
      const bf16x8 a = *(const GAS bf16x8*)(AI + (size_t)(row0 + 2 * sp) * 512 + head * 128 + vg * 8), b = *(const GAS bf16x8*)(AI + (size_t)(row0 + 2 * sp + 1) * 512 + head * 128 + vg * 8);
#pragma unroll
      for (int e = 0; e < 8; ++e) *(LAS unsigned*)(VT + (vg * 8 + e) * LD64 + sp * 4) = (unsigned)(unsigned short)a[e] | ((unsigned)(unsigned short)b[e] << 16); }
    __syncthreads();
    const int r32 = lane & 31, hi = lane >> 5;
    if (w < 4) {
        const int tt = w >> 1, st = w & 1; f32x16 sc = {};
        if (!(tt == 0 && st == 1)) mma_tile<128>(sc, QT + tt * 32 * LD128, LD128, KT + st * 32 * LD128, LD128, lane);
#pragma unroll
        for (int i = 0; i < 16; ++i) { const int t = tt * 32 + crow(i, hi), s = st * 32 + r32; *(LAS unsigned short*)(P + t * LD64 + s * 2) = (unsigned short)f2bf(s <= t ? sc[i] : 0.f); }
    }
    const int tt = w >> 2, vt = w & 3; f32x16 acc = {};
    mma_tile<128>(acc, QD + tt * 32 * LD128, LD128, STS + vt * 32 * LD128, LD128, lane);
    __syncthreads();
    mma_tile<64>(acc, P + tt * 32 * LD64, LD64, VT + vt * 32 * LD64, LD64, lane);
    __syncthreads();
#pragma unroll
    for (int i = 0; i < 16; ++i) OT[(tt * 32 + crow(i, hi)) * 132 + vt * 32 + r32] = acc[i];
    __syncthreads();
    mixer_out_rows(F, OT, row0, (const bf16*)(F.ws + WS_R1 + R1_AG), A.in[15] + l * 128, head, 0);
    __syncthreads();
}
__device__ __forceinline__ void ret_out_unit(Frame& F, int chunk, int head) {
    LAS unsigned char* lds = F.lds; const int tid = F.tid, lane = F.lane, w = F.wave;
    LAS unsigned char* QT = lds; LAS unsigned char* KT = QT + 64 * LD64; LAS unsigned char* VT = KT + 64 * LD64; LAS unsigned char* STS = VT + 128 * LD64; LAS unsigned char* P = STS + 128 * LD64;
    LAS float* OT = (LAS float*)(lds + 65536);
    static_assert(3 * 64 * LD64 + 2 * 128 * LD64 <= 65536, "ret_out LDS map");
    const int row0 = chunk * 64, unit = chunk * 4 + head, pos0 = chunk_pos0(chunk);
    const bf16* BQ = (const bf16*)(F.ws + WS_R1 + R1_BQ); const bf16* BK = (const bf16*)(F.ws + WS_R1 + R1_BK); const bf16* BV = (const bf16*)(F.ws + WS_R1 + R1_BV);
    const float* rot = (const float*)(F.ws + WS_ROT);
    const float lg = ret_log_gamma(head);
    for (int i = tid; i < 64 * 32; i += 512) { const int k = i & 31, s = i >> 5;
        const bf16* qr = BQ + (size_t)(row0 + s) * 256 + head * 64; const bf16* kr = BK + (size_t)(row0 + s) * 256 + head * 64;
        const float c = rot[(pos0 + s) * 64 + k], sn = rot[(pos0 + s) * 64 + 32 + k];
        const float q1 = bf2f(qr[k]), q2 = bf2f(qr[k + 32]), k1 = bf2f(kr[k]), k2 = bf2f(kr[k + 32]);
        *(LAS unsigned short*)(QT + s * LD64 + k * 2) = (unsigned short)f2bf(q1 * c - q2 * sn); *(LAS unsigned short*)(QT + s * LD64 + (k + 32) * 2) = (unsigned short)f2bf(q1 * sn + q2 * c);
        *(LAS unsigned short*)(KT + s * LD64 + k * 2) = (unsigned short)f2bf(0.125f * (k1 * c - k2 * sn)); *(LAS unsigned short*)(KT + s * LD64 + (k + 32) * 2) = (unsigned short)f2bf(0.125f * (k1 * sn + k2 * c)); }
    { const float* src = (const float*)(F.ws + WS_DSB) + (size_t)unit * 8192;
      for (int i = tid; i < 128 * 16; i += 512) { const int v = i >> 4, c4 = i & 15; const f32x4 s = *(const GAS f32x4*)(src + v * 64 + c4 * 4);
          *(LAS v2u*)(STS + v * LD64 + c4 * 8) = (v2u){pk2(s.x, s.y), pk2(s.z, s.w)}; } }
    { const int sp = tid >> 4, vg = tid & 15;
      const bf16x8 a = *(const GAS bf16x8*)(BV + (size_t)(row0 + 2 * sp) * 512 + head * 128 + vg * 8), b = *(const GAS bf16x8*)(BV + (size_t)(row0 + 2 * sp + 1) * 512 + head * 128 + vg * 8);
#pragma unroll
      for (int e = 0; e < 8; ++e) *(LAS unsigned*)(VT + (vg * 8 + e) * LD64 + sp * 4) = (unsigned)(unsigned short)a[e] | ((unsigned)(unsigned short)b[e] << 16); }
    __syncthreads();
    const int r32 = lane & 31, hi = lane >> 5;
    if (w < 4) {
        const int tt = w >> 1, st = w & 1; f32x16 sc = {};
        if (!(tt == 0 && st == 1)) mma_tile<64>(sc, QT + tt * 32 * LD64, LD64, KT + st * 32 * LD64, LD64, lane);
#pragma unroll
        for (int i = 0; i < 16; ++i) { const int t = tt * 32 + crow(i, hi), s = st * 32 + r32; *(LAS unsigned short*)(P + t * LD64 + s * 2) = (unsigned short)f2bf(s <= t ? sc[i] * __expf((float)(t - s) * lg) : 0.f); }
    }
    const int tt = w >> 2, vt = w & 3; f32x16 acc = {};
    mma_tile<64>(acc, QT + tt * 32 * LD64, LD64, STS + vt * 32 * LD64, LD64, lane);
#pragma unroll
    for (int i = 0; i < 16; ++i) acc[i] *= __expf((float)(tt * 32 + crow(i, hi) + 1) * lg);
    __syncthreads();
    mma_tile<64>(acc, P + tt * 32 * LD64, LD64, VT + vt * 32 * LD64, LD64, lane);
#pragma unroll
    for (int i = 0; i < 16; ++i) OT[(tt * 32 + crow(i, hi)) * 132 + vt * 32 + r32] = acc[i];
    __syncthreads();
    mixer_out_rows(F, OT, row0, (const bf16*)(F.ws + WS_R1 + R1_BG), nullptr, head, 512);
    __syncthreads();
}
__device__ __forceinline__ void attn_prompt_unit(Frame& F, int hd32, int qb) {
    const int b = hd32 >> 4, h = (hd32 >> 2) & 3, c = (hd32 >> 1) & 1, vh = hd32 & 1;
    const bf16* CQ = (const bf16*)(F.ws + WS_R1 + R1_CQ); const bf16* CK = (const bf16*)(F.ws + WS_R1 + R1_CK); const bf16* CV = (const bf16*)(F.ws + WS_R1 + R1_CV);
    const size_t rb = (size_t)b * SEQ;
    att::KVSrc src; src.k0 = CK + rb * 1024 + h * 256 + c * 128; src.v0 = CV + rb * 1024 + h * 256 + vh * 128; src.k1 = src.k0; src.v1 = src.v0; src.nt0 = 4 * qb + 4; src.ntreal = 4 * qb + 4;
    const size_t qrow = rb + (size_t)qb * 256 + F.wave * 32;
    float* O = (float*)(F.ws + WS_Y) + qrow * 2048 + h * 512 + c * 256 + vh * 128;
    __syncthreads();
    att::attn_body(CQ + qrow * 1024 + h * 256 + c * 128, src, O, 4 * qb + 4, 4 * qb + (F.wave >> 1), (char*)F.lds);
}
__device__ __forceinline__ void attn_sample_unit(Frame& F, int x) {
    const int seq = x >> 4, h = (x >> 2) & 3, c = (x >> 1) & 1, vh = x & 1;
    const bf16* CQ = (const bf16*)(F.ws + WS_R1 + R1_CQ); const bf16* CK = (const bf16*)(F.ws + WS_R1 + R1_CK); const bf16* CV = (const bf16*)(F.ws + WS_R1 + R1_CV);
    const bf16* KC = (const bf16*)(F.ws + WS_CK); const bf16* VC = (const bf16*)(F.ws + WS_CV);
    const size_t rs = (size_t)MP + (size_t)seq * 64;
    att::KVSrc src; src.k0 = KC + (size_t)seq * PAST * 1024 + h * 256 + c * 128; src.v0 = VC + (size_t)seq * PAST * 1024 + h * 256 + vh * 128;
    src.k1 = CK + rs * 1024 + h * 256 + c * 128; src.v1 = CV + rs * 1024 + h * 256 + vh * 128; src.nt0 = PAST / 64; src.ntreal = PAST / 64 + 1;
    const size_t qrow = rs + (size_t)(F.wave & 1) * 32;
    float* O = (F.wave < 2) ? (float*)(F.ws + WS_Y) + qrow * 2048 + h * 512 + c * 256 + vh * 128 : nullptr;
    __syncthreads();
    att::attn_body(CQ + qrow * 1024 + h * 256 + c * 128, src, O, PAST / 64 + 2, PAST / 64, (char*)F.lds);
}
__device__ __forceinline__ void phase_combine(Frame& F, const Args& A, int l) {
    const int gw = F.bid * NWAVES + F.wave, NGW = F.G * NWAVES;
    const float lam = ((const float*)(F.ws + WS_SCAL))[l];
    const float post = 1.0f - (0.8f - 0.6f * expf(-0.3f * (float)l));
    const float* OP = (const float*)(F.ws + WS_Y); bf16* MIXp = (bf16*)(F.ws + WS_R1 + R1_MIX);
    const f32x4 g = *(const GAS f32x4*)(A.in[20] + l * 256 + F.lane * 4);
    for (int it = gw; it < M * 4; it += NGW) { const int m = it >> 2, h = it & 3;
        const float* p = OP + (size_t)m * 2048 + h * 512 + F.lane * 4;
        const f32x4 a = *(const GAS f32x4*)p, b = *(const GAS f32x4*)(p + 256);
        f32x4 d; d.x = a.x - lam * b.x; d.y = a.y - lam * b.y; d.z = a.z - lam * b.z; d.w = a.w - lam * b.w;
        const float ss = wave_sum((d.x * d.x + d.y * d.y) + (d.z * d.z + d.w * d.w));
        const float rinv = post / sqrtf(ss * (1.0f / 256.0f) + EPS);
        v2u w; w.x = pk2(d.x * rinv * g.x, d.y * rinv * g.y); w.y = pk2(d.z * rinv * g.z, d.w * rinv * g.w);
        *(GAS v2u*)(MIXp + (size_t)m * DM + 1024 + h * 256 + F.lane * 4) = w;
    }
}
__global__ void __launch_bounds__(NWAVES * 64, 2) mk_fwd(Args A) {
    extern __shared__ __attribute__((aligned(16))) unsigned char lds[];
    Frame F;
    F.lds = (LAS unsigned char*)lds;
    F.MISC = (volatile LAS unsigned*)(F.lds + MISC_OFF);
    F.tid = threadIdx.x; F.lane = F.tid & 63; F.wave = __builtin_amdgcn_readfirstlane(F.tid >> 6);
    F.G = gridDim.x; F.bid = blockIdx.x;
    F.ws = A.ws; F.out = A.out; F.ctl = (gu32*)(A.ws + WS_CTL);
    for (int u = F.tid; u < (LDS_BYTES - LDSCTL_OFF) / 4; u += NWAVES * 64) ((LAS unsigned*)(F.lds + LDSCTL_OFF))[u] = 0u;
    __syncthreads();
    XcdBarrier bar; bar.bar = (unsigned*)(F.ctl + CW_BAR); bar.x = 0; bar.st = nullptr;
    if (N_LAUNCHES == 1) bar = xcd_barrier_post((unsigned*)(F.ctl + CW_BAR), F.MISC + 8);
#define GRID_BAR() do { if (N_LAUNCHES == 1) xcd_barrier(bar); } while (0)
    const int lo = A.ph_lo, hi = A.ph_hi;
#ifndef PH_MASK
#define PH_MASK 0x1fff
#endif
#define EN(j) (((PH_MASK) >> (j)) & 1)
#define IN(k) (lo <= (k) && (k) < hi)
#define PHASE_BEGIN() do { int t_ = threadIdx.x; asm volatile("" : "+v"(t_)); F.tid = t_; F.lane = t_ & 63; F.wave = __builtin_amdgcn_readfirstlane(t_ >> 6); } while (0)
#define BOTH(k) (IN(k) && IN((k) + 1))
    bf16* Hb = (bf16*)(F.ws + WS_H); float* Yb = (float*)(F.ws + WS_Y); bf16* Ub = (bf16*)(F.ws + WS_R1); bf16* MIXb = (bf16*)(F.ws + WS_R1 + R1_MIX);

    if (EN(10) && IN(0)) { PHASE_BEGIN(); phase_prologue(F, A); if (BOTH(0)) GRID_BAR(); }

    for (int l = 0; l < DEPTH; ++l) {
        const int pb = 1 + l * PH_PER_LAYER;
        if (EN(0) && IN(pb + 0)) { PHASE_BEGIN();
            pg8::Gemm g{Hb, (const bf16*)(F.ws + WS_WIN + l * WIN_BYTES), M, NIN, DM}; pg8::StaticOrder S; S.init(M, NIN, F.G, F.bid);
            pg8::EpiInProj E;
            unsigned char* r1 = F.ws + WS_R1;
            E.d.aq = (bf16*)(r1 + R1_AQ); E.d.ai = (bf16*)(r1 + R1_AI); E.d.ag = (bf16*)(r1 + R1_AG); E.d.bq = (bf16*)(r1 + R1_BQ); E.d.bk = (bf16*)(r1 + R1_BK);
            E.d.bv = (bf16*)(r1 + R1_BV); E.d.bg = (bf16*)(r1 + R1_BG); E.d.cq = (bf16*)(r1 + R1_CQ); E.d.ck = (bf16*)(r1 + R1_CK); E.d.cv = (bf16*)(r1 + R1_CV);
            E.d.logf = (float*)(r1 + R1_LOGF);
            E.d.kout_p = F.out + O_KP + (size_t)l * MP * 1024; E.d.kout_s = F.out + O_KS + (size_t)l * MS * 1024;
            E.d.vout_p = F.out + O_VP + (size_t)l * MP * 1024; E.d.vout_s = F.out + O_VS + (size_t)l * MS * 1024;
            E.d.lb = (const float*)(F.ws + WS_SCAL) + 16; E.d.first = (l == 0) ? 1 : 0; E.d.pad = 0;
            pg8::gemm_phase<pg8::EpiInProj, pg8::StaticOrder, true, true>(F.lds + RING_OFF, g, S, E);
            if (BOTH(pb + 0)) GRID_BAR();
        }
        if (EN(1) && IN(pb + 1)) { PHASE_BEGIN();
            for (int u = F.bid; u < 2 * NCHUNK * 4; u += F.G) {
                const int r = u % (NCHUNK * 4);
                if (u < NCHUNK * 4) hgrn_state_unit(F, r >> 2, r & 3); else ret_state_unit(F, r >> 2, r & 3);
            }
            if (BOTH(pb + 1)) GRID_BAR();
        }
        if (EN(2) && IN(pb + 2)) { PHASE_BEGIN(); phase_scan(F, A, l); if (BOTH(pb + 2)) GRID_BAR(); }
        if (EN(3) && IN(pb + 3)) { PHASE_BEGIN();
            if (EN(11)) for (int u = F.bid; u < 2 * NCHUNK * 4; u += F.G) {
                const int r = u % (NCHUNK * 4);
                if (u < NCHUNK * 4) hgrn_out_unit(F, A, l, r >> 2, r & 3); else ret_out_unit(F, r >> 2, r & 3);
            }
            if (EN(12)) for (int it = F.bid; it < 512 + 256; it += F.G) {
                if (it < 512) { const int hd32 = it >> 4, pr = it & 15; attn_prompt_unit(F, hd32, 31 - pr); attn_prompt_unit(F, hd32, pr); }
                else attn_sample_unit(F, it - 512);
            }
            if (BOTH(pb + 3)) GRID_BAR();
        }
        if (EN(4) && IN(pb + 4)) { PHASE_BEGIN(); phase_combine(F, A, l); if (BOTH(pb + 4)) GRID_BAR(); }
        if (EN(5) && IN(pb + 5)) { PHASE_BEGIN();
            pg8::Gemm g{MIXb, (const bf16*)(F.ws + WS_WOUT + l * WOUT_BYTES), M, DM, DM}; pg8::StaticOrder S; S.init(M, DM, F.G, F.bid);
            pg8::EpiF32 E{Yb, DM};
            pg8::gemm_phase<pg8::EpiF32, pg8::StaticOrder, true, true>(F.lds + RING_OFF, g, S, E);
            if (BOTH(pb + 5)) GRID_BAR();
        }
        if (EN(6) && IN(pb + 6)) { PHASE_BEGIN();
            const int gw = F.bid * NWAVES + F.wave, NGW = F.G * NWAVES;
            for (int m = gw; m < M; m += NGW) {
                const float* xi = (l == 0) ? xrow_in(A, m) : F.out + (size_t)m * DM;
                resid_norm_row(Yb + (size_t)m * DM, xi, A.in[11] + l * DM, F.out + (size_t)m * DM, A.in[12] + l * DM, Hb + (size_t)m * DM, F.lane);
            }
            if (BOTH(pb + 6)) GRID_BAR();
        }
        if (EN(7) && IN(pb + 7)) { PHASE_BEGIN();
            pg8::Gemm g{Hb, (const bf16*)(F.ws + WS_WUP + l * WUP_BYTES), M, DFF, DM}; pg8::StaticOrder S; S.init(M, DFF, F.G, F.bid);
            pg8::EpiRelu2 E{Ub, DFF};
            pg8::gemm_phase<pg8::EpiRelu2, pg8::StaticOrder, true, true>(F.lds + RING_OFF, g, S, E);
            if (BOTH(pb + 7)) GRID_BAR();
        }
        if (EN(8) && IN(pb + 8)) { PHASE_BEGIN();
            pg8::Gemm g{Ub, (const bf16*)(F.ws + WS_WDN + l * WDN_BYTES), M, DM, DFF}; pg8::StaticOrder S; S.init(M, DM, F.G, F.bid);
            pg8::EpiF32 E{Yb, DM};
            pg8::gemm_phase<pg8::EpiF32, pg8::StaticOrder, true, true>(F.lds + RING_OFF, g, S, E);
            if (BOTH(pb + 8)) GRID_BAR();
        }
        if (EN(9) && IN(pb + 9)) { PHASE_BEGIN();
            const bool last = (l == DEPTH - 1); const int gw = F.bid * NWAVES + F.wave, NGW = F.G * NWAVES;
            for (int m = gw; m < M; m += NGW)
                resid_norm_row(Yb + (size_t)m * DM, F.out + (size_t)m * DM, A.in[13] + l * DM, F.out + (size_t)m * DM, last ? nullptr : A.in[10] + (l + 1) * DM, Hb + (size_t)m * DM, F.lane);
            if (!last) convert_cache(F, A, l + 1);
            if (BOTH(pb + 9)) GRID_BAR();
        }
    }
#undef IN
#undef BOTH
#undef GRID_BAR
}

extern "C" void kernel_launch(void* const* d_in, const int* in_sizes, int n_in, void* d_out, int out_size, void* d_ws, size_t ws_size, hipStream_t stream) {
    static int grid = 0;
    if (grid == 0) {
        if (n_in != 21 || (size_t)out_size != O_END || ws_size < WS_END) { fprintf(stderr, "kernel_launch: shape mismatch: n_in %d out %d ws %zu (need %zu)\n", n_in, out_size, ws_size, (size_t)WS_END); grid = -1; return; }
        int dev = 0, cus = 0, per_cu = 0;
        if (hipGetDevice(&dev) != hipSuccess || hipDeviceGetAttribute(&cus, hipDeviceAttributeMultiprocessorCount, dev) != hipSuccess) { grid = -1; return; }
        if (hipFuncSetAttribute((const void*)mk_fwd, hipFuncAttributeMaxDynamicSharedMemorySize, LDS_BYTES) != hipSuccess) { fprintf(stderr, "kernel_launch: hipFuncSetAttribute failed\n"); grid = -1; return; }
        if (hipOccupancyMaxActiveBlocksPerMultiprocessor(&per_cu, (const void*)mk_fwd, NWAVES * 64, LDS_BYTES) != hipSuccess || per_cu < 1)
            fprintf(stderr, "kernel_launch: note: occupancy query reports %d workgroups per CU\n", per_cu);
        (void)hipGetLastError();
        grid = cus;
    }
    if (grid < 0) return;
    if (hipMemsetAsync((char*)d_ws + WS_CTL, 0, CTL_ZERO_BYTES, stream) != hipSuccess) return;
    Args a{};
    for (int i = 0; i < 21; ++i) a.in[i] = (const float*)d_in[i];
    a.out = (float*)d_out; a.ws = (unsigned char*)d_ws; a.pad = 0;
    for (int li = 0; li < N_LAUNCHES; ++li) {
        a.ph_lo = (N_LAUNCHES == 1) ? 0 : li; a.ph_hi = (N_LAUNCHES == 1) ? NPHASE : li + 1; a.li = li;
        hipLaunchKernelGGL(mk_fwd, dim3(grid), dim3(NWAVES * 64), LDS_BYTES, stream, a);
        const hipError_t le = hipPeekAtLastError();
        if (le != hipSuccess) { fprintf(stderr, "kernel_launch: launch %d failed: %s\n", li, hipGetErrorName(le)); break; }
    }
}
```

```cpp
#include <hip/hip_runtime.h>
#include <cstdio>
#include <cstdint>
namespace pg8 {
#define PG8_LAS __attribute__((address_space(3)))
typedef unsigned short bf16_t;
typedef short bf16x8 __attribute__((ext_vector_type(8)));
typedef float f32x4 __attribute__((ext_vector_type(4)));
typedef unsigned u32x4 __attribute__((ext_vector_type(4)));
constexpr int BM = 256, BK = 64, HALF = 128, HTB = HALF * BK * 2  , STAGE_BYTES = 8 * HTB, NXCD = 8, WGM = 8;

__host__ __device__ __forceinline__ int lds_byte(int r, int c) { const int st = (r >> 4) * 2 + (c >> 5), rr = r & 15, cc = c & 31, ob = rr * 64 + cc * 2; return st * 1024 + (ob ^ (((ob >> 9) & 1) << 5)); }
__host__ __device__ __forceinline__ void stage_rc(int b, int& R, int& C) { const int st = b / 1024, sb = b % 1024, swz = sb ^ (((sb >> 9) & 1) << 5); R = (st >> 1) * 16 + swz / 64; C = (st & 1) * 32 + (swz % 64) / 2; }
__host__ __device__ __forceinline__ int perm32(int rho) { const int n = rho >> 4, i = rho & 15; return 8 * (i >> 2) + 4 * n + (i & 3); }

struct Unit { int pm, pn; };
struct Gemm { const bf16_t* A; const bf16_t* Bt; int M, N, K; };

struct StaticOrder {
    int nM, nN, nwg, G, c;
    __host__ __device__ void init(int M, int N, int G_, int c_) { nM = M / BM; nN = N / BM; nwg = nM * nN; G = G_; c = c_; }
    __host__ __device__ bool next(int i, Unit& u) const {
        const long L = (long)i * G + c; if (L >= nwg) return false;
        int wgid = (int)L; { const int q = nwg / NXCD, r = nwg % NXCD, xcd = wgid % NXCD, off = wgid / NXCD; wgid = (xcd < r ? xcd * (q + 1) : r * (q + 1) + (xcd - r) * q) + off; }
        const int nig = WGM * nN, gid = wgid / nig, fm = gid * WGM, gsz = (nM - fm) < WGM ? (nM - fm) : WGM;
        u.pm = fm + ((wgid % nig) % gsz); u.pn = (wgid % nig) / gsz; return true;
    }
    __device__ __forceinline__ void a_ready(const Unit&) const {}
    __device__ __forceinline__ void done(const Unit&) const {}
};

__device__ __forceinline__ unsigned cvt_pk_bf16(float lo, float hi) { unsigned r; asm volatile("v_cvt_pk_bf16_f32 %0, %1, %2" : "=v"(r) : "v"(lo), "v"(hi)); return r; }
typedef float f32x2 __attribute__((ext_vector_type(2)));
constexpr int EP_MP = 16384;
struct InProjDst {
    bf16_t *aq, *ai, *ag, *bq, *bk, *bv, *bg, *cq, *ck, *cv; float* logf;
    float *kout_p, *kout_s, *vout_p, *vout_s;
    const float* lb;
    int first, pad;
};
__device__ __forceinline__ float silu_f(float x) { return x / (1.0f + __expf(-x)); }
__device__ __forceinline__ float hgrn_logf(float z, float lb, int first) {
    const float e = __expf(-fabsf(z)), ope = 1.0f + e;
    if (first) return fminf(z, 0.f) - __logf(ope);
    const float sig = (z >= 0.f ? 1.0f : e) / ope;
    return __logf(lb + (1.0f - lb) * sig);
}
struct EpiInProj {
    static constexpr bool PERM = true, AFTER_DRAIN = false;
    InProjDst d;
    __device__ __forceinline__ void operator()(const f32x4 (&acc)[2][2][4][2], const Unit& u, int wr, int wc, int fr, int fq) const {
        const int pn = u.pn, row0 = u.pm * BM + wr * 64 + fr, cw = wc * 32 + 8 * fq;
        bf16_t* dst = nullptr; float* fdst = nullptr; int ld = 512, c0 = 0, mode = 0;
        const bool samp = u.pm >= (EP_MP / BM);
        if (pn < 2)        { dst = d.aq; ld = 512;  c0 = pn * 256;        mode = 1; }
        else if (pn < 4)   {             ld = 512;  c0 = (pn - 2) * 256;  mode = 2; }
        else if (pn < 6)   { dst = d.ai; ld = 512;  c0 = (pn - 4) * 256; }
        else if (pn < 8)   { dst = d.ag; ld = 512;  c0 = (pn - 6) * 256; }
        else if (pn == 8)  { dst = d.bq; ld = 256;  c0 = 0; }
        else if (pn == 9)  { dst = d.bk; ld = 256;  c0 = 0; }
        else if (pn < 12)  { dst = d.bv; ld = 512;  c0 = (pn - 10) * 256; }
        else if (pn < 14)  { dst = d.bg; ld = 512;  c0 = (pn - 12) * 256; }
        else if (pn < 18)  { dst = d.cq; ld = 1024; c0 = (pn - 14) * 256; }
        else if (pn < 22)  { dst = d.ck; ld = 1024; c0 = (pn - 18) * 256; mode = 3; fdst = samp ? d.kout_s : d.kout_p; }
        else               { dst = d.cv; ld = 1024; c0 = (pn - 22) * 256; mode = 3; fdst = samp ? d.vout_s : d.vout_p; }
        const int rsub = samp ? EP_MP : 0;
#pragma unroll
        for (int ai = 0; ai < 2; ++ai)
#pragma unroll
            for (int m = 0; m < 4; ++m) {
                const int row = row0 + ai * HALF + m * 16;
#pragma unroll
                for (int bj = 0; bj < 2; ++bj) {
                    const int col = c0 + cw + bj * HALF;
                    f32x4 v0 = acc[ai][bj][m][0], v1 = acc[ai][bj][m][1];
                    if (mode == 2) {
                        f32x4 l0 = {0.f, 0.f, 0.f, 0.f}, l1 = {0.f, 0.f, 0.f, 0.f};
                        if (!d.first) { l0 = *(const f32x4*)(d.lb + col); l1 = *(const f32x4*)(d.lb + col + 4); }
                        f32x4 o0, o1;
#pragma unroll
                        for (int e = 0; e < 4; ++e) { o0[e] = hgrn_logf(v0[e], l0[e], d.first); o1[e] = hgrn_logf(v1[e], l1[e], d.first); }
                        float* p = d.logf + (size_t)row * 512 + col;
                        *(f32x4*)p = o0; *(f32x4*)(p + 4) = o1;
                    } else {
                        if (mode == 1) {
                            const float sc = 0.08838834764831845f;
#pragma unroll
                            for (int e = 0; e < 4; ++e) { v0[e] = silu_f(v0[e]) * sc; v1[e] = silu_f(v1[e]) * sc; }
                        }
                        if (mode == 3) { float* p = fdst + (size_t)(row - rsub) * 1024 + col; *(f32x4*)p = v0; *(f32x4*)(p + 4) = v1; }
                        u32x4 w; w.x = cvt_pk_bf16(v0[0], v0[1]); w.y = cvt_pk_bf16(v0[2], v0[3]); w.z = cvt_pk_bf16(v1[0], v1[1]); w.w = cvt_pk_bf16(v1[2], v1[3]);
                        *(u32x4*)(dst + (size_t)row * ld + col) = w;
                    }
                }
            }
    }
};
struct EpiF32 {
    static constexpr bool PERM = false, AFTER_DRAIN = false;
    float* O; int ldc;
    __device__ __forceinline__ void operator()(const f32x4 (&acc)[2][2][4][2], const Unit& u, int wr, int wc, int fr, int fq) const {
        const int row0 = u.pm * BM + wr * 64 + fr, col0 = u.pn * BM + wc * 32 + 4 * fq;
#pragma unroll
        for (int ai = 0; ai < 2; ++ai)
#pragma unroll
            for (int m = 0; m < 4; ++m) { float* rowp = O + (size_t)(row0 + ai * HALF + m * 16) * ldc + col0;
#pragma unroll
                for (int bj = 0; bj < 2; ++bj)
#pragma unroll
                    for (int n = 0; n < 2; ++n) *(f32x4*)(rowp + bj * HALF + n * 16) = acc[ai][bj][m][n]; }
    }
};
struct EpiRelu2 {
    static constexpr bool PERM = true, AFTER_DRAIN = false;
    bf16_t* O; int ldc;
    __device__ __forceinline__ void operator()(const f32x4 (&acc)[2][2][4][2], const Unit& u, int wr, int wc, int fr, int fq) const {
        const int row0 = u.pm * BM + wr * 64 + fr, col0 = u.pn * BM + wc * 32 + 8 * fq;
#pragma unroll
        for (int ai = 0; ai < 2; ++ai)
#pragma unroll
            for (int m = 0; m < 4; ++m) { bf16_t* rowp = O + (size_t)(row0 + ai * HALF + m * 16) * ldc + col0;
#pragma unroll
                for (int bj = 0; bj < 2; ++bj) { f32x4 v0 = acc[ai][bj][m][0], v1 = acc[ai][bj][m][1];
#pragma unroll
                    for (int e = 0; e < 4; ++e) { const float a = fmaxf(v0[e], 0.f), b = fmaxf(v1[e], 0.f); v0[e] = a * a; v1[e] = b * b; }
                    u32x4 w; w.x = cvt_pk_bf16(v0[0], v0[1]); w.y = cvt_pk_bf16(v0[2], v0[3]); w.z = cvt_pk_bf16(v1[0], v1[1]); w.w = cvt_pk_bf16(v1[2], v1[3]);
                    *(u32x4*)(rowp + bj * HALF) = w; } }
    }
};
template <class Epi, class Sched, bool ALIGN_EPI = false, bool SP2 = false>
__device__ __forceinline__ void gemm_phase(PG8_LAS unsigned char* lds, const Gemm g, const Sched& S, const Epi& E) {
    int tid_ = threadIdx.x; asm volatile("" : "+v"(tid_));
    const int tid = tid_, wid = __builtin_amdgcn_readfirstlane(tid >> 6), lane = tid & 63, wr = wid >> 2, wc = wid & 3, fr = lane & 15, fq = lane >> 4;
    const int K = g.K, nt = K / BK;
    unsigned voffA[2], voffB[2];
#pragma unroll
    for (int i = 0; i < 2; ++i) { int R, C; stage_rc(tid * 16 + i * 8192, R, C); const int Rb = Epi::PERM ? ((R & ~31) + perm32(R & 31)) : R;
        voffA[i] = (unsigned)(R * K + C) * 2u; voffB[i] = (unsigned)(Rb * K + C) * 2u; }
    const size_t kstep = (size_t)(BK * 2);
    const size_t hstep = (size_t)HALF * K * 2;
    const size_t tstep = 2 * hstep;
    const unsigned ldsw = (unsigned)wid * 1024u;
    const int aoff = lds_byte(wr * 64 + fr, fq * 8), boff = lds_byte(wc * 32 + fr, fq * 8);
#define PG8_SA(b, h) (((b) * 2 + (h)) * HTB)
#define PG8_SB(b, h) ((4 + (b) * 2 + (h)) * HTB)
#define PG8_STAGE(bufoff, gbase, voff) do { _Pragma("unroll") for (int _i = 0; _i < 2; ++_i) \
        __builtin_amdgcn_global_load_lds((const unsigned*)((const char*)(gbase) + (voff)[_i]), (PG8_LAS unsigned*)(lds + (bufoff) + ldsw + _i * 8192), 16, 0, 0); } while (0)
#define PG8_LDA(dst, b, h) do { _Pragma("unroll") for (int m = 0; m < 4; ++m) _Pragma("unroll") for (int k = 0; k < 2; ++k) dst[m][k] = *(const PG8_LAS bf16x8*)(lds + PG8_SA(b, h) + aoff + m * 2048 + k * 1024); } while (0)
#define PG8_LDB(dst, b, h) do { _Pragma("unroll") for (int n = 0; n < 2; ++n) _Pragma("unroll") for (int k = 0; k < 2; ++k) dst[n][k] = *(const PG8_LAS bf16x8*)(lds + PG8_SB(b, h) + boff + n * 2048 + k * 1024); } while (0)
#define PG8_MMA(ai, bj, At, Bt) do { __builtin_amdgcn_s_setprio(1); _Pragma("unroll") for (int m = 0; m < 4; ++m) _Pragma("unroll") for (int n = 0; n < 2; ++n) _Pragma("unroll") for (int k = 0; k < 2; ++k) \
        acc[ai][bj][m][n] = __builtin_amdgcn_mfma_f32_16x16x32_bf16(Bt[n][k], At[m][k], acc[ai][bj][m][n], 0, 0, 0); __builtin_amdgcn_s_setprio(0); } while (0)
#define PG8_WAIT_V(n) asm volatile("s_waitcnt vmcnt(" #n ")" ::: "memory")
#define PG8_WAIT_L(n) asm volatile("s_waitcnt lgkmcnt(" #n ")" ::: "memory")
#define PG8_BAR __builtin_amdgcn_s_barrier()
#define PG8_SCHED __builtin_amdgcn_sched_barrier(0)
    Unit cur, nxt; int ui = 0;
    if (!S.next(0, cur)) return;
    f32x4 acc[2][2][4][2];
#pragma unroll
    for (int a = 0; a < 2; ++a)
#pragma unroll
        for (int b = 0; b < 2; ++b)
#pragma unroll
            for (int m = 0; m < 4; ++m)
#pragma unroll
                for (int n = 0; n < 2; ++n) acc[a][b][m][n] = (f32x4){0.f, 0.f, 0.f, 0.f};
    bf16x8 At[4][2], B0[2][2], B1[2][2];
    const char* cA = (const char*)g.A + (size_t)cur.pm * tstep; const char* cB = (const char*)g.Bt + (size_t)cur.pn * tstep;
    S.a_ready(cur);
    if constexpr (SP2) {
        PG8_STAGE(PG8_SB(0, 0), cB, voffB); PG8_STAGE(PG8_SB(0, 1), cB + hstep, voffB); PG8_STAGE(PG8_SA(0, 0), cA, voffA); PG8_STAGE(PG8_SA(0, 1), cA + hstep, voffA);
        if (wr == 1) PG8_BAR;
        PG8_WAIT_V(2); PG8_BAR;
        PG8_STAGE(PG8_SB(1, 0), cB + kstep, voffB); PG8_STAGE(PG8_SA(1, 0), cA + kstep, voffA); PG8_STAGE(PG8_SB(1, 1), cB + hstep + kstep, voffB);
        PG8_WAIT_V(6); PG8_BAR;
    } else {
        PG8_STAGE(PG8_SB(0, 0), cB, voffB); PG8_STAGE(PG8_SA(0, 0), cA, voffA); PG8_STAGE(PG8_SB(0, 1), cB + hstep, voffB); PG8_STAGE(PG8_SA(0, 1), cA + hstep, voffA);
        if (wr == 1) PG8_BAR;
        PG8_WAIT_V(4); PG8_BAR;
        PG8_STAGE(PG8_SB(1, 0), cB + kstep, voffB); PG8_STAGE(PG8_SA(1, 0), cA + kstep, voffA); PG8_STAGE(PG8_SB(1, 1), cB + hstep + kstep, voffB);
        PG8_WAIT_V(6); PG8_BAR;
    }
    for (;;) {
        const bool has_next = S.next(ui + 1, nxt);
        const char* nA = has_next ? (const char*)g.A + (size_t)nxt.pm * tstep : cA; const char* nB = has_next ? (const char*)g.Bt + (size_t)nxt.pn * tstep : cB;
        for (int t = 0; t < nt; t += 2) {
            const bool last = (t == nt - 2);
            const char* a1 = cA + (size_t)(t + 1) * kstep;
            const char* a2 = last ? nA : cA + (size_t)(t + 2) * kstep; const char* b2 = last ? nB : cB + (size_t)(t + 2) * kstep;
            const char* a3 = a2 + kstep; const char* b3 = b2 + kstep;
            if (last && has_next) S.a_ready(nxt);
            if constexpr (SP2) {
            PG8_LDB(B0, 0, 0); PG8_LDB(B1, 0, 1); PG8_SCHED; PG8_LDA(At, 0, 0); PG8_STAGE(PG8_SA(1, 1), a1 + hstep, voffA);
            PG8_WAIT_V(8); PG8_WAIT_L(0); PG8_BAR; PG8_MMA(0, 0, At, B0); PG8_MMA(0, 1, At, B1); PG8_BAR; PG8_SCHED;
            PG8_LDA(At, 0, 1); PG8_STAGE(PG8_SB(0, 0), b2, voffB); PG8_STAGE(PG8_SB(0, 1), b2 + hstep, voffB); PG8_STAGE(PG8_SA(0, 0), a2, voffA);
            PG8_WAIT_V(8); PG8_WAIT_L(0); PG8_BAR; PG8_MMA(1, 0, At, B0); PG8_MMA(1, 1, At, B1); PG8_BAR; PG8_SCHED;
            PG8_LDB(B0, 1, 0); PG8_LDB(B1, 1, 1); PG8_SCHED; PG8_LDA(At, 1, 0); PG8_STAGE(PG8_SA(0, 1), a2 + hstep, voffA);
            PG8_WAIT_V(8); PG8_WAIT_L(0); PG8_BAR; PG8_MMA(0, 0, At, B0); PG8_MMA(0, 1, At, B1); PG8_BAR; PG8_SCHED;
            PG8_LDA(At, 1, 1); PG8_STAGE(PG8_SB(1, 0), b3, voffB); PG8_STAGE(PG8_SB(1, 1), b3 + hstep, voffB); PG8_STAGE(PG8_SA(1, 0), a3, voffA);
            PG8_WAIT_V(8); PG8_WAIT_L(0); PG8_BAR; PG8_MMA(1, 0, At, B0); PG8_MMA(1, 1, At, B1); PG8_BAR; PG8_SCHED;
            } else {
            PG8_LDB(B0, 0, 0); PG8_SCHED; PG8_LDA(At, 0, 0); PG8_STAGE(PG8_SA(1, 1), a1 + hstep, voffA);
            PG8_WAIT_L(8); PG8_BAR; PG8_WAIT_L(0); PG8_MMA(0, 0, At, B0); PG8_BAR; PG8_SCHED;
            PG8_LDB(B1, 0, 1); PG8_STAGE(PG8_SB(0, 0), b2, voffB);
            PG8_BAR; PG8_WAIT_L(0); PG8_MMA(0, 1, At, B1); PG8_BAR;
            PG8_LDA(At, 0, 1); PG8_STAGE(PG8_SA(0, 0), a2, voffA);
            PG8_BAR; PG8_WAIT_L(0); PG8_MMA(1, 0, At, B0); PG8_BAR; PG8_SCHED;
            PG8_STAGE(PG8_SB(0, 1), b2 + hstep, voffB);
            PG8_WAIT_V(6); PG8_BAR; PG8_MMA(1, 1, At, B1); PG8_BAR;
            PG8_LDB(B0, 1, 0); PG8_SCHED; PG8_LDA(At, 1, 0); PG8_STAGE(PG8_SA(0, 1), a2 + hstep, voffA);
            PG8_WAIT_L(8); PG8_BAR; PG8_WAIT_L(0); PG8_MMA(0, 0, At, B0); PG8_BAR; PG8_SCHED;
            PG8_LDB(B1, 1, 1); PG8_STAGE(PG8_SB(1, 0), b3, voffB);
            PG8_BAR; PG8_WAIT_L(0); PG8_MMA(0, 1, At, B1); PG8_BAR;
            PG8_LDA(At, 1, 1); PG8_STAGE(PG8_SA(1, 0), a3, voffA);
            PG8_BAR; PG8_WAIT_L(0); PG8_MMA(1, 0, At, B0); PG8_BAR; PG8_SCHED;
            PG8_STAGE(PG8_SB(1, 1), b3 + hstep, voffB);
            PG8_WAIT_V(6); PG8_BAR; PG8_MMA(1, 1, At, B1); PG8_BAR;
            }
        }
        if constexpr (ALIGN_EPI) { if (wr == 0) PG8_BAR; }
        if constexpr (!Epi::AFTER_DRAIN) { E(acc, cur, wr, wc, fr, fq); S.done(cur); }
        if (!has_next) break;
#pragma unroll
        for (int a = 0; a < 2; ++a)
#pragma unroll
            for (int b = 0; b < 2; ++b)
#pragma unroll
                for (int m = 0; m < 4; ++m)
#pragma unroll
                    for (int n = 0; n < 2; ++n) acc[a][b][m][n] = (f32x4){0.f, 0.f, 0.f, 0.f};
        cur = nxt; cA = nA; cB = nB; ++ui;
        if constexpr (ALIGN_EPI) { if (wr == 1) PG8_BAR; }
    }
    PG8_WAIT_V(0);
    if constexpr (!ALIGN_EPI) { if (wr == 0) PG8_BAR; }
    PG8_BAR;
    if constexpr (Epi::AFTER_DRAIN) { E.fused(acc, cur, wr, wc, fr, fq, lds, wid, lane); S.done(cur); }
#undef PG8_SA
#undef PG8_SB
#undef PG8_STAGE
#undef PG8_LDA
#undef PG8_LDB
#undef PG8_MMA
#undef PG8_WAIT_V
#undef PG8_WAIT_L
#undef PG8_BAR
#undef PG8_SCHED
}
}
namespace att {
typedef unsigned short bf16;
constexpr int   D = 128, NW = 8, QBLK = 32, KVBLK = 64;
constexpr float SCALE = 0.088388347648318440f;
constexpr float THR = 8.f;
constexpr int SDEPTH = 1;
constexpr int LDQ = 1024, LDK = 1024, LDO = 2048;
constexpr size_t SHM_V = KVBLK * D * 2, SHM_K = KVBLK * D * 2, SHM_ATTN = 2 * SHM_V + 2 * SHM_K + NW * 64 * 4;
using bf16x8 = __attribute__((ext_vector_type(8))) short;
using s16x4  = __attribute__((ext_vector_type(4))) short;
using f32x16 = __attribute__((ext_vector_type(16))) float;
using f32x8  = __attribute__((ext_vector_type(8))) float;
using u32x4  = __attribute__((ext_vector_type(4))) unsigned;
#define KSWZ(row, colB) ((row) * 256 + ((colB) ^ (((row) & 7) << 4)))
#define SBAR() __builtin_amdgcn_sched_barrier(0)
__device__ __forceinline__ int crow(int r, int hi) { return (r & 3) + 8 * (r >> 2) + 4 * hi; }
__device__ __forceinline__ unsigned cvtpk(float lo, float hi) {
  unsigned r; asm volatile("v_cvt_pk_bf16_f32 %0, %1, %2" : "=v"(r) : "v"(lo), "v"(hi)); return r;
}
template <typename TIn> struct Stage;
template <> struct Stage<bf16>  { using T = bf16x8;
  __device__ static __forceinline__ T ld8(const bf16* p) { return *reinterpret_cast<const bf16x8*>(p); }
  __device__ static __forceinline__ bf16x8 tobf(T x) { return x; } };
template <> struct Stage<float> { using T = f32x8;
  __device__ static __forceinline__ T ld8(const float* p) { return *reinterpret_cast<const f32x8*>(p); }
  __device__ static __forceinline__ bf16x8 tobf(T x) {
    u32x4 w = {cvtpk(x[0], x[1]), cvtpk(x[2], x[3]), cvtpk(x[4], x[5]), cvtpk(x[6], x[7])}; return *reinterpret_cast<bf16x8*>(&w); } };

__device__ __forceinline__ void partialSM(f32x16& p0, f32x16& p1, float& m_reg, float& mn, float& alpha) {
  constexpr float C = SCALE * 1.4426950408889634f;
  float pmax = p0[0]; for (int r = 1; r < 16; ++r) pmax = fmaxf(pmax, p0[r]); for (int r = 0; r < 16; ++r) pmax = fmaxf(pmax, p1[r]);
  { auto rr = __builtin_amdgcn_permlane32_swap(__float_as_uint(pmax), __float_as_uint(pmax), false, false);
    pmax = fmaxf(__uint_as_float(rr[0]), __uint_as_float(rr[1])); }
  if (__builtin_expect(__all(pmax - m_reg <= THR / SCALE), 1)) { mn = m_reg; alpha = 1.f; }
  else { mn = fmaxf(m_reg, pmax); alpha = __builtin_amdgcn_exp2f((m_reg - mn) * C); m_reg = mn; }
  float mnC = -mn * C;
  for (int r = 0; r < 16; ++r) p0[r] = fmaf(p0[r], C, mnC); for (int r = 0; r < 16; ++r) p1[r] = fmaf(p1[r], C, mnC);
  for (int r = 0; r < 16; ++r) p0[r] = __builtin_amdgcn_exp2f(p0[r]);
}
__device__ __forceinline__ void finishSM(f32x16& p0, f32x16& p1, float alpha, float& l_reg, bf16x8& pa0, bf16x8& pa1, bf16x8& pa2, bf16x8& pa3) {
  for (int r = 0; r < 16; ++r) p1[r] = __builtin_amdgcn_exp2f(p1[r]);
  float ps = 0; for (int r = 0; r < 16; ++r) ps += p0[r]; for (int r = 0; r < 16; ++r) ps += p1[r];
  { auto rr = __builtin_amdgcn_permlane32_swap(__float_as_uint(ps), __float_as_uint(ps), false, false);
    ps = __uint_as_float(rr[0]) + __uint_as_float(rr[1]); }
  l_reg = l_reg * alpha + ps;
#define PK4(P, BASE, OUT) do { unsigned a0 = cvtpk(P[BASE + 0], P[BASE + 1]), a1 = cvtpk(P[BASE + 2], P[BASE + 3]);   \
    unsigned b0 = cvtpk(P[BASE + 4], P[BASE + 5]), b1 = cvtpk(P[BASE + 6], P[BASE + 7]);                              \
    auto r0 = __builtin_amdgcn_permlane32_swap(a0, b0, false, false); auto r1 = __builtin_amdgcn_permlane32_swap(a1, b1, false, false); \
    u32x4 w = {r0[0], r1[0], r0[1], r1[1]}; OUT = *reinterpret_cast<bf16x8*>(&w); } while (0)
  PK4(p0, 0, pa0); PK4(p0, 8, pa1); PK4(p1, 0, pa2); PK4(p1, 8, pa3);
#undef PK4
}
__device__ __forceinline__ void qkt(f32x16& p0, f32x16& p1, const bf16* Ks, const bf16x8* qr, int r32, int hi) {
  p0 = f32x16{}; p1 = f32x16{};
  for (int d0 = 0; d0 < 8; ++d0) { int cb = (d0 * 16 + hi * 8) * 2;
    bf16x8 b0 = *reinterpret_cast<const bf16x8*>((const char*)Ks + KSWZ(r32, cb));
    bf16x8 b1 = *reinterpret_cast<const bf16x8*>((const char*)Ks + KSWZ(32 + r32, cb));
    p0 = __builtin_amdgcn_mfma_f32_32x32x16_bf16(b0, qr[d0], p0, 0, 0, 0);
    p1 = __builtin_amdgcn_mfma_f32_32x32x16_bf16(b1, qr[d0], p1, 0, 0, 0); }
}
__device__ __forceinline__ int v_st(int k, int c) { const int kk = (k & ~0xC) | ((k & 4) << 1) | ((k & 8) >> 1); return ((kk >> 3) * 4 + (c >> 5)) * 512 + ((kk & 7) * 32 + (c & 31)) * 2; }
__device__ __forceinline__ int v_rd_base(int lane) { return ((lane & 3) << 3) | (((lane >> 2) & 3) << 6) | (((lane >> 4) & 1) << 5) | (((lane >> 5) & 1) << 8); }
constexpr int v_rd_off(int d0, int ks, int half) { return d0 * 512 + ks * 4096 + half * 2048; }
template <int OFF> __device__ __forceinline__ s16x4 tr_read(int vb) {
  s16x4 r; asm volatile("ds_read_b64_tr_b16 %0, %1 offset:%2" : "=&v"(r) : "v"(vb), "i"(OFF) : "memory"); return r;
}
template <int D0> __device__ __forceinline__ void pv_one(f32x16& od, int vb, bf16x8 pa0, bf16x8 pa1, bf16x8 pa2, bf16x8 pa3) {
  const s16x4 l0 = tr_read<v_rd_off(D0, 0, 0)>(vb), h0 = tr_read<v_rd_off(D0, 0, 1)>(vb), l1 = tr_read<v_rd_off(D0, 1, 0)>(vb), h1 = tr_read<v_rd_off(D0, 1, 1)>(vb);
  const s16x4 l2 = tr_read<v_rd_off(D0, 2, 0)>(vb), h2 = tr_read<v_rd_off(D0, 2, 1)>(vb), l3 = tr_read<v_rd_off(D0, 3, 0)>(vb), h3 = tr_read<v_rd_off(D0, 3, 1)>(vb);
  asm volatile("s_waitcnt lgkmcnt(0)" ::: "memory"); SBAR();
#define PK(L, H) (bf16x8){L[0], L[1], L[2], L[3], H[0], H[1], H[2], H[3]}
  od = __builtin_amdgcn_mfma_f32_32x32x16_bf16(pa0, PK(l0, h0), od, 0, 0, 0);
  od = __builtin_amdgcn_mfma_f32_32x32x16_bf16(pa1, PK(l1, h1), od, 0, 0, 0);
  od = __builtin_amdgcn_mfma_f32_32x32x16_bf16(pa2, PK(l2, h2), od, 0, 0, 0);
  od = __builtin_amdgcn_mfma_f32_32x32x16_bf16(pa3, PK(l3, h3), od, 0, 0, 0);
#undef PK
}
__device__ __forceinline__ void pv_d0(f32x16* o, int vb, bf16x8 pa0, bf16x8 pa1, bf16x8 pa2, bf16x8 pa3) {
  pv_one<0>(o[0], vb, pa0, pa1, pa2, pa3); pv_one<1>(o[1], vb, pa0, pa1, pa2, pa3); pv_one<2>(o[2], vb, pa0, pa1, pa2, pa3); pv_one<3>(o[3], vb, pa0, pa1, pa2, pa3);
}

struct KVSrc { const bf16* k0; const bf16* v0; const bf16* k1; const bf16* v1; int nt0, ntreal; };
__device__ __forceinline__ void mask_tile(f32x16& p0, f32x16& p1) {
#pragma unroll
  for (int r = 0; r < 16; ++r) { p0[r] = -1e30f; p1[r] = -1e30f; }
}
__device__ __forceinline__ void attn_body(const bf16* __restrict__ Qwv, const KVSrc src, float* __restrict__ Owv, const int NT, const int lim, char* lds) {
  using St = Stage<bf16>;
  int tid_ = threadIdx.x; asm volatile("" : "+v"(tid_));
  const int tid = tid_, wid = tid >> 6, lane = tid & 63, r32 = lane & 31, hi = lane >> 5;
  bf16* V_lds = (bf16*)lds; bf16* K_lds = (bf16*)(lds + 2 * SHM_V);
  float* ws = (float*)(lds + 2 * SHM_V + 2 * SHM_K) + wid * 64; float* li_l = ws; float* al_l = ws + 32;
  float m_reg = -1e30f, l_reg = 0; f32x16 o[4] = {}; bf16x8 qr[8];
  const bf16* Qw = Qwv + (long)r32 * LDQ + hi * 8;
#pragma unroll
  for (int d0 = 0; d0 < 8; ++d0) qr[d0] = St::ld8(Qw + d0 * 16);
  const int sr = tid >> 4, sc = (tid & 15) * 8, vst0 = v_st(sr, sc), vst1 = v_st(32 + sr, sc);
  const int vb0 = (int)(uintptr_t)V_lds + v_rd_base(lane);
  struct { typename St::T vs0, vs1, ks0, ks1; } sr_[SDEPTH];
#define SLOAD(i, t) do { int tt_ = (t) < src.ntreal ? (t) : src.ntreal - 1; const bf16* kp_; const bf16* vp_; \
    if (tt_ < src.nt0) { kp_ = src.k0 + (long)tt_ * (KVBLK * LDK); vp_ = src.v0 + (long)tt_ * (KVBLK * LDK); } \
    else { kp_ = src.k1 + (long)(tt_ - src.nt0) * (KVBLK * LDK); vp_ = src.v1 + (long)(tt_ - src.nt0) * (KVBLK * LDK); } \
    sr_[i].vs0 = St::ld8(&vp_[(long)sr * LDK + sc]); sr_[i].vs1 = St::ld8(&vp_[(long)(32 + sr) * LDK + sc]); \
    sr_[i].ks0 = St::ld8(&kp_[(long)sr * LDK + sc]); sr_[i].ks1 = St::ld8(&kp_[(long)(32 + sr) * LDK + sc]); } while (0)
#define SWRITE(b, i) do { *(bf16x8*)((char*)V_lds + (b) * SHM_V + vst0) = St::tobf(sr_[i].vs0);          \
    *(bf16x8*)((char*)V_lds + (b) * SHM_V + vst1) = St::tobf(sr_[i].vs1); int kc = sc * 2;               \
    *(bf16x8*)((char*)K_lds + (b) * SHM_K + KSWZ(sr, kc)) = St::tobf(sr_[i].ks0);                       \
    *(bf16x8*)((char*)K_lds + (b) * SHM_K + KSWZ(32 + sr, kc)) = St::tobf(sr_[i].ks1); } while (0)
#define SWAIT() do { if constexpr (SDEPTH == 2) asm volatile("s_waitcnt vmcnt(4)" ::: "memory"); else asm volatile("s_waitcnt vmcnt(0)" ::: "memory"); } while (0)
#define RESC(a) do { if (__any((a) < 1.f)) { if (hi == 0) al_l[r32] = (a); asm volatile("s_waitcnt lgkmcnt(0)" ::: "memory"); \
    for (int d = 0; d < 4; ++d) for (int r = 0; r < 16; ++r) o[d][r] *= al_l[crow(r, hi)]; } } while (0)
  f32x16 pA0, pA1, pB0, pB1; float mnA, mnB, alA, alB; bf16x8 pa0, pa1, pa2, pa3;
  constexpr int SE = 0, SO = SDEPTH - 1;
  SLOAD(SE, 0); asm volatile("s_waitcnt vmcnt(0)" ::: "memory"); SWRITE(0, SE); __syncthreads();
  qkt(pA0, pA1, K_lds, qr, r32, hi); partialSM(pA0, pA1, m_reg, mnA, alA);
  SLOAD(SO, 1); if constexpr (SDEPTH == 2) { if (2 < NT) SLOAD(SE, 2); }
  SWAIT(); SWRITE(1, SO); __syncthreads();
  for (int j = 1; j + 1 < NT; j += 2) {
    SBAR(); qkt(pB0, pB1, (bf16*)((char*)K_lds + SHM_K), qr, r32, hi); if (j > lim) mask_tile(pB0, pB1);
    finishSM(pA0, pA1, alA, l_reg, pa0, pa1, pa2, pa3); SBAR();
    SLOAD(SO, j + SDEPTH); SBAR();
    pv_d0(o, vb0, pa0, pa1, pa2, pa3); partialSM(pB0, pB1, m_reg, mnB, alB);
    __syncthreads(); SWAIT(); SWRITE(0, SE);
    RESC(alB); __syncthreads();
    SBAR(); qkt(pA0, pA1, K_lds, qr, r32, hi); if (j + 1 > lim) mask_tile(pA0, pA1);
    finishSM(pB0, pB1, alB, l_reg, pa0, pa1, pa2, pa3); SBAR();
    if (SDEPTH == 1 || j + 3 < NT) SLOAD(SE, j + 1 + SDEPTH); SBAR();
    pv_d0(o, vb0 + (int)SHM_V, pa0, pa1, pa2, pa3); partialSM(pA0, pA1, m_reg, mnA, alA);
    __syncthreads(); SWAIT(); SWRITE(1, SO);
    RESC(alA); __syncthreads();
  }
  SBAR(); qkt(pB0, pB1, (bf16*)((char*)K_lds + SHM_K), qr, r32, hi); if (NT - 1 > lim) mask_tile(pB0, pB1);
  finishSM(pA0, pA1, alA, l_reg, pa0, pa1, pa2, pa3); SBAR();
  pv_d0(o, vb0, pa0, pa1, pa2, pa3); partialSM(pB0, pB1, m_reg, mnB, alB);
  __syncthreads(); RESC(alB);
  finishSM(pB0, pB1, alB, l_reg, pa0, pa1, pa2, pa3); SBAR();
  pv_d0(o, vb0 + (int)SHM_V, pa0, pa1, pa2, pa3);
  if (hi == 0) li_l[r32] = l_reg; asm volatile("s_waitcnt lgkmcnt(0)" ::: "memory");
  float rli[16];
#pragma unroll
  for (int r = 0; r < 16; ++r) rli[r] = __builtin_amdgcn_rcpf(li_l[crow(r, hi)]);
  if (Owv != nullptr) {
#pragma unroll
    for (int r = 0; r < 16; ++r) { int orow = crow(r, hi);
      for (int d0 = 0; d0 < 4; ++d0) Owv[(long)orow * LDO + d0 * 32 + r32] = o[d0][r] * rli[r]; }
  }
  asm volatile("s_waitcnt vmcnt(0)" ::: "memory");
#undef SLOAD
#undef SWRITE
#undef SWAIT
#undef RESC
}
#undef KSWZ
#undef SBAR
}
constexpr int NWAVES = 8;
#ifndef MK_N_LAUNCHES
#define MK_N_LAUNCHES 1
#endif
constexpr int DM = 2048, MP = 16384, MS = 1024, M = MP + MS, NIN = 6656, DFF = 8192, DEPTH = 2, SEQ = 8192, PAST = 2048;
constexpr int NCHUNK = M / 64;
constexpr float EPS = 1e-6f;
constexpr int PH_PER_LAYER = 10, NPHASE = 1 + DEPTH * PH_PER_LAYER;
constexpr int N_LAUNCHES = (MK_N_LAUNCHES == 1) ? 1 : NPHASE;
constexpr size_t O_YP = 0, O_YS = O_YP + (size_t)MP * DM, O_HP = O_YS + (size_t)MS * DM, O_HS = O_HP + (size_t)DEPTH * 2 * 4 * 128 * 128,
                 O_RP = O_HS + (size_t)DEPTH * 16 * 4 * 128 * 128, O_RS = O_RP + (size_t)DEPTH * 2 * 4 * 64 * 128, O_KP = O_RS + (size_t)DEPTH * 16 * 4 * 64 * 128,
                 O_KS = O_KP + (size_t)DEPTH * MP * 1024, O_VP = O_KS + (size_t)DEPTH * MS * 1024, O_VS = O_VP + (size_t)DEPTH * MP * 1024, O_END = O_VS + (size_t)DEPTH * MS * 1024;
constexpr size_t MiB = 1u << 20;
constexpr size_t WS_CTL = 0, CTL_ZERO_BYTES = 1 * MiB;
constexpr size_t WS_SCAL = 1 * MiB;
constexpr size_t WS_ROT = 2 * MiB;
constexpr size_t WS_WIN = 4 * MiB, WIN_BYTES = (size_t)NIN * DM * 2;
constexpr size_t WS_WOUT = WS_WIN + 2 * WIN_BYTES, WOUT_BYTES = (size_t)DM * DM * 2;
constexpr size_t WS_WUP = WS_WOUT + 2 * WOUT_BYTES, WUP_BYTES = (size_t)DFF * DM * 2;
constexpr size_t WS_WDN = WS_WUP + 2 * WUP_BYTES, WDN_BYTES = (size_t)DM * DFF * 2;
constexpr size_t WS_H = WS_WDN + 2 * WDN_BYTES;
constexpr size_t WS_R1 = WS_H + (size_t)M * DM * 2;
constexpr size_t R1_AQ = 0, R1_LOGF = R1_AQ + (size_t)M * 512 * 2, R1_AI = R1_LOGF + (size_t)M * 512 * 4, R1_AG = R1_AI + (size_t)M * 512 * 2,
                 R1_BQ = R1_AG + (size_t)M * 512 * 2, R1_BK = R1_BQ + (size_t)M * 256 * 2, R1_BV = R1_BK + (size_t)M * 256 * 2, R1_BG = R1_BV + (size_t)M * 512 * 2,
                 R1_CQ = R1_BG + (size_t)M * 512 * 2, R1_CK = R1_CQ + (size_t)M * 1024 * 2, R1_CV = R1_CK + (size_t)M * 1024 * 2, R1_MIX = R1_CV + (size_t)M * 1024 * 2,
                 R1_END = R1_MIX + (size_t)M * DM * 2;
static_assert((size_t)M * DFF * 2 <= R1_END, "U overlays R1");
constexpr size_t WS_Y = WS_R1 + R1_END;
constexpr size_t WS_DSA = WS_Y + (size_t)M * DM * 4;
constexpr size_t WS_DSB = WS_DSA + (size_t)NCHUNK * 4 * 16384 * 4;
constexpr size_t WS_DEC = WS_DSB + (size_t)NCHUNK * 4 * 8192 * 4;
constexpr size_t WS_CK = WS_DEC + 1 * MiB;
constexpr size_t WS_CV = WS_CK + (size_t)16 * PAST * 1024 * 2;
constexpr size_t WS_END = WS_CV + (size_t)16 * PAST * 1024 * 2;
static_assert((size_t)NCHUNK * 4 * 128 * 4 <= 1 * MiB, "decay table");
constexpr int CW_TMO = 0, CW_BAR = 4096;

constexpr int RING_OFF = 0, RING_BYTES = 131072;
constexpr int LDSCTL_OFF = RING_BYTES, MISC_OFF = LDSCTL_OFF + 320;
constexpr int LDS_BYTES = 147456;
static_assert(MISC_OFF + 128 <= LDS_BYTES, "LDS map");

#define GAS __attribute__((address_space(1)))
#define LAS __attribute__((address_space(3)))
typedef unsigned short bf16;
typedef unsigned v4u __attribute__((ext_vector_type(4)));
typedef unsigned v2u __attribute__((ext_vector_type(2)));
typedef float f32x4 __attribute__((ext_vector_type(4)));
typedef float f32x16 __attribute__((ext_vector_type(16)));
typedef short bf16x8 __attribute__((ext_vector_type(8)));
typedef GAS unsigned gu32;
#define RLX_AGENT __ATOMIC_RELAXED, __HIP_MEMORY_SCOPE_AGENT
#define LDS_WAIT() asm volatile("s_waitcnt lgkmcnt(0)" ::: "memory")
#define VM_WAIT() asm volatile("s_waitcnt vmcnt(0)" ::: "memory")
__device__ __forceinline__ unsigned f2bf(float f) { unsigned u = __builtin_bit_cast(unsigned, f); return (u + 0x7fffu + ((u >> 16) & 1u)) >> 16; }
__device__ __forceinline__ unsigned pk2(float lo, float hi) { return f2bf(lo) | (f2bf(hi) << 16); }
__device__ __forceinline__ float bf2f(unsigned short b) { return __builtin_bit_cast(float, (unsigned)b << 16); }
#define XB_TMO      128
#define XB_XCNT(j)  (256  + 64 * (j))
#define XB_XSUB(j)  (1280 + 64 * (j))
#define XB_XGEN(j)  (2304 + 64 * (j))
#define XB_TOP      3328
#define XB_TOPGEN   3392
#define XCD_BAR_WORDS 3456
#define XB_SPIN_CAP (1u << 18)

__device__ __forceinline__ unsigned xb_ld(unsigned* p)              { return __hip_atomic_load(p, __ATOMIC_RELAXED, __HIP_MEMORY_SCOPE_AGENT); }
__device__ __forceinline__ unsigned xb_add(unsigned* p, unsigned v) { return __hip_atomic_fetch_add(p, v, __ATOMIC_RELAXED, __HIP_MEMORY_SCOPE_AGENT); }
__device__ __forceinline__ unsigned xb_xcc_id() { return (unsigned)__builtin_amdgcn_s_getreg((3 << 11) | 20) & 0xFu; }
#define XB_SPIN(cond, bar) do { unsigned _sp = 0; while (cond) { __builtin_amdgcn_s_sleep(1); \
    if ((++_sp & 255u) == 0u) { if (xb_ld(&(bar)[XB_TMO])) break; if (_sp > XB_SPIN_CAP) { atomicAdd(&(bar)[XB_TMO], 1u); break; } } } } while (0)

struct XcdBarrier {
    unsigned* bar; unsigned x;
    volatile LAS unsigned* st;
};

__device__ __forceinline__ XcdBarrier xcd_barrier_post(unsigned* bar, volatile LAS unsigned* st) {
    XcdBarrier b; b.bar = bar; b.x = xb_xcc_id(); b.st = st;
    if (threadIdx.x == 0) (void)xb_add(&bar[XB_XCNT(b.x)], 1u);
    return b;
}
__device__ __forceinline__ void xcd_barrier_complete(unsigned* bar, unsigned x, unsigned& nloc, unsigned& nx) {
    const unsigned G = gridDim.x * gridDim.y * gridDim.z;
    unsigned sum, cnt, mine, sp = 0u;
    for (;;) {
        sum = 0u; cnt = 0u; mine = 0u;
#pragma unroll
        for (unsigned j = 0; j < 16; ++j) { const unsigned c = xb_ld(&bar[XB_XCNT(j)]); sum += c; cnt += (c > 0u) ? 1u : 0u; mine = (j == x) ? c : mine; }
        if (sum == G) break;
        __builtin_amdgcn_s_sleep(1);
        if ((++sp & 255u) == 0u) { if (xb_ld(&bar[XB_TMO])) break; if (sp > XB_SPIN_CAP) { atomicAdd(&bar[XB_TMO], 1u); break; } }
    }
    nloc = mine > 0u ? mine : 1u; nx = cnt > 0u ? cnt : 1u;
}

__device__ __forceinline__ void xcd_barrier(const XcdBarrier& b) {
    asm volatile("s_waitcnt vmcnt(0)" ::: "memory");
    __syncthreads();
    if (threadIdx.x == 0) {
        unsigned* bar = b.bar;
        __builtin_amdgcn_s_waitcnt(0);
        unsigned nloc = b.st[0], nx = b.st[1];
        if (nloc == 0u) { xcd_barrier_complete(bar, b.x, nloc, nx); b.st[0] = nloc; b.st[1] = nx; }
        const unsigned old = xb_add(&bar[XB_XSUB(b.x)], 1u);
        const unsigned gen = old / nloc;
        if (old + 1u == (gen + 1u) * nloc) {
            __builtin_amdgcn_fence(__ATOMIC_RELEASE, "agent");
            asm volatile("s_waitcnt vmcnt(0)" ::: "memory");
            const unsigned og = xb_add(&bar[XB_TOP], 1u);
            const unsigned tg = og / nx;
            if (og + 1u == (tg + 1u) * nx) xb_add(&bar[XB_TOPGEN], 1u);
            else XB_SPIN(xb_ld(&bar[XB_TOPGEN]) == tg, bar);
            __builtin_amdgcn_fence(__ATOMIC_ACQUIRE, "agent");
            xb_add(&bar[XB_XGEN(b.x)], 1u);
            asm volatile("s_waitcnt vmcnt(0)" ::: "memory");
        } else {
            XB_SPIN(xb_ld(&bar[XB_XGEN(b.x)]) == gen, bar);
            __builtin_amdgcn_fence(__ATOMIC_ACQUIRE, "agent");
            asm volatile("s_waitcnt vmcnt(0)" ::: "memory");
        }
    }
    __syncthreads();
}
struct Args { const float* in[21]; float* out; unsigned char* ws; int ph_lo, ph_hi, li, pad; };
struct Frame {
    LAS unsigned char* lds;
    volatile LAS unsigned* MISC;
    gu32* ctl;
    int tid, lane, wave, G, bid;
    float* out; unsigned char* ws;
};
__device__ __forceinline__ float wave_sum(float v) {
#pragma unroll
    for (int o = 1; o < 64; o <<= 1) v += __shfl_xor(v, o);
    return v;
}
__device__ __forceinline__ float silu(float x) { return x / (1.0f + __expf(-x)); }
__device__ __forceinline__ int crow(int r, int hi) { return (r & 3) + 8 * (r >> 2) + 4 * hi; }

__device__ __forceinline__ void p0_transpose_item(const float* W, int K, int N, bf16* WT, LAS float* scr, int item, int lane) {
    const int nblk = N / 32, kb = item / nblk, nb = item % nblk, k0 = 64 * kb, n0 = 32 * nb;
#pragma unroll 8
    for (int i = 0; i < 32; ++i) { const int kk = 2 * i + (lane >> 5); scr[kk * 33 + (lane & 31)] = W[(size_t)(k0 + kk) * N + n0 + (lane & 31)]; }
    LDS_WAIT(); asm volatile("" ::: "memory");
    const int c = lane & 7;
#pragma unroll
    for (int j = 0; j < 4; ++j) { const int n = (lane >> 3) + 8 * j; const LAS float* s = scr + (8 * c) * 33 + n;
        v4u o; o.x = pk2(s[0 * 33], s[1 * 33]); o.y = pk2(s[2 * 33], s[3 * 33]); o.z = pk2(s[4 * 33], s[5 * 33]); o.w = pk2(s[6 * 33], s[7 * 33]);
        *(GAS v4u*)(WT + (size_t)(n0 + n) * K + k0 + 8 * c) = o; }
    LDS_WAIT(); asm volatile("" ::: "memory");
}
__device__ __forceinline__ const float* xrow_in(const Args& A, int m) { return m < MP ? A.in[0] + (size_t)m * DM : A.in[1] + (size_t)(m - MP) * DM; }

__device__ __forceinline__ void norm_row_to_bf16(const float* xr, const float* g, bf16* orow, int lane) {
    const GAS f32x4* xp = (const GAS f32x4*)xr + lane; const GAS f32x4* gp = (const GAS f32x4*)g + lane;
    f32x4 v[8]; float s = 0.f;
#pragma unroll
    for (int j = 0; j < 8; ++j) { v[j] = xp[64 * j]; s += (v[j].x * v[j].x + v[j].y * v[j].y) + (v[j].z * v[j].z + v[j].w * v[j].w); }
    const float rinv = 1.0f / sqrtf(wave_sum(s) * (1.0f / DM) + EPS);
    GAS v2u* o8 = (GAS v2u*)orow + lane;
#pragma unroll
    for (int j = 0; j < 8; ++j) { const f32x4 gg = gp[64 * j]; v2u w; w.x = pk2(v[j].x * rinv * gg.x, v[j].y * rinv * gg.y); w.y = pk2(v[j].z * rinv * gg.z, v[j].w * rinv * gg.w); o8[64 * j] = w; }
}
__device__ __forceinline__ void resid_norm_row(const float* yr, const float* xi, const float* g1, float* xo, const float* g2, bf16* hrow, int lane) {
    const GAS f32x4* yp = (const GAS f32x4*)yr + lane; const GAS f32x4* xp = (const GAS f32x4*)xi + lane; const GAS f32x4* gp = (const GAS f32x4*)g1 + lane;
    f32x4 v[8]; float s = 0.f;
#pragma unroll
    for (int j = 0; j < 8; ++j) { v[j] = yp[64 * j]; s += (v[j].x * v[j].x + v[j].y * v[j].y) + (v[j].z * v[j].z + v[j].w * v[j].w); }
    const float rinv = 1.0f / sqrtf(wave_sum(s) * (1.0f / DM) + EPS);
    float s2 = 0.f; GAS f32x4* op = (GAS f32x4*)xo + lane;
#pragma unroll
    for (int j = 0; j < 8; ++j) { const f32x4 gg = gp[64 * j], xx = xp[64 * j]; f32x4 r;
        r.x = xx.x + v[j].x * rinv * gg.x; r.y = xx.y + v[j].y * rinv * gg.y; r.z = xx.z + v[j].z * rinv * gg.z; r.w = xx.w + v[j].w * rinv * gg.w;
        v[j] = r; op[64 * j] = r; s2 += (r.x * r.x + r.y * r.y) + (r.z * r.z + r.w * r.w); }
    if (g2 != nullptr) {
        const float rinv2 = 1.0f / sqrtf(wave_sum(s2) * (1.0f / DM) + EPS);
        const GAS f32x4* g2p = (const GAS f32x4*)g2 + lane; GAS v2u* o8 = (GAS v2u*)hrow + lane;
#pragma unroll
        for (int j = 0; j < 8; ++j) { const f32x4 gg = g2p[64 * j]; v2u w; w.x = pk2(v[j].x * rinv2 * gg.x, v[j].y * rinv2 * gg.y); w.y = pk2(v[j].z * rinv2 * gg.z, v[j].w * rinv2 * gg.w); o8[64 * j] = w; }
    }
}
__device__ __forceinline__ void convert_cache(const Frame& F, const Args& A, int l) {
    const size_t n8 = (size_t)16 * PAST * 1024 / 8;
    const float* ck = A.in[4] + (size_t)l * 16 * PAST * 1024; const float* cv = A.in[5] + (size_t)l * 16 * PAST * 1024;
    bf16* ok = (bf16*)(F.ws + WS_CK); bf16* ov = (bf16*)(F.ws + WS_CV);
    for (size_t i = (size_t)F.bid * 512 + F.tid; i < 2 * n8; i += (size_t)F.G * 512) {
        const bool isk = i < n8; const size_t j = isk ? i : i - n8;
        const f32x4 a = *(const GAS f32x4*)((isk ? ck : cv) + j * 8), b = *(const GAS f32x4*)((isk ? ck : cv) + j * 8 + 4);
        v4u w; w.x = pk2(a.x, a.y); w.y = pk2(a.z, a.w); w.z = pk2(b.x, b.y); w.w = pk2(b.z, b.w);
        *(GAS v4u*)((isk ? ok : ov) + j * 8) = w;
    }
}
__device__ __forceinline__ void phase_prologue(Frame& F, const Args& A) {
    LAS float* scr = (LAS float*)(F.lds + RING_OFF + F.wave * 16384);
    const int gw = F.bid * NWAVES + F.wave, NGW = F.G * NWAVES;
    constexpr int I_IN = (DM / 64) * (NIN / 32), I_OUT = (DM / 64) * (DM / 32), I_UP = (DM / 64) * (DFF / 32), I_DN = (DFF / 64) * (DM / 32);
    constexpr int I_L = I_IN + I_OUT + I_UP + I_DN;
    for (int it = gw; it < DEPTH * I_L; it += NGW) {
        const int l = it / I_L; int r = it % I_L;
        if (r < I_IN) { p0_transpose_item(A.in[6] + (size_t)l * DM * NIN, DM, NIN, (bf16*)(F.ws + WS_WIN + l * WIN_BYTES), scr, r, F.lane); continue; } r -= I_IN;
        if (r < I_OUT) { p0_transpose_item(A.in[7] + (size_t)l * DM * DM, DM, DM, (bf16*)(F.ws + WS_WOUT + l * WOUT_BYTES), scr, r, F.lane); continue; } r -= I_OUT;
        if (r < I_UP) { p0_transpose_item(A.in[8] + (size_t)l * DM * DFF, DM, DFF, (bf16*)(F.ws + WS_WUP + l * WUP_BYTES), scr, r, F.lane); continue; } r -= I_UP;
        p0_transpose_item(A.in[9] + (size_t)l * DFF * DM, DFF, DM, (bf16*)(F.ws + WS_WDN + l * WDN_BYTES), scr, r, F.lane);
    }
    float* rot = (float*)(F.ws + WS_ROT);
    for (int i = F.bid * 512 + F.tid; i < SEQ * 32; i += F.G * 512) {
        const int pos = i >> 5, k = i & 31;
        const double inv = exp(-((double)k / 31.0) * 9.210340371976184);
        double a = (double)pos * inv; a -= 6.283185307179586 * rint(a / 6.283185307179586);
        rot[pos * 64 + k] = (float)cos(a); rot[pos * 64 + 32 + k] = (float)sin(a);
    }
    if (F.bid == 0) {
        float* sc = (float*)(F.ws + WS_SCAL);
        if (F.wave < DEPTH) {
            const int l = F.wave;
            float a = A.in[16][l * 128 + F.lane] * A.in[17][l * 128 + F.lane] + A.in[16][l * 128 + 64 + F.lane] * A.in[17][l * 128 + 64 + F.lane];
            float b = A.in[18][l * 128 + F.lane] * A.in[19][l * 128 + F.lane] + A.in[18][l * 128 + 64 + F.lane] * A.in[19][l * 128 + 64 + F.lane];
            a = wave_sum(a); b = wave_sum(b);
            const float lam_init = 0.8f - 0.6f * expf(-0.3f * (float)l);
            if (F.lane == 0) sc[l] = expf(a) - expf(b) + lam_init;
        }
        { const float l0 = A.in[14][F.tid], l1 = A.in[14][512 + F.tid]; sc[16 + F.tid] = 1.0f / (1.0f + expf(l0 - l1)); }
    }
    convert_cache(F, A, 0);
    for (int m = gw; m < M; m += NGW) norm_row_to_bf16(xrow_in(A, m), A.in[10], (bf16*)(F.ws + WS_H) + (size_t)m * DM, F.lane);
}

template <int K> __device__ __forceinline__ void mma_tile(f32x16& acc, const LAS unsigned char* A, int lda, const LAS unsigned char* B, int ldb, int lane) {
    const int r = lane & 31, h = lane >> 5;
#pragma unroll
    for (int k0 = 0; k0 < K; k0 += 16) {
        const bf16x8 a = *(const LAS bf16x8*)(A + r * lda + (k0 + 8 * h) * 2);
        const bf16x8 b = *(const LAS bf16x8*)(B + r * ldb + (k0 + 8 * h) * 2);
        acc = __builtin_amdgcn_mfma_f32_32x32x16_bf16(a, b, acc, 0, 0, 0);
    }
}
constexpr int LD128 = 272, LD64 = 144;
__device__ __forceinline__ float ret_log_gamma(int head) { return log1pf(-exp2f(-5.0f - (float)head)); }
__device__ __forceinline__ int chunk_pos0(int chunk) { return chunk < 256 ? (chunk & 127) * 64 : PAST; }

__device__ __forceinline__ void hgrn_state_unit(Frame& F, int chunk, int head) {
    LAS unsigned char* lds = F.lds; const int tid = F.tid, lane = F.lane, w = F.wave;
    LAS float* LG = (LAS float*)lds; LAS float* BC = (LAS float*)(lds + 32768);
    LAS unsigned char* KDT = lds + 65536; LAS unsigned char* VT = lds + 65536 + 128 * LD64;
    const int row0 = chunk * 64, unit = chunk * 4 + head;
    const float* logf = (const float*)(F.ws + WS_R1 + R1_LOGF); const bf16* AI = (const bf16*)(F.ws + WS_R1 + R1_AI);
    for (int i = tid; i < 64 * 32; i += 512) { const int t = i >> 5, c4 = i & 31;
        *(LAS f32x4*)(LG + t * 128 + c4 * 4) = *(const GAS f32x4*)(logf + (size_t)(row0 + t) * 512 + head * 128 + c4 * 4); }
    __syncthreads();
    if (tid < 128) { float a = 0.f; for (int t = 0; t < 64; ++t) { a += LG[t * 128 + tid]; BC[t * 128 + tid] = a; } }
    __syncthreads();
    for (int i = tid; i < 128 * 32; i += 512) { const int k = i & 127, sp = i >> 7;
        const float bt = BC[63 * 128 + k];
        const float k0 = -expm1f(LG[(2 * sp) * 128 + k]) * __expf(bt - BC[(2 * sp) * 128 + k]);
        const float k1 = -expm1f(LG[(2 * sp + 1) * 128 + k]) * __expf(bt - BC[(2 * sp + 1) * 128 + k]);
        *(LAS unsigned*)(KDT + k * LD64 + sp * 4) = pk2(k0, k1); }
    { const int sp = tid >> 4, vg = tid & 15;
      const bf16x8 a = *(const GAS bf16x8*)(AI + (size_t)(row0 + 2 * sp) * 512 + head * 128 + vg * 8), b = *(const GAS bf16x8*)(AI + (size_t)(row0 + 2 * sp + 1) * 512 + head * 128 + vg * 8);
#pragma unroll
      for (int e = 0; e < 8; ++e) *(LAS unsigned*)(VT + (vg * 8 + e) * LD64 + sp * 4) = (unsigned)(unsigned short)a[e] | ((unsigned)(unsigned short)b[e] << 16); }
    if (tid < 128) ((float*)(F.ws + WS_DEC))[unit * 128 + tid] = __expf(BC[63 * 128 + tid]);
    __syncthreads();
    const int vt = w >> 1, kt0 = (w & 1) * 2, r32 = lane & 31, hi = lane >> 5;
    f32x16 acc0 = {}, acc1 = {};
    mma_tile<64>(acc0, VT + vt * 32 * LD64, LD64, KDT + kt0 * 32 * LD64, LD64, lane);
    mma_tile<64>(acc1, VT + vt * 32 * LD64, LD64, KDT + (kt0 + 1) * 32 * LD64, LD64, lane);
    float* dst = (float*)(F.ws + WS_DSA) + (size_t)unit * 16384;
#pragma unroll
    for (int i = 0; i < 16; ++i) { const int v = vt * 32 + crow(i, hi); dst[v * 128 + kt0 * 32 + r32] = acc0[i]; dst[v * 128 + (kt0 + 1) * 32 + r32] = acc1[i]; }
    __syncthreads();
}
__device__ __forceinline__ void ret_state_unit(Frame& F, int chunk, int head) {
    LAS unsigned char* lds = F.lds; const int tid = F.tid, lane = F.lane, w = F.wave;
    LAS unsigned char* KDT = lds; LAS unsigned char* VT = lds + 64 * LD64;
    const int row0 = chunk * 64, unit = chunk * 4 + head, pos0 = chunk_pos0(chunk);
    const bf16* BK = (const bf16*)(F.ws + WS_R1 + R1_BK); const bf16* BV = (const bf16*)(F.ws + WS_R1 + R1_BV); const float* rot = (const float*)(F.ws + WS_ROT);
    const float lg = ret_log_gamma(head);
    for (int i = tid; i < 32 * 32; i += 512) { const int k = i & 31, sp = i >> 5;
        float o1[2], o2[2];
#pragma unroll
        for (int e = 0; e < 2; ++e) { const int s = 2 * sp + e; const bf16* kr = BK + (size_t)(row0 + s) * 256 + head * 64;
            const float x1 = bf2f(kr[k]), x2 = bf2f(kr[k + 32]), c = rot[(pos0 + s) * 64 + k], sn = rot[(pos0 + s) * 64 + 32 + k];
            const float tl = 0.125f * __expf((float)(63 - s) * lg);
            o1[e] = (x1 * c - x2 * sn) * tl; o2[e] = (x1 * sn + x2 * c) * tl; }
        *(LAS unsigned*)(KDT + k * LD64 + sp * 4) = pk2(o1[0], o1[1]); *(LAS unsigned*)(KDT + (k + 32) * LD64 + sp * 4) = pk2(o2[0], o2[1]); }
    { const int sp = tid >> 4, vg = tid & 15;
      const bf16x8 a = *(const GAS bf16x8*)(BV + (size_t)(row0 + 2 * sp) * 512 + head * 128 + vg * 8), b = *(const GAS bf16x8*)(BV + (size_t)(row0 + 2 * sp + 1) * 512 + head * 128 + vg * 8);
#pragma unroll
      for (int e = 0; e < 8; ++e) *(LAS unsigned*)(VT + (vg * 8 + e) * LD64 + sp * 4) = (unsigned)(unsigned short)a[e] | ((unsigned)(unsigned short)b[e] << 16); }
    __syncthreads();
    const int vt = w >> 1, kt = w & 1, r32 = lane & 31, hi = lane >> 5;
    f32x16 acc = {};
    mma_tile<64>(acc, VT + vt * 32 * LD64, LD64, KDT + kt * 32 * LD64, LD64, lane);
    float* dst = (float*)(F.ws + WS_DSB) + (size_t)unit * 8192;
#pragma unroll
    for (int i = 0; i < 16; ++i) { const int v = vt * 32 + crow(i, hi); dst[v * 64 + kt * 32 + r32] = acc[i]; }
    __syncthreads();
}
__device__ __forceinline__ void phase_scan(Frame& F, const Args& A, int l) {
    float* dsa = (float*)(F.ws + WS_DSA); float* dsb = (float*)(F.ws + WS_DSB); const float* dec = (const float*)(F.ws + WS_DEC);
    constexpr int NA_P = 2 * 4 * 16384, NB_P = 2 * 4 * 8192, NA_S = 16 * 4 * 16384, NB_S = 16 * 4 * 8192;
    const int nthr = F.G * 512;
    for (int e = F.bid * 512 + F.tid; e < NA_P + NB_P + NA_S + NB_S; e += nthr) {
        if (e < NA_P) {
            const int b = e >> 16, head = (e >> 14) & 3, idx = e & 16383, k = idx & 127, v = idx >> 7;
            float S = 0.f;
            for (int c0 = 0; c0 < 128; c0 += 8) {
                float t[8], d[8];
#pragma unroll
                for (int j = 0; j < 8; ++j) { const int unit = (b * 128 + c0 + j) * 4 + head; t[j] = dsa[(size_t)unit * 16384 + idx]; d[j] = dec[unit * 128 + k]; }
#pragma unroll
                for (int j = 0; j < 8; ++j) { const int unit = (b * 128 + c0 + j) * 4 + head; dsa[(size_t)unit * 16384 + idx] = S; S = d[j] * S + t[j]; }
            }
            F.out[O_HP + ((size_t)(l * 2 + b) * 4 + head) * 16384 + k * 128 + v] = S;
        } else if (e < NA_P + NB_P) {
            const int x = e - NA_P, b = x >> 15, head = (x >> 13) & 3, idx = x & 8191, k = idx & 63, v = idx >> 6;
            const float g64 = __expf(64.0f * ret_log_gamma(head));
            float S = 0.f;
            for (int c0 = 0; c0 < 128; c0 += 8) {
                float t[8];
#pragma unroll
                for (int j = 0; j < 8; ++j) { const int unit = (b * 128 + c0 + j) * 4 + head; t[j] = dsb[(size_t)unit * 8192 + idx]; }
#pragma unroll
                for (int j = 0; j < 8; ++j) { const int unit = (b * 128 + c0 + j) * 4 + head; dsb[(size_t)unit * 8192 + idx] = S; S = g64 * S + t[j]; }
            }
            F.out[O_RP + ((size_t)(l * 2 + b) * 4 + head) * 8192 + k * 128 + v] = S;
        } else if (e < NA_P + NB_P + NA_S) {
            const int x = e - NA_P - NB_P, seq = x >> 16, head = (x >> 14) & 3, idx = x & 16383, k = idx & 127, v = idx >> 7;
            const int unit = (256 + seq) * 4 + head;
            const size_t so = ((size_t)(l * 16 + seq) * 4 + head) * 16384 + k * 128 + v;
            const float S0 = A.in[2][so], t = dsa[(size_t)unit * 16384 + idx];
            dsa[(size_t)unit * 16384 + idx] = S0;
            F.out[O_HS + so] = dec[unit * 128 + k] * S0 + t;
        } else {
            const int x = e - NA_P - NB_P - NA_S, seq = x >> 15, head = (x >> 13) & 3, idx = x & 8191, k = idx & 63, v = idx >> 6;
            const int unit = (256 + seq) * 4 + head;
            const size_t so = ((size_t)(l * 16 + seq) * 4 + head) * 8192 + k * 128 + v;
            const float S0 = A.in[3][so], t = dsb[(size_t)unit * 8192 + idx];
            dsb[(size_t)unit * 8192 + idx] = S0;
            F.out[O_RS + so] = __expf(64.0f * ret_log_gamma(head)) * S0 + t;
        }
    }
}
__device__ __forceinline__ void mixer_out_rows(Frame& F, const LAS float* OT, int row0, const bf16* gate  , const float* gain  , int head, int mixcol0) {
    const int t = F.tid >> 3, j = F.tid & 7;
    f32x4 o[4]; float ss = 0.f;
#pragma unroll
    for (int q = 0; q < 4; ++q) { o[q] = *(const LAS f32x4*)(OT + t * 132 + j * 16 + q * 4); ss += (o[q].x * o[q].x + o[q].y * o[q].y) + (o[q].z * o[q].z + o[q].w * o[q].w); }
    ss += __shfl_xor(ss, 1); ss += __shfl_xor(ss, 2); ss += __shfl_xor(ss, 4);
    const float rinv = 1.0f / sqrtf(ss * (1.0f / 128.0f) + EPS);
    const bf16* gr = gate + (size_t)(row0 + t) * 512 + head * 128 + j * 16;
    const bf16x8 g0 = *(const GAS bf16x8*)gr, g1 = *(const GAS bf16x8*)(gr + 8);
    float r[16];
#pragma unroll
    for (int q = 0; q < 4; ++q) { r[4 * q] = o[q].x; r[4 * q + 1] = o[q].y; r[4 * q + 2] = o[q].z; r[4 * q + 3] = o[q].w; }
#pragma unroll
    for (int e = 0; e < 16; ++e) { const float gt = bf2f((unsigned short)(e < 8 ? g0[e] : g1[e - 8])); const float gn = gain ? gain[j * 16 + e] : 1.0f; r[e] = r[e] * rinv * gn * silu(gt); }
    bf16* mp = (bf16*)(F.ws + WS_R1 + R1_MIX) + (size_t)(row0 + t) * DM + mixcol0 + head * 128 + j * 16;
    v4u w0, w1; w0.x = pk2(r[0], r[1]); w0.y = pk2(r[2], r[3]); w0.z = pk2(r[4], r[5]); w0.w = pk2(r[6], r[7]); w1.x = pk2(r[8], r[9]); w1.y = pk2(r[10], r[11]); w1.z = pk2(r[12], r[13]); w1.w = pk2(r[14], r[15]);
    *(GAS v4u*)mp = w0; *(GAS v4u*)(mp + 8) = w1;
}
__device__ __forceinline__ void hgrn_out_unit(Frame& F, const Args& A, int l, int chunk, int head) {
    LAS unsigned char* lds = F.lds; const int tid = F.tid, lane = F.lane, w = F.wave;
    LAS float* LG = (LAS float*)lds; LAS float* BC = (LAS float*)(lds + 32768);
    LAS unsigned char* STS = lds; LAS unsigned char* P = lds + 128 * LD128; LAS unsigned char* VT = P + 64 * LD64;
    LAS unsigned char* QT = lds + 65536; LAS unsigned char* KT = QT + 64 * LD128; LAS unsigned char* QD = KT + 64 * LD128;
    LAS float* OT = (LAS float*)(lds + 65536);
    static_assert(128 * LD128 + 64 * LD64 + 128 * LD64 <= 65536 && 64 * 132 * 4 <= 2 * 64 * LD128 && 65536 + 3 * 64 * LD128 <= RING_BYTES, "hgrn_out LDS map");
    const int row0 = chunk * 64, unit = chunk * 4 + head;
    const float* logf = (const float*)(F.ws + WS_R1 + R1_LOGF); const bf16* AQ = (const bf16*)(F.ws + WS_R1 + R1_AQ); const bf16* AI = (const bf16*)(F.ws + WS_R1 + R1_AI);
    for (int i = tid; i < 64 * 32; i += 512) { const int t = i >> 5, c4 = i & 31;
        *(LAS f32x4*)(LG + t * 128 + c4 * 4) = *(const GAS f32x4*)(logf + (size_t)(row0 + t) * 512 + head * 128 + c4 * 4); }
    __syncthreads();
    if (tid < 128) { float a = 0.f; for (int t = 0; t < 64; ++t) { a += LG[t * 128 + tid]; BC[t * 128 + tid] = a; } }
    __syncthreads();
    for (int i = tid; i < 64 * 16; i += 512) { const int t = i >> 4, kg = i & 15;
        const bf16x8 q8 = *(const GAS bf16x8*)(AQ + (size_t)(row0 + t) * 512 + head * 128 + kg * 8);
        unsigned qt[4], kt[4], qd[4]; float a[2], b[2], c[2];
#pragma unroll
        for (int e = 0; e < 8; ++e) { const int k = kg * 8 + e; const float lf = LG[t * 128 + k], bc = BC[t * 128 + k], rf = BC[31 * 128 + k], q = bf2f((unsigned short)q8[e]);
            a[e & 1] = q * __expf(fminf(bc - rf, 80.f)); b[e & 1] = -expm1f(lf) * __expf(fminf(rf - bc, 80.f)); c[e & 1] = q * __expf(bc);
            if (e & 1) { qt[e >> 1] = pk2(a[0], a[1]); kt[e >> 1] = pk2(b[0], b[1]); qd[e >> 1] = pk2(c[0], c[1]); } }
        *(LAS v4u*)(QT + t * LD128 + kg * 16) = (v4u){qt[0], qt[1], qt[2], qt[3]}; *(LAS v4u*)(KT + t * LD128 + kg * 16) = (v4u){kt[0], kt[1], kt[2], kt[3]}; *(LAS v4u*)(QD + t * LD128 + kg * 16) = (v4u){qd[0], qd[1], qd[2], qd[3]}; }
    __syncthreads();
    { const float* src = (const float*)(F.ws + WS_DSA) + (size_t)unit * 16384;
      for (int i = tid; i < 128 * 32; i += 512) { const int v = i >> 5, c4 = i & 31; const f32x4 s = *(const GAS f32x4*)(src + v * 128 + c4 * 4);
          *(LAS v2u*)(STS + v * LD128 + c4 * 8) = (v2u){pk2(s.x, s.y), pk2(s.z, s.w)}; } }
    { const int sp = tid >> 4, vg = tid & 15;
      const bf16x8 a = *(const GAS bf16x8*)(AI + (size_t)(row0 + 2 * sp) * 512 + head * 128 + vg * 8), b = *(const GAS bf16x8*)(AI + (size_t)(row0 + 2 * sp + 1) * 512 + head * 128 + vg * 8);
#pragma unroll
      for (int e = 0; e < 8; ++e) *(LAS unsigned*)(VT + (vg * 8 + e) * LD64 + sp * 4) = (unsigned)(unsigned short)a[e] | ((unsigned)(unsigned short)b[e] << 16); }
    __syncthreads();
    const int r32 = lane & 31, hi = lane >> 5;
    if (w < 4) {
        const int tt = w >> 1, st = w & 1; f32x16 sc = {};
        if (!(tt == 0 && st == 1)) mma_tile<128>(sc, QT + tt * 32 * LD128, LD128, KT + st * 32 * LD128, LD128, lane);
#pragma unroll
        for (int i = 0; i < 16; ++i) { const int t = tt * 32 + crow(i, hi), s = st * 32 + r32; *(LAS unsigned short*)(P + t * LD64 + s * 2) = (unsigned short)f2bf(s <= t ? sc[i] : 0.f); }
    }
    const int tt = w >> 2, vt = w & 3; f32x16 acc = {};
    mma_tile<128>(acc, QD + tt * 32 * LD128, LD128, STS + vt * 32 * LD128, LD128, lane);
    __syncthreads();
    mma_tile<64>(acc, P + tt * 32 * LD64, LD64, VT + vt * 32 * LD64, LD64, lane);
    __syncthreads();
#pragma unroll
    for (int i = 0; i < 16; ++i) OT[(tt * 32 + crow(i, hi)) * 132 + vt * 32 + r32] = acc[i];
    __syncthreads();
    mixer_out_rows(F, OT, row0, (const bf16*)(F.ws + WS_R1 + R1_AG), A.in[15] + l * 128, head, 0);
    __syncthreads();
}
__device__ __forceinline__ void ret_out_unit(Frame& F, int chunk, int head) {
    LAS unsigned char* lds = F.lds; const int tid = F.tid, lane = F.lane, w = F.wave;
    LAS unsigned char* QT = lds; LAS unsigned char* KT = QT + 64 * LD64; LAS unsigned char* VT = KT + 64 * LD64; LAS unsigned char* STS = VT + 128 * LD64; LAS unsigned char* P = STS + 128 * LD64;
    LAS float* OT = (LAS float*)(lds + 65536);
    static_assert(3 * 64 * LD64 + 2 * 128 * LD64 <= 65536, "ret_out LDS map");
    const int row0 = chunk * 64, unit = chunk * 4 + head, pos0 = chunk_pos0(chunk);
    const bf16* BQ = (const bf16*)(F.ws + WS_R1 + R1_BQ); const bf16* BK = (const bf16*)(F.ws + WS_R1 + R1_BK); const bf16* BV = (const bf16*)(F.ws + WS_R1 + R1_BV);
    const float* rot = (const float*)(F.ws + WS_ROT);
    const float lg = ret_log_gamma(head);
    for (int i = tid; i < 64 * 32; i += 512) { const int k = i & 31, s = i >> 5;
        const bf16* qr = BQ + (size_t)(row0 + s) * 256 + head * 64; const bf16* kr = BK + (size_t)(row0 + s) * 256 + head * 64;
        const float c = rot[(pos0 + s) * 64 + k], sn = rot[(pos0 + s) * 64 + 32 + k];
        const float q1 = bf2f(qr[k]), q2 = bf2f(qr[k + 32]), k1 = bf2f(kr[k]), k2 = bf2f(kr[k + 32]);
        *(LAS unsigned short*)(QT + s * LD64 + k * 2) = (unsigned short)f2bf(q1 * c - q2 * sn); *(LAS unsigned short*)(QT + s * LD64 + (k + 32) * 2) = (unsigned short)f2bf(q1 * sn + q2 * c);
        *(LAS unsigned short*)(KT + s * LD64 + k * 2) = (unsigned short)f2bf(0.125f * (k1 * c - k2 * sn)); *(LAS unsigned short*)(KT + s * LD64 + (k + 32) * 2) = (unsigned short)f2bf(0.125f * (k1 * sn + k2 * c)); }
    { const float* src = (const float*)(F.ws + WS_DSB) + (size_t)unit * 8192;
      for (int i = tid; i < 128 * 16; i += 512) { const int v = i >> 4, c4 = i & 15; const f32x4 s = *(const GAS f32x4*)(src + v * 64 + c4 * 4);
          *(LAS v2u*)(STS + v * LD64 + c4 * 8) = (v2u){pk2(s.x, s.y), pk2(s.z, s.w)}; } }
    { const int sp = tid >> 4, vg = tid & 15;
      const bf16x8 a = *(const GAS bf16x8*)(BV + (size_t)(row0 + 2 * sp) * 512 + head * 128 + vg * 8), b = *(const GAS bf16x8*)(BV + (size_t)(row0 + 2 * sp + 1) * 512 + head * 128 + vg * 8);
#pragma unroll
      for (int e = 0; e < 8; ++e) *(LAS unsigned*)(VT + (vg * 8 + e) * LD64 + sp * 4) = (unsigned)(unsigned short)a[e] | ((unsigned)(unsigned short)b[e] << 16); }
    __syncthreads();
    const int r32 = lane & 31, hi = lane >> 5;
    if (w < 4) {
        const int tt = w >> 1, st = w & 1; f32x16 sc = {};
        if (!(tt == 0 && st == 1)) mma_tile<64>(sc, QT + tt * 32 * LD64, LD64, KT + st * 32 * LD64, LD64, lane);
#pragma unroll
        for (int i = 0; i < 16; ++i) { const int t = tt * 32 + crow(i, hi), s = st * 32 + r32; *(LAS unsigned short*)(P + t * LD64 + s * 2) = (unsigned short)f2bf(s <= t ? sc[i] * __expf((float)(t - s) * lg) : 0.f); }
    }
    const int tt = w >> 2, vt = w & 3; f32x16 acc = {};
    mma_tile<64>(acc, QT + tt * 32 * LD64, LD64, STS + vt * 32 * LD64, LD64, lane);
#pragma unroll
    for (int i = 0; i < 16; ++i) acc[i] *= __expf((float)(tt * 32 + crow(i, hi) + 1) * lg);
    __syncthreads();
    mma_tile<64>(acc, P + tt * 32 * LD64, LD64, VT + vt * 32 * LD64, LD64, lane);
#pragma unroll
    for (int i = 0; i < 16; ++i) OT[(tt * 32 + crow(i, hi)) * 132 + vt * 32 + r32] = acc[i];
    __syncthreads();
    mixer_out_rows(F, OT, row0, (const bf16*)(F.ws + WS_R1 + R1_BG), nullptr, head, 512);
    __syncthreads();
}
__device__ __forceinline__ void attn_prompt_unit(Frame& F, int hd32, int qb) {
    const int b = hd32 >> 4, h = (hd32 >> 2) & 3, c = (hd32 >> 1) & 1, vh = hd32 & 1;
    const bf16* CQ = (const bf16*)(F.ws + WS_R1 + R1_CQ); const bf16* CK = (const bf16*)(F.ws + WS_R1 + R1_CK); const bf16* CV = (const bf16*)(F.ws + WS_R1 + R1_CV);
    const size_t rb = (size_t)b * SEQ;
    att::KVSrc src; src.k0 = CK + rb * 1024 + h * 256 + c * 128; src.v0 = CV + rb * 1024 + h * 256 + vh * 128; src.k1 = src.k0; src.v1 = src.v0; src.nt0 = 4 * qb + 4; src.ntreal = 4 * qb + 4;
    const size_t qrow = rb + (size_t)qb * 256 + F.wave * 32;
    float* O = (float*)(F.ws + WS_Y) + qrow * 2048 + h * 512 + c * 256 + vh * 128;
    __syncthreads();
    att::attn_body(CQ + qrow * 1024 + h * 256 + c * 128, src, O, 4 * qb + 4, 4 * qb + (F.wave >> 1), (char*)F.lds);
}
__device__ __forceinline__ void attn_sample_unit(Frame& F, int x) {
    const int seq = x >> 4, h = (x >> 2) & 3, c = (x >> 1) & 1, vh = x & 1;
    const bf16* CQ = (const bf16*)(F.ws + WS_R1 + R1_CQ); const bf16* CK = (const bf16*)(F.ws + WS_R1 + R1_CK); const bf16* CV = (const bf16*)(F.ws + WS_R1 + R1_CV);
    const bf16* KC = (const bf16*)(F.ws + WS_CK); const bf16* VC = (const bf16*)(F.ws + WS_CV);
    const size_t rs = (size_t)MP + (size_t)seq * 64;
    att::KVSrc src; src.k0 = KC + (size_t)seq * PAST * 1024 + h * 256 + c * 128; src.v0 = VC + (size_t)seq * PAST * 1024 + h * 256 + vh * 128;
    src.k1 = CK + rs * 1024 + h * 256 + c * 128; src.v1 = CV + rs * 1024 + h * 256 + vh * 128; src.nt0 = PAST / 64; src.ntreal = PAST / 64 + 1;
    const size_t qrow = rs + (size_t)(F.wave & 1) * 32;
    float* O = (F.wave < 2) ? (float*)(F.ws + WS_Y) + qrow * 2048 + h * 512 + c * 256 + vh * 128 : nullptr;
    __syncthreads();
    int nt_ = PAST / 64 + 2, lim_ = PAST / 64; asm volatile("" : "+s"(nt_), "+s"(lim_));
    att::attn_body(CQ + qrow * 1024 + h * 256 + c * 128, src, O, nt_, lim_, (char*)F.lds);
}
__device__ __forceinline__ void phase_combine(Frame& F, const Args& A, int l) {
    const int gw = F.bid * NWAVES + F.wave, NGW = F.G * NWAVES;
    const float lam = ((const float*)(F.ws + WS_SCAL))[l];
    const float post = 1.0f - (0.8f - 0.6f * expf(-0.3f * (float)l));
    const float* OP = (const float*)(F.ws + WS_Y); bf16* MIXp = (bf16*)(F.ws + WS_R1 + R1_MIX);
    const f32x4 g = *(const GAS f32x4*)(A.in[20] + l * 256 + F.lane * 4);
    for (int it = gw; it < M * 4; it += NGW) { const int m = it >> 2, h = it & 3;
        const float* p = OP + (size_t)m * 2048 + h * 512 + F.lane * 4;
        const f32x4 a = *(const GAS f32x4*)p, b = *(const GAS f32x4*)(p + 256);
        f32x4 d; d.x = a.x - lam * b.x; d.y = a.y - lam * b.y; d.z = a.z - lam * b.z; d.w = a.w - lam * b.w;
        const float ss = wave_sum((d.x * d.x + d.y * d.y) + (d.z * d.z + d.w * d.w));
        const float rinv = post / sqrtf(ss * (1.0f / 256.0f) + EPS);
        v2u w; w.x = pk2(d.x * rinv * g.x, d.y * rinv * g.y); w.y = pk2(d.z * rinv * g.z, d.w * rinv * g.w);
        *(GAS v2u*)(MIXp + (size_t)m * DM + 1024 + h * 256 + F.lane * 4) = w;
    }
}
#ifdef NAIVE_SAMPLE_ATTN
__device__ __forceinline__ void phase_naive_sample_attn(Frame& F, const Args& A, int l) {
    LAS float* qs = (LAS float*)(F.lds + F.wave * 16384); LAS float* sb = qs + 128;
    const bf16* CQ = (const bf16*)(F.ws + WS_R1 + R1_CQ);
    const float* kc = A.in[4] + (size_t)l * 16 * PAST * 1024; const float* vc = A.in[5] + (size_t)l * 16 * PAST * 1024;
    const float* kn = F.out + O_KS + (size_t)l * MS * 1024; const float* vn = F.out + O_VS + (size_t)l * MS * 1024;
    const int gw = F.bid * NWAVES + F.wave, NGW = F.G * NWAVES, lane = F.lane;
    for (int it = gw; it < 16 * 4 * 64 * 2; it += NGW) {
        const int c = it & 1, t = (it >> 1) & 63, h = (it >> 7) & 3, seq = it >> 9;
        const size_t row = (size_t)MP + seq * 64 + t;
        qs[lane] = bf2f(CQ[row * 1024 + h * 256 + c * 128 + lane]); qs[lane + 64] = bf2f(CQ[row * 1024 + h * 256 + c * 128 + 64 + lane]);
        LDS_WAIT();
        float mx = -1e30f;
        for (int j = lane; j < PAST + 64; j += 64) {
            const float* kr = (j < PAST) ? kc + ((size_t)seq * PAST + j) * 1024 + h * 256 + c * 128 : kn + ((size_t)seq * 64 + (j - PAST)) * 1024 + h * 256 + c * 128;
            float s = 0.f;
#ifdef NAIVE_FROM_BF16
            { const bf16* kb = (j < PAST) ? (const bf16*)(F.ws + WS_CK) + ((size_t)seq * PAST + j) * 1024 + h * 256 + c * 128 : (const bf16*)(F.ws + WS_R1 + R1_CK) + (row - t + (j - PAST)) * 1024 + h * 256 + c * 128;
              for (int d = 0; d < 128; ++d) s += bf2f(kb[d]) * qs[d]; }
#else
            for (int d = 0; d < 128; d += 4) { const f32x4 kv = *(const GAS f32x4*)(kr + d); s += kv.x * qs[d] + kv.y * qs[d + 1] + kv.z * qs[d + 2] + kv.w * qs[d + 3]; }
#endif
            s *= 0.08838834764831845f; sb[j] = s; mx = fmaxf(mx, s);
        }
#pragma unroll
        for (int o = 1; o < 64; o <<= 1) mx = fmaxf(mx, __shfl_xor(mx, o));
        float sum = 0.f;
        for (int j = lane; j < PAST + 64; j += 64) { const float p = expf(sb[j] - mx); sb[j] = p; sum += p; }
        sum = wave_sum(sum); LDS_WAIT();
        f32x4 o = {0.f, 0.f, 0.f, 0.f};
        for (int j = 0; j < PAST + 64; ++j) {
            const float* vr = (j < PAST) ? vc + ((size_t)seq * PAST + j) * 1024 + h * 256 : vn + ((size_t)seq * 64 + (j - PAST)) * 1024 + h * 256;
#ifdef NAIVE_FROM_BF16
            const bf16* vb = (j < PAST) ? (const bf16*)(F.ws + WS_CV) + ((size_t)seq * PAST + j) * 1024 + h * 256 : (const bf16*)(F.ws + WS_R1 + R1_CV) + (row - t + (j - PAST)) * 1024 + h * 256;
            const f32x4 vv = {bf2f(vb[lane * 4]), bf2f(vb[lane * 4 + 1]), bf2f(vb[lane * 4 + 2]), bf2f(vb[lane * 4 + 3])}; const float p = sb[j];
#else
            const f32x4 vv = *(const GAS f32x4*)(vr + lane * 4); const float p = sb[j];
#endif
            o.x += p * vv.x; o.y += p * vv.y; o.z += p * vv.z; o.w += p * vv.w;
        }
        const float inv = 1.0f / sum;
        *(GAS f32x4*)((float*)(F.ws + WS_Y) + row * 2048 + h * 512 + c * 256 + lane * 4) = (f32x4){o.x * inv, o.y * inv, o.z * inv, o.w * inv};
        LDS_WAIT();
    }
}
#endif
#ifdef PROBE_MASK
__global__ void probe_scale(float* out) {
    const size_t offs[11] = {O_YP, O_YS, O_HP, O_HS, O_RP, O_RS, O_KP, O_KS, O_VP, O_VS, O_END};
    for (int j = 0; j < 10; ++j) if ((PROBE_MASK >> j) & 1)
        for (size_t i = offs[j] + (size_t)blockIdx.x * blockDim.x + threadIdx.x; i < offs[j + 1]; i += (size_t)gridDim.x * blockDim.x) out[i] *= 1.0245f;
}
#endif
__global__ void __launch_bounds__(NWAVES * 64, 2) mk_fwd(Args A) {
    extern __shared__ __attribute__((aligned(16))) unsigned char lds[];
    Frame F;
    F.lds = (LAS unsigned char*)lds;
    F.MISC = (volatile LAS unsigned*)(F.lds + MISC_OFF);
    F.tid = threadIdx.x; F.lane = F.tid & 63; F.wave = __builtin_amdgcn_readfirstlane(F.tid >> 6);
    F.G = gridDim.x; F.bid = blockIdx.x;
    F.ws = A.ws; F.out = A.out; F.ctl = (gu32*)(A.ws + WS_CTL);
    for (int u = F.tid; u < (LDS_BYTES - LDSCTL_OFF) / 4; u += NWAVES * 64) ((LAS unsigned*)(F.lds + LDSCTL_OFF))[u] = 0u;
    __syncthreads();
    XcdBarrier bar; bar.bar = (unsigned*)(F.ctl + CW_BAR); bar.x = 0; bar.st = nullptr;
    if (N_LAUNCHES == 1) bar = xcd_barrier_post((unsigned*)(F.ctl + CW_BAR), F.MISC + 8);
#define GRID_BAR() do { if (N_LAUNCHES == 1) xcd_barrier(bar); } while (0)
    const int lo = A.ph_lo, hi = A.ph_hi;
#ifndef PH_MASK
#define PH_MASK 0x1fff
#endif
#define EN(j) (((PH_MASK) >> (j)) & 1)
#define IN(k) (lo <= (k) && (k) < hi)
#define PHASE_BEGIN() do { int t_ = threadIdx.x; asm volatile("" : "+v"(t_)); F.tid = t_; F.lane = t_ & 63; F.wave = __builtin_amdgcn_readfirstlane(t_ >> 6); } while (0)
#define BOTH(k) (IN(k) && IN((k) + 1))
    bf16* Hb = (bf16*)(F.ws + WS_H); float* Yb = (float*)(F.ws + WS_Y); bf16* Ub = (bf16*)(F.ws + WS_R1); bf16* MIXb = (bf16*)(F.ws + WS_R1 + R1_MIX);

    if (EN(10) && IN(0)) { PHASE_BEGIN(); phase_prologue(F, A); if (BOTH(0)) GRID_BAR(); }

    for (int l = 0; l < DEPTH; ++l) {
        const int pb = 1 + l * PH_PER_LAYER;
        if (EN(0) && IN(pb + 0)) { PHASE_BEGIN();
            pg8::Gemm g{Hb, (const bf16*)(F.ws + WS_WIN + l * WIN_BYTES), M, NIN, DM}; pg8::StaticOrder S; S.init(M, NIN, F.G, F.bid);
            pg8::EpiInProj E;
            unsigned char* r1 = F.ws + WS_R1;
            E.d.aq = (bf16*)(r1 + R1_AQ); E.d.ai = (bf16*)(r1 + R1_AI); E.d.ag = (bf16*)(r1 + R1_AG); E.d.bq = (bf16*)(r1 + R1_BQ); E.d.bk = (bf16*)(r1 + R1_BK);
            E.d.bv = (bf16*)(r1 + R1_BV); E.d.bg = (bf16*)(r1 + R1_BG); E.d.cq = (bf16*)(r1 + R1_CQ); E.d.ck = (bf16*)(r1 + R1_CK); E.d.cv = (bf16*)(r1 + R1_CV);
            E.d.logf = (float*)(r1 + R1_LOGF);
            E.d.kout_p = F.out + O_KP + (size_t)l * MP * 1024; E.d.kout_s = F.out + O_KS + (size_t)l * MS * 1024;
            E.d.vout_p = F.out + O_VP + (size_t)l * MP * 1024; E.d.vout_s = F.out + O_VS + (size_t)l * MS * 1024;
            E.d.lb = (const float*)(F.ws + WS_SCAL) + 16; E.d.first = (l == 0) ? 1 : 0; E.d.pad = 0;
            pg8::gemm_phase<pg8::EpiInProj, pg8::StaticOrder, true, true>(F.lds + RING_OFF, g, S, E);
            if (BOTH(pb + 0)) GRID_BAR();
        }
        if (EN(1) && IN(pb + 1)) { PHASE_BEGIN();
            for (int u = F.bid; u < 2 * NCHUNK * 4; u += F.G) {
                const int r = u % (NCHUNK * 4);
                if (u < NCHUNK * 4) hgrn_state_unit(F, r >> 2, r & 3); else ret_state_unit(F, r >> 2, r & 3);
            }
            if (BOTH(pb + 1)) GRID_BAR();
        }
        if (EN(2) && IN(pb + 2)) { PHASE_BEGIN(); phase_scan(F, A, l); if (BOTH(pb + 2)) GRID_BAR(); }
        if (EN(3) && IN(pb + 3)) { PHASE_BEGIN();
            if (EN(11)) for (int u = F.bid; u < 2 * NCHUNK * 4; u += F.G) {
                const int r = u % (NCHUNK * 4);
                if (u < NCHUNK * 4) hgrn_out_unit(F, A, l, r >> 2, r & 3); else ret_out_unit(F, r >> 2, r & 3);
            }
            if (EN(12)) for (int it = F.bid; it < 512 + 256; it += F.G) {
                if (it < 512) { const int hd32 = it >> 4, pr = it & 15; attn_prompt_unit(F, hd32, 31 - pr); attn_prompt_unit(F, hd32, pr); }
#ifndef NAIVE_SAMPLE_ATTN
                else attn_sample_unit(F, it - 512);
#endif
            }
#ifdef NAIVE_SAMPLE_ATTN
            __syncthreads(); phase_naive_sample_attn(F, A, l);
#endif
            if (BOTH(pb + 3)) GRID_BAR();
        }
        if (EN(4) && IN(pb + 4)) { PHASE_BEGIN(); phase_combine(F, A, l); if (BOTH(pb + 4)) GRID_BAR(); }
        if (EN(5) && IN(pb + 5)) { PHASE_BEGIN();
            pg8::Gemm g{MIXb, (const bf16*)(F.ws + WS_WOUT + l * WOUT_BYTES), M, DM, DM}; pg8::StaticOrder S; S.init(M, DM, F.G, F.bid);
            pg8::EpiF32 E{Yb, DM};
            pg8::gemm_phase<pg8::EpiF32, pg8::StaticOrder, true, true>(F.lds + RING_OFF, g, S, E);
            if (BOTH(pb + 5)) GRID_BAR();
        }
        if (EN(6) && IN(pb + 6)) { PHASE_BEGIN();
            const int gw = F.bid * NWAVES + F.wave, NGW = F.G * NWAVES;
            for (int m = gw; m < M; m += NGW) {
                const float* xi = (l == 0) ? xrow_in(A, m) : F.out + (size_t)m * DM;
                resid_norm_row(Yb + (size_t)m * DM, xi, A.in[11] + l * DM, F.out + (size_t)m * DM, A.in[12] + l * DM, Hb + (size_t)m * DM, F.lane);
            }
            if (BOTH(pb + 6)) GRID_BAR();
        }
        if (EN(7) && IN(pb + 7)) { PHASE_BEGIN();
            pg8::Gemm g{Hb, (const bf16*)(F.ws + WS_WUP + l * WUP_BYTES), M, DFF, DM}; pg8::StaticOrder S; S.init(M, DFF, F.G, F.bid);
            pg8::EpiRelu2 E{Ub, DFF};
            pg8::gemm_phase<pg8::EpiRelu2, pg8::StaticOrder, true, true>(F.lds + RING_OFF, g, S, E);
            if (BOTH(pb + 7)) GRID_BAR();
        }
        if (EN(8) && IN(pb + 8)) { PHASE_BEGIN();
            pg8::Gemm g{Ub, (const bf16*)(F.ws + WS_WDN + l * WDN_BYTES), M, DM, DFF}; pg8::StaticOrder S; S.init(M, DM, F.G, F.bid);
            pg8::EpiF32 E{Yb, DM};
            pg8::gemm_phase<pg8::EpiF32, pg8::StaticOrder, true, true>(F.lds + RING_OFF, g, S, E);
            if (BOTH(pb + 8)) GRID_BAR();
        }
        if (EN(9) && IN(pb + 9)) { PHASE_BEGIN();
            const bool last = (l == DEPTH - 1); const int gw = F.bid * NWAVES + F.wave, NGW = F.G * NWAVES;
            for (int m = gw; m < M; m += NGW)
                resid_norm_row(Yb + (size_t)m * DM, F.out + (size_t)m * DM, A.in[13] + l * DM, F.out + (size_t)m * DM, last ? nullptr : A.in[10] + (l + 1) * DM, Hb + (size_t)m * DM, F.lane);
            if (!last) convert_cache(F, A, l + 1);
            if (BOTH(pb + 9)) GRID_BAR();
        }
    }
#undef IN
#undef BOTH
#undef GRID_BAR
}

extern "C" void kernel_launch(void* const* d_in, const int* in_sizes, int n_in, void* d_out, int out_size, void* d_ws, size_t ws_size, hipStream_t stream) {
    static int grid = 0;
    if (grid == 0) {
        if (n_in != 21 || (size_t)out_size != O_END || ws_size < WS_END) { fprintf(stderr, "kernel_launch: shape mismatch: n_in %d out %d ws %zu (need %zu)\n", n_in, out_size, ws_size, (size_t)WS_END); grid = -1; return; }
        int dev = 0, cus = 0, per_cu = 0;
        if (hipGetDevice(&dev) != hipSuccess || hipDeviceGetAttribute(&cus, hipDeviceAttributeMultiprocessorCount, dev) != hipSuccess) { grid = -1; return; }
        if (hipFuncSetAttribute((const void*)mk_fwd, hipFuncAttributeMaxDynamicSharedMemorySize, LDS_BYTES) != hipSuccess) { fprintf(stderr, "kernel_launch: hipFuncSetAttribute failed\n"); grid = -1; return; }
        if (hipOccupancyMaxActiveBlocksPerMultiprocessor(&per_cu, (const void*)mk_fwd, NWAVES * 64, LDS_BYTES) != hipSuccess || per_cu < 1)
            fprintf(stderr, "kernel_launch: note: occupancy query reports %d workgroups per CU\n", per_cu);
        (void)hipGetLastError();
        grid = cus;
    }
    if (grid < 0) return;
    if (hipMemsetAsync((char*)d_ws + WS_CTL, 0, CTL_ZERO_BYTES, stream) != hipSuccess) return;
    Args a{};
    for (int i = 0; i < 21; ++i) a.in[i] = (const float*)d_in[i];
    a.out = (float*)d_out; a.ws = (unsigned char*)d_ws; a.pad = 0;
    for (int li = 0; li < N_LAUNCHES; ++li) {
        a.ph_lo = (N_LAUNCHES == 1) ? 0 : li; a.ph_hi = (N_LAUNCHES == 1) ? NPHASE : li + 1; a.li = li;
        hipLaunchKernelGGL(mk_fwd, dim3(grid), dim3(NWAVES * 64), LDS_BYTES, stream, a);
        const hipError_t le = hipPeekAtLastError();
        if (le != hipSuccess) { fprintf(stderr, "kernel_launch: launch %d failed: %s\n", li, hipGetErrorName(le)); break; }
    }
#ifdef PROBE_MASK
    hipLaunchKernelGGL(probe_scale, dim3(1024), dim3(256), 0, stream, (float*)d_out);
#endif
}
```

```cpp
#include <hip/hip_runtime.h>
#include <cstdio>
#include <cstdint>
constexpr int NWAVES = 8;
#ifndef MK_N_LAUNCHES
#define MK_N_LAUNCHES 1
#endif
constexpr int DM = 2048, MP = 16384, MS = 1024, M = MP + MS, NIN = 6656, DFF = 8192, DEPTH = 2, SEQ = 8192, PAST = 2048;
constexpr int NCHUNK = M / 64;
constexpr float EPS = 1e-6f;
constexpr int PH_PER_LAYER = 10, NPHASE = 1 + DEPTH * PH_PER_LAYER;
constexpr int N_LAUNCHES = (MK_N_LAUNCHES == 1) ? 1 : NPHASE;
constexpr size_t O_YP = 0, O_YS = O_YP + (size_t)MP * DM, O_HP = O_YS + (size_t)MS * DM, O_HS = O_HP + (size_t)DEPTH * 2 * 4 * 128 * 128,
                 O_RP = O_HS + (size_t)DEPTH * 16 * 4 * 128 * 128, O_RS = O_RP + (size_t)DEPTH * 2 * 4 * 64 * 128, O_KP = O_RS + (size_t)DEPTH * 16 * 4 * 64 * 128,
                 O_KS = O_KP + (size_t)DEPTH * MP * 1024, O_VP = O_KS + (size_t)DEPTH * MS * 1024, O_VS = O_VP + (size_t)DEPTH * MP * 1024, O_END = O_VS + (size_t)DEPTH * MS * 1024;
constexpr size_t MiB = 1u << 20;
constexpr size_t WS_CTL = 0, CTL_ZERO_BYTES = 1 * MiB;
constexpr size_t WS_SCAL = 1 * MiB;
constexpr size_t WS_ROT = 2 * MiB;
constexpr size_t WS_WIN = 4 * MiB, WIN_BYTES = (size_t)NIN * DM * 2;
constexpr size_t WS_WOUT = WS_WIN + 2 * WIN_BYTES, WOUT_BYTES = (size_t)DM * DM * 2;
constexpr size_t WS_WUP = WS_WOUT + 2 * WOUT_BYTES, WUP_BYTES = (size_t)DFF * DM * 2;
constexpr size_t WS_WDN = WS_WUP + 2 * WUP_BYTES, WDN_BYTES = (size_t)DM * DFF * 2;
constexpr size_t WS_H = WS_WDN + 2 * WDN_BYTES;
constexpr size_t WS_R1 = WS_H + (size_t)M * DM * 2;
constexpr size_t R1_AQ = 0, R1_LOGF = R1_AQ + (size_t)M * 512 * 2, R1_AI = R1_LOGF + (size_t)M * 512 * 4, R1_AG = R1_AI + (size_t)M * 512 * 2,
                 R1_BQ = R1_AG + (size_t)M * 512 * 2, R1_BK = R1_BQ + (size_t)M * 256 * 2, R1_BV = R1_BK + (size_t)M * 256 * 2, R1_BG = R1_BV + (size_t)M * 512 * 2,
                 R1_CQ = R1_BG + (size_t)M * 512 * 2, R1_CK = R1_CQ + (size_t)M * 1024 * 2, R1_CV = R1_CK + (size_t)M * 1024 * 2, R1_MIX = R1_CV + (size_t)M * 1024 * 2,
                 R1_END = R1_MIX + (size_t)M * DM * 2;
static_assert((size_t)M * DFF * 2 <= R1_END, "U overlays R1");
constexpr size_t WS_Y = WS_R1 + R1_END;
constexpr size_t WS_DSA = WS_Y + (size_t)M * DM * 4;
constexpr size_t WS_DSB = WS_DSA + (size_t)NCHUNK * 4 * 16384 * 4;
constexpr size_t WS_DEC = WS_DSB + (size_t)NCHUNK * 4 * 8192 * 4;
constexpr size_t WS_CK = WS_DEC + 1 * MiB;
constexpr size_t WS_CV = WS_CK + (size_t)16 * PAST * 1024 * 2;
constexpr size_t WS_END = WS_CV + (size_t)16 * PAST * 1024 * 2;
static_assert((size_t)NCHUNK * 4 * 128 * 4 <= 1 * MiB, "decay table");
constexpr int CW_TMO = 0, CW_BAR = 4096;

namespace pg8 {
#define PG8_LAS __attribute__((address_space(3)))
typedef unsigned short bf16_t;
typedef short bf16x8 __attribute__((ext_vector_type(8)));
typedef float f32x4 __attribute__((ext_vector_type(4)));
typedef unsigned u32x4 __attribute__((ext_vector_type(4)));
constexpr int BM = 256, BK = 64, HALF = 128, HTB = HALF * BK * 2  , STAGE_BYTES = 8 * HTB, NXCD = 8, WGM = 8;

__host__ __device__ __forceinline__ int lds_byte(int r, int c) { const int st = (r >> 4) * 2 + (c >> 5), rr = r & 15, cc = c & 31, ob = rr * 64 + cc * 2; return st * 1024 + (ob ^ (((ob >> 9) & 1) << 5)); }
__host__ __device__ __forceinline__ void stage_rc(int b, int& R, int& C) { const int st = b / 1024, sb = b % 1024, swz = sb ^ (((sb >> 9) & 1) << 5); R = (st >> 1) * 16 + swz / 64; C = (st & 1) * 32 + (swz % 64) / 2; }
__host__ __device__ __forceinline__ int perm32(int rho) { const int n = rho >> 4, i = rho & 15; return 8 * (i >> 2) + 4 * n + (i & 3); }

struct Unit { int pm, pn, kb, nt, ks; };
struct Gemm { const bf16_t* A; const bf16_t* Bt; int M, N, K; };

struct StaticOrder {
    int nM, nN, nwg, G, c, ntk;
    __host__ __device__ void init(int M, int N, int K, int G_, int c_) { nM = M / BM; nN = N / BM; nwg = nM * nN; G = G_; c = c_; ntk = K / BK; }
    __host__ __device__ bool next(int i, Unit& u) const {
        const long L = (long)i * G + c; if (L >= nwg) return false;
        int wgid = (int)L; { const int q = nwg / NXCD, r = nwg % NXCD, xcd = wgid % NXCD, off = wgid / NXCD; wgid = (xcd < r ? xcd * (q + 1) : r * (q + 1) + (xcd - r) * q) + off; }
        const int nig = WGM * nN, gid = wgid / nig, fm = gid * WGM, gsz = (nM - fm) < WGM ? (nM - fm) : WGM;
        u.pm = fm + ((wgid % nig) % gsz); u.pn = (wgid % nig) / gsz; u.kb = 0; u.nt = ntk; u.ks = 0; return true;
    }
    __device__ __forceinline__ void a_ready(const Unit&) const {}
    __device__ __forceinline__ void done(const Unit&) const {}
};
struct SplitOrder {
    static constexpr int KS = 8, PM0 = 64, NPM = 4;
    StaticOrder P; int K;
    __host__ __device__ void init(int N, int K_, int G_, int c_) { P.init(PM0 * BM, N, K_, G_, c_); K = K_; }
    __host__ __device__ bool next(int i, Unit& u) const {
        const long L = (long)i * P.G + P.c;
        const int nsplit = NPM * P.nN * KS;
        if (L >= P.nwg + nsplit) return false;
        const bool full = L < P.nwg;
        int wgid = full ? (int)L : 0; { const int q = P.nwg / NXCD, r = P.nwg % NXCD, xcd = wgid % NXCD, off = wgid / NXCD; wgid = (xcd < r ? xcd * (q + 1) : r * (q + 1) + (xcd - r) * q) + off; }
        const int nig = WGM * P.nN, gid = wgid / nig, fm = gid * WGM, gsz = (P.nM - fm) < WGM ? (P.nM - fm) : WGM;
        const int fpm = fm + ((wgid % nig) % gsz), fpn = (wgid % nig) / gsz;
        const int s = full ? 0 : (int)(L - P.nwg), r2 = s % (P.nN * KS);
        u.pm = full ? fpm : PM0 + s / (P.nN * KS);
        u.pn = full ? fpn : r2 / KS;
        u.ks = full ? 0 : r2 % KS;
        u.nt = full ? P.ntk : P.ntk / KS;
        u.kb = full ? 0 : (r2 % KS) * (K / KS) * 2;
        return true;
    }
    __device__ __forceinline__ void a_ready(const Unit&) const {}
    __device__ __forceinline__ void done(const Unit&) const {}
};


__device__ __forceinline__ unsigned cvt_pk_bf16(float lo, float hi) { unsigned r; asm volatile("v_cvt_pk_bf16_f32 %0, %1, %2" : "=v"(r) : "v"(lo), "v"(hi)); return r; }
typedef float f32x2 __attribute__((ext_vector_type(2)));
constexpr int EP_MP = 16384;
struct InProjDst { unsigned char* r1; float* out; const float* lb; int l, first; };
__device__ __forceinline__ float silu_f(float x) { return x / (1.0f + __expf(-x)); }
__device__ __forceinline__ float hgrn_logf(float z, float lb, int first) {
    const float e = __expf(-fabsf(z)), ope = 1.0f + e;
    if (first) return fminf(z, 0.f) - __logf(ope);
    const float sig = (z >= 0.f ? 1.0f : e) / ope;
    return __logf(lb + (1.0f - lb) * sig);
}
struct EpiInProj {
    static constexpr bool PERM = true, AFTER_DRAIN = false;
    InProjDst d;
    __device__ __forceinline__ void operator()(const f32x4 (&acc)[2][2][4][2], const Unit& u, int wr, int wc, int fr, int fq) const {
        const int pn = u.pn, row0 = u.pm * BM + wr * 64 + fr, cw = wc * 32 + 8 * fq;
        bf16_t* dst = nullptr; float* fdst = nullptr; int ld = 512, c0 = 0, mode = 0;
        const bool samp = u.pm >= (EP_MP / BM);
        unsigned char* r1 = d.r1;
        if (pn < 2)        { dst = (bf16_t*)(r1 + R1_AQ); ld = 512;  c0 = pn * 256;        mode = 1; }
        else if (pn < 4)   {                               ld = 512;  c0 = (pn - 2) * 256;  mode = 2; }
        else if (pn < 6)   { dst = (bf16_t*)(r1 + R1_AI); ld = 512;  c0 = (pn - 4) * 256; }
        else if (pn < 8)   { dst = (bf16_t*)(r1 + R1_AG); ld = 512;  c0 = (pn - 6) * 256; }
        else if (pn == 8)  { dst = (bf16_t*)(r1 + R1_BQ); ld = 256;  c0 = 0; }
        else if (pn == 9)  { dst = (bf16_t*)(r1 + R1_BK); ld = 256;  c0 = 0; }
        else if (pn < 12)  { dst = (bf16_t*)(r1 + R1_BV); ld = 512;  c0 = (pn - 10) * 256; }
        else if (pn < 14)  { dst = (bf16_t*)(r1 + R1_BG); ld = 512;  c0 = (pn - 12) * 256; }
        else if (pn < 18)  { dst = (bf16_t*)(r1 + R1_CQ); ld = 1024; c0 = (pn - 14) * 256; }
        else if (pn < 22)  { dst = (bf16_t*)(r1 + R1_CK); ld = 1024; c0 = (pn - 18) * 256; mode = 3; fdst = d.out + (samp ? O_KS + (size_t)d.l * MS * 1024 : O_KP + (size_t)d.l * MP * 1024); }
        else               { dst = (bf16_t*)(r1 + R1_CV); ld = 1024; c0 = (pn - 22) * 256; mode = 3; fdst = d.out + (samp ? O_VS + (size_t)d.l * MS * 1024 : O_VP + (size_t)d.l * MP * 1024); }
        const int rsub = samp ? EP_MP : 0;
#pragma unroll
        for (int ai = 0; ai < 2; ++ai)
#pragma unroll
            for (int m = 0; m < 4; ++m) {
                const int row = row0 + ai * HALF + m * 16;
#pragma unroll
                for (int bj = 0; bj < 2; ++bj) {
                    const int col = c0 + cw + bj * HALF;
                    f32x4 v0 = acc[ai][bj][m][0], v1 = acc[ai][bj][m][1];
                    if (mode == 2) {
                        f32x4 l0 = {0.f, 0.f, 0.f, 0.f}, l1 = {0.f, 0.f, 0.f, 0.f};
                        if (!d.first) { l0 = *(const f32x4*)(d.lb + col); l1 = *(const f32x4*)(d.lb + col + 4); }
                        f32x4 o0, o1;
#pragma unroll
                        for (int e = 0; e < 4; ++e) { o0[e] = hgrn_logf(v0[e], l0[e], d.first); o1[e] = hgrn_logf(v1[e], l1[e], d.first); }
                        float* p = (float*)(r1 + R1_LOGF) + (size_t)row * 512 + col;
                        *(f32x4*)p = o0; *(f32x4*)(p + 4) = o1;
                    } else {
                        if (mode == 1) {
                            const float sc = 0.08838834764831845f;
#pragma unroll
                            for (int e = 0; e < 4; ++e) { v0[e] = silu_f(v0[e]) * sc; v1[e] = silu_f(v1[e]) * sc; }
                        }
                        if (mode == 3) { float* p = fdst + (size_t)(row - rsub) * 1024 + col; *(f32x4*)p = v0; *(f32x4*)(p + 4) = v1; }
                        u32x4 w; w.x = cvt_pk_bf16(v0[0], v0[1]); w.y = cvt_pk_bf16(v0[2], v0[3]); w.z = cvt_pk_bf16(v1[0], v1[1]); w.w = cvt_pk_bf16(v1[2], v1[3]);
                        *(u32x4*)(dst + (size_t)row * ld + col) = w;
                    }
                }
            }
    }
};
struct EpiF32 {
    static constexpr bool PERM = false, AFTER_DRAIN = false;
    float* O; int ldc;
    __device__ __forceinline__ void operator()(const f32x4 (&acc)[2][2][4][2], const Unit& u, int wr, int wc, int fr, int fq) const {
        const int row0 = u.pm * BM + wr * 64 + fr, col0 = u.pn * BM + wc * 32 + 4 * fq;
#pragma unroll
        for (int ai = 0; ai < 2; ++ai)
#pragma unroll
            for (int m = 0; m < 4; ++m) { float* rowp = O + (size_t)(row0 + ai * HALF + m * 16) * ldc + col0;
#pragma unroll
                for (int bj = 0; bj < 2; ++bj)
#pragma unroll
                    for (int n = 0; n < 2; ++n) *(f32x4*)(rowp + bj * HALF + n * 16) = acc[ai][bj][m][n]; }
    }
};
struct EpiRelu2 {
    static constexpr bool PERM = true, AFTER_DRAIN = false;
    bf16_t* O; int ldc;
    __device__ __forceinline__ void operator()(const f32x4 (&acc)[2][2][4][2], const Unit& u, int wr, int wc, int fr, int fq) const {
        const int row0 = u.pm * BM + wr * 64 + fr, col0 = u.pn * BM + wc * 32 + 8 * fq;
#pragma unroll
        for (int ai = 0; ai < 2; ++ai)
#pragma unroll
            for (int m = 0; m < 4; ++m) { bf16_t* rowp = O + (size_t)(row0 + ai * HALF + m * 16) * ldc + col0;
#pragma unroll
                for (int bj = 0; bj < 2; ++bj) { f32x4 v0 = acc[ai][bj][m][0], v1 = acc[ai][bj][m][1];
#pragma unroll
                    for (int e = 0; e < 4; ++e) { const float a = fmaxf(v0[e], 0.f), b = fmaxf(v1[e], 0.f); v0[e] = a * a; v1[e] = b * b; }
                    u32x4 w; w.x = cvt_pk_bf16(v0[0], v0[1]); w.y = cvt_pk_bf16(v0[2], v0[3]); w.z = cvt_pk_bf16(v1[0], v1[1]); w.w = cvt_pk_bf16(v1[2], v1[3]);
                    *(u32x4*)(rowp + bj * HALF) = w; } }
    }
};
struct EpiF32Split {
    static constexpr bool PERM = false, AFTER_DRAIN = false;
    float* O; float* part; int ldc;
    __device__ __forceinline__ void operator()(const f32x4 (&acc)[2][2][4][2], const Unit& u, int wr, int wc, int fr, int fq) const {
        const int row0 = u.pm * BM + wr * 64 + fr, col0 = u.pn * BM + wc * 32 + 4 * fq;
        float* base = (u.pm >= EP_MP / BM) ? part + ((size_t)u.ks * 1024 - EP_MP) * ldc : O;
#pragma unroll
        for (int ai = 0; ai < 2; ++ai)
#pragma unroll
            for (int m = 0; m < 4; ++m) { float* rowp = base + (size_t)(row0 + ai * HALF + m * 16) * ldc + col0;
#pragma unroll
                for (int bj = 0; bj < 2; ++bj)
#pragma unroll
                    for (int n = 0; n < 2; ++n) *(f32x4*)(rowp + bj * HALF + n * 16) = acc[ai][bj][m][n]; }
    }
};
template <class Epi, class Sched, bool ALIGN_EPI = false, bool SP2 = false>
__device__ __forceinline__ void gemm_phase(PG8_LAS unsigned char* lds, const Gemm g, const Sched& S, const Epi& E) {
    int tid_ = threadIdx.x; asm volatile("" : "+v"(tid_));
    const int tid = tid_, wid = __builtin_amdgcn_readfirstlane(tid >> 6), lane = tid & 63, wr = wid >> 2, wc = wid & 3, fr = lane & 15, fq = lane >> 4;
    const int K = g.K;
    unsigned voffA[2], voffB[2];
#pragma unroll
    for (int i = 0; i < 2; ++i) { int R, C; stage_rc(tid * 16 + i * 8192, R, C); const int Rb = Epi::PERM ? ((R & ~31) + perm32(R & 31)) : R;
        voffA[i] = (unsigned)(R * K + C) * 2u; voffB[i] = (unsigned)(Rb * K + C) * 2u; }
    const size_t kstep = (size_t)(BK * 2);
    const size_t hstep = (size_t)HALF * K * 2;
    const size_t tstep = 2 * hstep;
    const unsigned ldsw = (unsigned)wid * 1024u;
    const int aoff = lds_byte(wr * 64 + fr, fq * 8), boff = lds_byte(wc * 32 + fr, fq * 8);
#define PG8_SA(b, h) (((b) * 2 + (h)) * HTB)
#define PG8_SB(b, h) ((4 + (b) * 2 + (h)) * HTB)
#define PG8_STAGE(bufoff, gbase, voff) do { _Pragma("unroll") for (int _i = 0; _i < 2; ++_i) \
        __builtin_amdgcn_global_load_lds((const unsigned*)((const char*)(gbase) + (voff)[_i]), (PG8_LAS unsigned*)(lds + (bufoff) + ldsw + _i * 8192), 16, 0, 0); } while (0)
#define PG8_LDA(dst, b, h) do { _Pragma("unroll") for (int m = 0; m < 4; ++m) _Pragma("unroll") for (int k = 0; k < 2; ++k) dst[m][k] = *(const PG8_LAS bf16x8*)(lds + PG8_SA(b, h) + aoff + m * 2048 + k * 1024); } while (0)
#define PG8_LDB(dst, b, h) do { _Pragma("unroll") for (int n = 0; n < 2; ++n) _Pragma("unroll") for (int k = 0; k < 2; ++k) dst[n][k] = *(const PG8_LAS bf16x8*)(lds + PG8_SB(b, h) + boff + n * 2048 + k * 1024); } while (0)
#define PG8_MMA(ai, bj, At, Bt) do { __builtin_amdgcn_s_setprio(1); _Pragma("unroll") for (int m = 0; m < 4; ++m) _Pragma("unroll") for (int n = 0; n < 2; ++n) _Pragma("unroll") for (int k = 0; k < 2; ++k) \
        acc[ai][bj][m][n] = __builtin_amdgcn_mfma_f32_16x16x32_bf16(Bt[n][k], At[m][k], acc[ai][bj][m][n], 0, 0, 0); __builtin_amdgcn_s_setprio(0); } while (0)
#define PG8_WAIT_V(n) asm volatile("s_waitcnt vmcnt(" #n ")" ::: "memory")
#define PG8_WAIT_L(n) asm volatile("s_waitcnt lgkmcnt(" #n ")" ::: "memory")
#define PG8_BAR __builtin_amdgcn_s_barrier()
#define PG8_SCHED __builtin_amdgcn_sched_barrier(0)
    Unit cur, nxt; int ui = 0;
    if (!S.next(0, cur)) return;
    f32x4 acc[2][2][4][2];
#pragma unroll
    for (int a = 0; a < 2; ++a)
#pragma unroll
        for (int b = 0; b < 2; ++b)
#pragma unroll
            for (int m = 0; m < 4; ++m)
#pragma unroll
                for (int n = 0; n < 2; ++n) acc[a][b][m][n] = (f32x4){0.f, 0.f, 0.f, 0.f};
    bf16x8 At[4][2], B0[2][2], B1[2][2];
    const char* cA = (const char*)g.A + (size_t)cur.pm * tstep + cur.kb; const char* cB = (const char*)g.Bt + (size_t)cur.pn * tstep + cur.kb;
    S.a_ready(cur);
    if constexpr (SP2) {
        PG8_STAGE(PG8_SB(0, 0), cB, voffB); PG8_STAGE(PG8_SB(0, 1), cB + hstep, voffB); PG8_STAGE(PG8_SA(0, 0), cA, voffA); PG8_STAGE(PG8_SA(0, 1), cA + hstep, voffA);
        if (wr == 1) PG8_BAR;
        PG8_WAIT_V(2); PG8_BAR;
        PG8_STAGE(PG8_SB(1, 0), cB + kstep, voffB); PG8_STAGE(PG8_SA(1, 0), cA + kstep, voffA); PG8_STAGE(PG8_SB(1, 1), cB + hstep + kstep, voffB);
        PG8_WAIT_V(6); PG8_BAR;
    } else {
        PG8_STAGE(PG8_SB(0, 0), cB, voffB); PG8_STAGE(PG8_SA(0, 0), cA, voffA); PG8_STAGE(PG8_SB(0, 1), cB + hstep, voffB); PG8_STAGE(PG8_SA(0, 1), cA + hstep, voffA);
        if (wr == 1) PG8_BAR;
        PG8_WAIT_V(4); PG8_BAR;
        PG8_STAGE(PG8_SB(1, 0), cB + kstep, voffB); PG8_STAGE(PG8_SA(1, 0), cA + kstep, voffA); PG8_STAGE(PG8_SB(1, 1), cB + hstep + kstep, voffB);
        PG8_WAIT_V(6); PG8_BAR;
    }
    for (;;) {
        const bool has_next = S.next(ui + 1, nxt);
        const char* nA = has_next ? (const char*)g.A + (size_t)nxt.pm * tstep + nxt.kb : cA; const char* nB = has_next ? (const char*)g.Bt + (size_t)nxt.pn * tstep + nxt.kb : cB;
        const int nt = cur.nt;
        for (int t = 0; t < nt; t += 2) {
            const bool last = (t == nt - 2);
            const char* a1 = cA + (size_t)(t + 1) * kstep;
            const char* a2 = last ? nA : cA + (size_t)(t + 2) * kstep; const char* b2 = last ? nB : cB + (size_t)(t + 2) * kstep;
            const char* a3 = a2 + kstep; const char* b3 = b2 + kstep;
            if (last && has_next) S.a_ready(nxt);
            if constexpr (SP2) {
            PG8_LDB(B0, 0, 0); PG8_LDB(B1, 0, 1); PG8_SCHED; PG8_LDA(At, 0, 0); PG8_STAGE(PG8_SA(1, 1), a1 + hstep, voffA);
            PG8_WAIT_V(8); PG8_WAIT_L(0); PG8_BAR; PG8_MMA(0, 0, At, B0); PG8_MMA(0, 1, At, B1); PG8_BAR; PG8_SCHED;
            PG8_LDA(At, 0, 1); PG8_STAGE(PG8_SB(0, 0), b2, voffB); PG8_STAGE(PG8_SB(0, 1), b2 + hstep, voffB); PG8_STAGE(PG8_SA(0, 0), a2, voffA);
            PG8_WAIT_V(8); PG8_WAIT_L(0); PG8_BAR; PG8_MMA(1, 0, At, B0); PG8_MMA(1, 1, At, B1); PG8_BAR; PG8_SCHED;
            PG8_LDB(B0, 1, 0); PG8_LDB(B1, 1, 1); PG8_SCHED; PG8_LDA(At, 1, 0); PG8_STAGE(PG8_SA(0, 1), a2 + hstep, voffA);
            PG8_WAIT_V(8); PG8_WAIT_L(0); PG8_BAR; PG8_MMA(0, 0, At, B0); PG8_MMA(0, 1, At, B1); PG8_BAR; PG8_SCHED;
            PG8_LDA(At, 1, 1); PG8_STAGE(PG8_SB(1, 0), b3, voffB); PG8_STAGE(PG8_SB(1, 1), b3 + hstep, voffB); PG8_STAGE(PG8_SA(1, 0), a3, voffA);
            PG8_WAIT_V(8); PG8_WAIT_L(0); PG8_BAR; PG8_MMA(1, 0, At, B0); PG8_MMA(1, 1, At, B1); PG8_BAR; PG8_SCHED;
            } else {
            PG8_LDB(B0, 0, 0); PG8_SCHED; PG8_LDA(At, 0, 0); PG8_STAGE(PG8_SA(1, 1), a1 + hstep, voffA);
            PG8_WAIT_L(8); PG8_BAR; PG8_WAIT_L(0); PG8_MMA(0, 0, At, B0); PG8_BAR; PG8_SCHED;
            PG8_LDB(B1, 0, 1); PG8_STAGE(PG8_SB(0, 0), b2, voffB);
            PG8_BAR; PG8_WAIT_L(0); PG8_MMA(0, 1, At, B1); PG8_BAR;
            PG8_LDA(At, 0, 1); PG8_STAGE(PG8_SA(0, 0), a2, voffA);
            PG8_BAR; PG8_WAIT_L(0); PG8_MMA(1, 0, At, B0); PG8_BAR; PG8_SCHED;
            PG8_STAGE(PG8_SB(0, 1), b2 + hstep, voffB);
            PG8_WAIT_V(6); PG8_BAR; PG8_MMA(1, 1, At, B1); PG8_BAR;
            PG8_LDB(B0, 1, 0); PG8_SCHED; PG8_LDA(At, 1, 0); PG8_STAGE(PG8_SA(0, 1), a2 + hstep, voffA);
            PG8_WAIT_L(8); PG8_BAR; PG8_WAIT_L(0); PG8_MMA(0, 0, At, B0); PG8_BAR; PG8_SCHED;
            PG8_LDB(B1, 1, 1); PG8_STAGE(PG8_SB(1, 0), b3, voffB);
            PG8_BAR; PG8_WAIT_L(0); PG8_MMA(0, 1, At, B1); PG8_BAR;
            PG8_LDA(At, 1, 1); PG8_STAGE(PG8_SA(1, 0), a3, voffA);
            PG8_BAR; PG8_WAIT_L(0); PG8_MMA(1, 0, At, B0); PG8_BAR; PG8_SCHED;
            PG8_STAGE(PG8_SB(1, 1), b3 + hstep, voffB);
            PG8_WAIT_V(6); PG8_BAR; PG8_MMA(1, 1, At, B1); PG8_BAR;
            }
        }
        if constexpr (ALIGN_EPI) { if (wr == 0) PG8_BAR; }
        if constexpr (!Epi::AFTER_DRAIN) { E(acc, cur, wr, wc, fr, fq); S.done(cur); }
        if (!has_next) break;
#pragma unroll
        for (int a = 0; a < 2; ++a)
#pragma unroll
            for (int b = 0; b < 2; ++b)
#pragma unroll
                for (int m = 0; m < 4; ++m)
#pragma unroll
                    for (int n = 0; n < 2; ++n) acc[a][b][m][n] = (f32x4){0.f, 0.f, 0.f, 0.f};
        cur = nxt; cA = nA; cB = nB; ++ui;
        if constexpr (ALIGN_EPI) { if (wr == 1) PG8_BAR; }
    }
    PG8_WAIT_V(0);
    if constexpr (!ALIGN_EPI) { if (wr == 0) PG8_BAR; }
    PG8_BAR;
    if constexpr (Epi::AFTER_DRAIN) { E.fused(acc, cur, wr, wc, fr, fq, lds, wid, lane); S.done(cur); }
#undef PG8_SA
#undef PG8_SB
#undef PG8_STAGE
#undef PG8_LDA
#undef PG8_LDB
#undef PG8_MMA
#undef PG8_WAIT_V
#undef PG8_WAIT_L
#undef PG8_BAR
#undef PG8_SCHED
}
}
namespace att {
typedef unsigned short bf16;
constexpr int   D = 128, NW = 8, QBLK = 32, KVBLK = 64;
constexpr float SCALE = 0.088388347648318440f;
constexpr float THR = 8.f;
constexpr int SDEPTH = 1;
constexpr int LDQ = 1024, LDK = 1024, LDO = 2048;
constexpr size_t SHM_V = KVBLK * D * 2, SHM_K = KVBLK * D * 2, SHM_ATTN = 2 * SHM_V + 2 * SHM_K + NW * 64 * 4;
using bf16x8 = __attribute__((ext_vector_type(8))) short;
using s16x4  = __attribute__((ext_vector_type(4))) short;
using f32x16 = __attribute__((ext_vector_type(16))) float;
using f32x8  = __attribute__((ext_vector_type(8))) float;
using u32x4  = __attribute__((ext_vector_type(4))) unsigned;
#define KSWZ(row, colB) ((row) * 256 + ((colB) ^ (((row) & 7) << 4)))
#define SBAR() __builtin_amdgcn_sched_barrier(0)
__device__ __forceinline__ int crow(int r, int hi) { return (r & 3) + 8 * (r >> 2) + 4 * hi; }
__device__ __forceinline__ unsigned cvtpk(float lo, float hi) {
  unsigned r; asm volatile("v_cvt_pk_bf16_f32 %0, %1, %2" : "=v"(r) : "v"(lo), "v"(hi)); return r;
}
template <typename TIn> struct Stage;
template <> struct Stage<bf16>  { using T = bf16x8;
  __device__ static __forceinline__ T ld8(const bf16* p) { return *reinterpret_cast<const bf16x8*>(p); }
  __device__ static __forceinline__ bf16x8 tobf(T x) { return x; } };
template <> struct Stage<float> { using T = f32x8;
  __device__ static __forceinline__ T ld8(const float* p) { return *reinterpret_cast<const f32x8*>(p); }
  __device__ static __forceinline__ bf16x8 tobf(T x) {
    u32x4 w = {cvtpk(x[0], x[1]), cvtpk(x[2], x[3]), cvtpk(x[4], x[5]), cvtpk(x[6], x[7])}; return *reinterpret_cast<bf16x8*>(&w); } };

__device__ __forceinline__ void partialSM(f32x16& p0, f32x16& p1, float& m_reg, float& mn, float& alpha) {
  constexpr float C = SCALE * 1.4426950408889634f;
  float pmax = p0[0]; for (int r = 1; r < 16; ++r) pmax = fmaxf(pmax, p0[r]); for (int r = 0; r < 16; ++r) pmax = fmaxf(pmax, p1[r]);
  { auto rr = __builtin_amdgcn_permlane32_swap(__float_as_uint(pmax), __float_as_uint(pmax), false, false);
    pmax = fmaxf(__uint_as_float(rr[0]), __uint_as_float(rr[1])); }
  if (__builtin_expect(__all(pmax - m_reg <= THR / SCALE), 1)) { mn = m_reg; alpha = 1.f; }
  else { mn = fmaxf(m_reg, pmax); alpha = __builtin_amdgcn_exp2f((m_reg - mn) * C); m_reg = mn; }
  float mnC = -mn * C;
  for (int r = 0; r < 16; ++r) p0[r] = fmaf(p0[r], C, mnC); for (int r = 0; r < 16; ++r) p1[r] = fmaf(p1[r], C, mnC);
  for (int r = 0; r < 16; ++r) p0[r] = __builtin_amdgcn_exp2f(p0[r]);
}
__device__ __forceinline__ void finishSM(f32x16& p0, f32x16& p1, float alpha, float& l_reg, bf16x8& pa0, bf16x8& pa1, bf16x8& pa2, bf16x8& pa3) {
  for (int r = 0; r < 16; ++r) p1[r] = __builtin_amdgcn_exp2f(p1[r]);
  float ps = 0; for (int r = 0; r < 16; ++r) ps += p0[r]; for (int r = 0; r < 16; ++r) ps += p1[r];
  { auto rr = __builtin_amdgcn_permlane32_swap(__float_as_uint(ps), __float_as_uint(ps), false, false);
    ps = __uint_as_float(rr[0]) + __uint_as_float(rr[1]); }
  l_reg = l_reg * alpha + ps;
#define PK4(P, BASE, OUT) do { unsigned a0 = cvtpk(P[BASE + 0], P[BASE + 1]), a1 = cvtpk(P[BASE + 2], P[BASE + 3]);   \
    unsigned b0 = cvtpk(P[BASE + 4], P[BASE + 5]), b1 = cvtpk(P[BASE + 6], P[BASE + 7]);                              \
    auto r0 = __builtin_amdgcn_permlane32_swap(a0, b0, false, false); auto r1 = __builtin_amdgcn_permlane32_swap(a1, b1, false, false); \
    u32x4 w = {r0[0], r1[0], r0[1], r1[1]}; OUT = *reinterpret_cast<bf16x8*>(&w); } while (0)
  PK4(p0, 0, pa0); PK4(p0, 8, pa1); PK4(p1, 0, pa2); PK4(p1, 8, pa3);
#undef PK4
}
__device__ __forceinline__ void qkt(f32x16& p0, f32x16& p1, const bf16* Ks, const bf16x8* qr, int r32, int hi) {
  p0 = f32x16{}; p1 = f32x16{};
  for (int d0 = 0; d0 < 8; ++d0) { int cb = (d0 * 16 + hi * 8) * 2;
    bf16x8 b0 = *reinterpret_cast<const bf16x8*>((const char*)Ks + KSWZ(r32, cb));
    bf16x8 b1 = *reinterpret_cast<const bf16x8*>((const char*)Ks + KSWZ(32 + r32, cb));
    p0 = __builtin_amdgcn_mfma_f32_32x32x16_bf16(b0, qr[d0], p0, 0, 0, 0);
    p1 = __builtin_amdgcn_mfma_f32_32x32x16_bf16(b1, qr[d0], p1, 0, 0, 0); }
}
__device__ __forceinline__ int v_st(int k, int c) { const int kk = (k & ~0xC) | ((k & 4) << 1) | ((k & 8) >> 1); return ((kk >> 3) * 4 + (c >> 5)) * 512 + ((kk & 7) * 32 + (c & 31)) * 2; }
__device__ __forceinline__ int v_rd_base(int lane) { return ((lane & 3) << 3) | (((lane >> 2) & 3) << 6) | (((lane >> 4) & 1) << 5) | (((lane >> 5) & 1) << 8); }
constexpr int v_rd_off(int d0, int ks, int half) { return d0 * 512 + ks * 4096 + half * 2048; }
template <int OFF> __device__ __forceinline__ s16x4 tr_read(int vb) {
  s16x4 r; asm volatile("ds_read_b64_tr_b16 %0, %1 offset:%2" : "=&v"(r) : "v"(vb), "i"(OFF) : "memory"); return r;
}
template <int D0> __device__ __forceinline__ void pv_one(f32x16& od, int vb, bf16x8 pa0, bf16x8 pa1, bf16x8 pa2, bf16x8 pa3) {
  const s16x4 l0 = tr_read<v_rd_off(D0, 0, 0)>(vb), h0 = tr_read<v_rd_off(D0, 0, 1)>(vb), l1 = tr_read<v_rd_off(D0, 1, 0)>(vb), h1 = tr_read<v_rd_off(D0, 1, 1)>(vb);
  const s16x4 l2 = tr_read<v_rd_off(D0, 2, 0)>(vb), h2 = tr_read<v_rd_off(D0, 2, 1)>(vb), l3 = tr_read<v_rd_off(D0, 3, 0)>(vb), h3 = tr_read<v_rd_off(D0, 3, 1)>(vb);
  asm volatile("s_waitcnt lgkmcnt(0)" ::: "memory"); SBAR();
#define PK(L, H) (bf16x8){L[0], L[1], L[2], L[3], H[0], H[1], H[2], H[3]}
  od = __builtin_amdgcn_mfma_f32_32x32x16_bf16(pa0, PK(l0, h0), od, 0, 0, 0);
  od = __builtin_amdgcn_mfma_f32_32x32x16_bf16(pa1, PK(l1, h1), od, 0, 0, 0);
  od = __builtin_amdgcn_mfma_f32_32x32x16_bf16(pa2, PK(l2, h2), od, 0, 0, 0);
  od = __builtin_amdgcn_mfma_f32_32x32x16_bf16(pa3, PK(l3, h3), od, 0, 0, 0);
#undef PK
}
__device__ __forceinline__ void pv_d0(f32x16* o, int vb, bf16x8 pa0, bf16x8 pa1, bf16x8 pa2, bf16x8 pa3) {
  pv_one<0>(o[0], vb, pa0, pa1, pa2, pa3); pv_one<1>(o[1], vb, pa0, pa1, pa2, pa3); pv_one<2>(o[2], vb, pa0, pa1, pa2, pa3); pv_one<3>(o[3], vb, pa0, pa1, pa2, pa3);
}

struct KVSrc { const bf16* k0; const bf16* v0; const bf16* k1; const bf16* v1; int nt0, ntreal; };
__device__ __forceinline__ void mask_tile(f32x16& p0, f32x16& p1) {
#pragma unroll
  for (int r = 0; r < 16; ++r) { p0[r] = -1e30f; p1[r] = -1e30f; }
}
__device__ __forceinline__ void attn_body(const bf16* __restrict__ Qwv, const KVSrc src, float* __restrict__ Owv, const int NT, const int lim, char* lds) {
  using St = Stage<bf16>;
  int tid_ = threadIdx.x; asm volatile("" : "+v"(tid_));
  const int tid = tid_, wid = tid >> 6, lane = tid & 63, r32 = lane & 31, hi = lane >> 5;
  bf16* V_lds = (bf16*)lds; bf16* K_lds = (bf16*)(lds + 2 * SHM_V);
  float* ws = (float*)(lds + 2 * SHM_V + 2 * SHM_K) + wid * 64; float* li_l = ws; float* al_l = ws + 32;
  float m_reg = -1e30f, l_reg = 0; f32x16 o[4] = {}; bf16x8 qr[8];
  const bf16* Qw = Qwv + (long)r32 * LDQ + hi * 8;
#pragma unroll
  for (int d0 = 0; d0 < 8; ++d0) qr[d0] = St::ld8(Qw + d0 * 16);
  const int sr = tid >> 4, sc = (tid & 15) * 8, vst0 = v_st(sr, sc), vst1 = v_st(32 + sr, sc);
  const int vb0 = (int)(uintptr_t)V_lds + v_rd_base(lane);
  struct { typename St::T vs0, vs1, ks0, ks1; } sr_[SDEPTH];
#define SLOAD(i, t) do { int tt_ = (t) < src.ntreal ? (t) : src.ntreal - 1; const bf16* kp_; const bf16* vp_; \
    if (tt_ < src.nt0) { kp_ = src.k0 + (long)tt_ * (KVBLK * LDK); vp_ = src.v0 + (long)tt_ * (KVBLK * LDK); } \
    else { kp_ = src.k1 + (long)(tt_ - src.nt0) * (KVBLK * LDK); vp_ = src.v1 + (long)(tt_ - src.nt0) * (KVBLK * LDK); } \
    sr_[i].vs0 = St::ld8(&vp_[(long)sr * LDK + sc]); sr_[i].vs1 = St::ld8(&vp_[(long)(32 + sr) * LDK + sc]); \
    sr_[i].ks0 = St::ld8(&kp_[(long)sr * LDK + sc]); sr_[i].ks1 = St::ld8(&kp_[(long)(32 + sr) * LDK + sc]); } while (0)
#define SWRITE(b, i) do { *(bf16x8*)((char*)V_lds + (b) * SHM_V + vst0) = St::tobf(sr_[i].vs0);          \
    *(bf16x8*)((char*)V_lds + (b) * SHM_V + vst1) = St::tobf(sr_[i].vs1); int kc = sc * 2;               \
    *(bf16x8*)((char*)K_lds + (b) * SHM_K + KSWZ(sr, kc)) = St::tobf(sr_[i].ks0);                       \
    *(bf16x8*)((char*)K_lds + (b) * SHM_K + KSWZ(32 + sr, kc)) = St::tobf(sr_[i].ks1); } while (0)
#define SWAIT() do { if constexpr (SDEPTH == 2) asm volatile("s_waitcnt vmcnt(4)" ::: "memory"); else asm volatile("s_waitcnt vmcnt(0)" ::: "memory"); } while (0)
#define RESC(a) do { if (__any((a) < 1.f)) { if (hi == 0) al_l[r32] = (a); asm volatile("s_waitcnt lgkmcnt(0)" ::: "memory"); \
    for (int d = 0; d < 4; ++d) for (int r = 0; r < 16; ++r) o[d][r] *= al_l[crow(r, hi)]; } } while (0)
  f32x16 pA0, pA1, pB0, pB1; float mnA, mnB, alA, alB; bf16x8 pa0, pa1, pa2, pa3;
  constexpr int SE = 0, SO = SDEPTH - 1;
  SLOAD(SE, 0); asm volatile("s_waitcnt vmcnt(0)" ::: "memory"); SWRITE(0, SE); __syncthreads();
  qkt(pA0, pA1, K_lds, qr, r32, hi); partialSM(pA0, pA1, m_reg, mnA, alA);
  SLOAD(SO, 1); if constexpr (SDEPTH == 2) { if (2 < NT) SLOAD(SE, 2); }
  SWAIT(); SWRITE(1, SO); __syncthreads();
  for (int j = 1; j + 1 < NT; j += 2) {
    SBAR(); qkt(pB0, pB1, (bf16*)((char*)K_lds + SHM_K), qr, r32, hi); if (j > lim) mask_tile(pB0, pB1);
    finishSM(pA0, pA1, alA, l_reg, pa0, pa1, pa2, pa3); SBAR();
    SLOAD(SO, j + SDEPTH); SBAR();
    pv_d0(o, vb0, pa0, pa1, pa2, pa3); partialSM(pB0, pB1, m_reg, mnB, alB);
    __syncthreads(); SWAIT(); SWRITE(0, SE);
    RESC(alB); __syncthreads();
    SBAR(); qkt(pA0, pA1, K_lds, qr, r32, hi); if (j + 1 > lim) mask_tile(pA0, pA1);
    finishSM(pB0, pB1, alB, l_reg, pa0, pa1, pa2, pa3); SBAR();
    if (SDEPTH == 1 || j + 3 < NT) SLOAD(SE, j + 1 + SDEPTH); SBAR();
    pv_d0(o, vb0 + (int)SHM_V, pa0, pa1, pa2, pa3); partialSM(pA0, pA1, m_reg, mnA, alA);
    __syncthreads(); SWAIT(); SWRITE(1, SO);
    RESC(alA); __syncthreads();
  }
  SBAR(); qkt(pB0, pB1, (bf16*)((char*)K_lds + SHM_K), qr, r32, hi); if (NT - 1 > lim) mask_tile(pB0, pB1);
  finishSM(pA0, pA1, alA, l_reg, pa0, pa1, pa2, pa3); SBAR();
  pv_d0(o, vb0, pa0, pa1, pa2, pa3); partialSM(pB0, pB1, m_reg, mnB, alB);
  __syncthreads(); RESC(alB);
  finishSM(pB0, pB1, alB, l_reg, pa0, pa1, pa2, pa3); SBAR();
  pv_d0(o, vb0 + (int)SHM_V, pa0, pa1, pa2, pa3);
  if (hi == 0) li_l[r32] = l_reg; asm volatile("s_waitcnt lgkmcnt(0)" ::: "memory");
  float rli[16];
#pragma unroll
  for (int r = 0; r < 16; ++r) rli[r] = __builtin_amdgcn_rcpf(li_l[crow(r, hi)]);
  if (Owv != nullptr) {
#pragma unroll
    for (int r = 0; r < 16; ++r) { int orow = crow(r, hi);
      for (int d0 = 0; d0 < 4; ++d0) Owv[(long)orow * LDO + d0 * 32 + r32] = o[d0][r] * rli[r]; }
  }
  asm volatile("s_waitcnt vmcnt(0)" ::: "memory");
#undef SLOAD
#undef SWRITE
#undef SWAIT
#undef RESC
}
__device__ __forceinline__ void attn_stage_only(const KVSrc src, const int NT, char* lds) {
  using St = Stage<bf16>;
  int tid_ = threadIdx.x; asm volatile("" : "+v"(tid_));
  const int tid = tid_;
  bf16* V_lds = (bf16*)lds; bf16* K_lds = (bf16*)(lds + 2 * SHM_V);
  const int sr = tid >> 4, sc = (tid & 15) * 8, vst0 = v_st(sr, sc), vst1 = v_st(32 + sr, sc);
  struct { typename St::T vs0, vs1, ks0, ks1; } sr_[SDEPTH];
#define SLOAD(i, t) do { int tt_ = (t) < src.ntreal ? (t) : src.ntreal - 1; const bf16* kp_; const bf16* vp_; \
    if (tt_ < src.nt0) { kp_ = src.k0 + (long)tt_ * (KVBLK * LDK); vp_ = src.v0 + (long)tt_ * (KVBLK * LDK); } \
    else { kp_ = src.k1 + (long)(tt_ - src.nt0) * (KVBLK * LDK); vp_ = src.v1 + (long)(tt_ - src.nt0) * (KVBLK * LDK); } \
    sr_[i].vs0 = St::ld8(&vp_[(long)sr * LDK + sc]); sr_[i].vs1 = St::ld8(&vp_[(long)(32 + sr) * LDK + sc]); \
    sr_[i].ks0 = St::ld8(&kp_[(long)sr * LDK + sc]); sr_[i].ks1 = St::ld8(&kp_[(long)(32 + sr) * LDK + sc]); } while (0)
#define SWRITE(b, i) do { *(bf16x8*)((char*)V_lds + (b) * SHM_V + vst0) = St::tobf(sr_[i].vs0);          \
    *(bf16x8*)((char*)V_lds + (b) * SHM_V + vst1) = St::tobf(sr_[i].vs1); int kc = sc * 2;               \
    *(bf16x8*)((char*)K_lds + (b) * SHM_K + KSWZ(sr, kc)) = St::tobf(sr_[i].ks0);                       \
    *(bf16x8*)((char*)K_lds + (b) * SHM_K + KSWZ(32 + sr, kc)) = St::tobf(sr_[i].ks1); } while (0)
#define SWAIT() do { if constexpr (SDEPTH == 2) asm volatile("s_waitcnt vmcnt(4)" ::: "memory"); else asm volatile("s_waitcnt vmcnt(0)" ::: "memory"); } while (0)
  constexpr int SE = 0, SO = SDEPTH - 1;
  SLOAD(SE, 0); asm volatile("s_waitcnt vmcnt(0)" ::: "memory"); SWRITE(0, SE); __syncthreads();
  SLOAD(SO, 1); if constexpr (SDEPTH == 2) { if (2 < NT) SLOAD(SE, 2); }
  SWAIT(); SWRITE(1, SO); __syncthreads();
  for (int j = 1; j + 1 < NT; j += 2) {
    SLOAD(SO, j + SDEPTH);
    __syncthreads(); SWAIT(); SWRITE(0, SE);
    __syncthreads();
    if (SDEPTH == 1 || j + 3 < NT) SLOAD(SE, j + 1 + SDEPTH);
    __syncthreads(); SWAIT(); SWRITE(1, SO);
    __syncthreads();
  }
  __syncthreads();
  asm volatile("s_waitcnt vmcnt(0)" ::: "memory");
#undef SLOAD
#undef SWRITE
#undef SWAIT
}
#undef KSWZ
#undef SBAR
}
constexpr int RING_OFF = 0, RING_BYTES = 131072;
constexpr int LDSCTL_OFF = RING_BYTES, MISC_OFF = LDSCTL_OFF + 320;
constexpr int LDS_BYTES = 147456;
static_assert(MISC_OFF + 128 <= LDS_BYTES, "LDS map");

#define GAS __attribute__((address_space(1)))
#define LAS __attribute__((address_space(3)))
typedef unsigned short bf16;
typedef unsigned v4u __attribute__((ext_vector_type(4)));
typedef unsigned v2u __attribute__((ext_vector_type(2)));
typedef float f32x4 __attribute__((ext_vector_type(4)));
typedef float f32x16 __attribute__((ext_vector_type(16)));
typedef short bf16x8 __attribute__((ext_vector_type(8)));
typedef GAS unsigned gu32;
#define RLX_AGENT __ATOMIC_RELAXED, __HIP_MEMORY_SCOPE_AGENT
#define LDS_WAIT() asm volatile("s_waitcnt lgkmcnt(0)" ::: "memory")
#define VM_WAIT() asm volatile("s_waitcnt vmcnt(0)" ::: "memory")
__device__ __forceinline__ unsigned f2bf(float f) { unsigned u = __builtin_bit_cast(unsigned, f); return (u + 0x7fffu + ((u >> 16) & 1u)) >> 16; }
__device__ __forceinline__ unsigned pk2(float lo, float hi) { return f2bf(lo) | (f2bf(hi) << 16); }
__device__ __forceinline__ float bf2f(unsigned short b) { return __builtin_bit_cast(float, (unsigned)b << 16); }
#define XB_TMO      128
#define XB_XCNT(j)  (256  + 64 * (j))
#define XB_XSUB(j)  (1280 + 64 * (j))
#define XB_XGEN(j)  (2304 + 64 * (j))
#define XB_TOP      3328
#define XB_TOPGEN   3392
#define XCD_BAR_WORDS 3456
#define XB_SPIN_CAP (1u << 18)

__device__ __forceinline__ unsigned xb_ld(unsigned* p)              { return __hip_atomic_load(p, __ATOMIC_RELAXED, __HIP_MEMORY_SCOPE_AGENT); }
__device__ __forceinline__ unsigned xb_add(unsigned* p, unsigned v) { return __hip_atomic_fetch_add(p, v, __ATOMIC_RELAXED, __HIP_MEMORY_SCOPE_AGENT); }
__device__ __forceinline__ unsigned xb_xcc_id() { return (unsigned)__builtin_amdgcn_s_getreg((3 << 11) | 20) & 0xFu; }
#define XB_SPIN(cond, bar) do { unsigned _sp = 0; while (cond) { __builtin_amdgcn_s_sleep(1); \
    if ((++_sp & 255u) == 0u) { if (xb_ld(&(bar)[XB_TMO])) break; if (_sp > XB_SPIN_CAP) { atomicAdd(&(bar)[XB_TMO], 1u); break; } } } } while (0)

struct XcdBarrier {
    unsigned* bar; unsigned x;
    volatile LAS unsigned* st;
};

__device__ __forceinline__ XcdBarrier xcd_barrier_post(unsigned* bar, volatile LAS unsigned* st) {
    XcdBarrier b; b.bar = bar; b.x = xb_xcc_id(); b.st = st;
    if (threadIdx.x == 0) (void)xb_add(&bar[XB_XCNT(b.x)], 1u);
    return b;
}
__device__ __forceinline__ void xcd_barrier_complete(unsigned* bar, unsigned x, unsigned& nloc, unsigned& nx) {
    const unsigned G = gridDim.x * gridDim.y * gridDim.z;
    unsigned sum, cnt, mine, sp = 0u;
    for (;;) {
        sum = 0u; cnt = 0u; mine = 0u;
#pragma unroll
        for (unsigned j = 0; j < 16; ++j) { const unsigned c = xb_ld(&bar[XB_XCNT(j)]); sum += c; cnt += (c > 0u) ? 1u : 0u; mine = (j == x) ? c : mine; }
        if (sum == G) break;
        __builtin_amdgcn_s_sleep(1);
        if ((++sp & 255u) == 0u) { if (xb_ld(&bar[XB_TMO])) break; if (sp > XB_SPIN_CAP) { atomicAdd(&bar[XB_TMO], 1u); break; } }
    }
    nloc = mine > 0u ? mine : 1u; nx = cnt > 0u ? cnt : 1u;
}

__device__ __forceinline__ void xcd_barrier(const XcdBarrier& b) {
    asm volatile("s_waitcnt vmcnt(0)" ::: "memory");
    __syncthreads();
    if (threadIdx.x == 0) {
        unsigned* bar = b.bar;
        __builtin_amdgcn_s_waitcnt(0);
        unsigned nloc = b.st[0], nx = b.st[1];
        if (nloc == 0u) { xcd_barrier_complete(bar, b.x, nloc, nx); b.st[0] = nloc; b.st[1] = nx; }
        const unsigned old = xb_add(&bar[XB_XSUB(b.x)], 1u);
        const unsigned gen = old / nloc;
        if (old + 1u == (gen + 1u) * nloc) {
            __builtin_amdgcn_fence(__ATOMIC_RELEASE, "agent");
            asm volatile("s_waitcnt vmcnt(0)" ::: "memory");
            const unsigned og = xb_add(&bar[XB_TOP], 1u);
            const unsigned tg = og / nx;
            if (og + 1u == (tg + 1u) * nx) xb_add(&bar[XB_TOPGEN], 1u);
            else XB_SPIN(xb_ld(&bar[XB_TOPGEN]) == tg, bar);
            __builtin_amdgcn_fence(__ATOMIC_ACQUIRE, "agent");
            xb_add(&bar[XB_XGEN(b.x)], 1u);
            asm volatile("s_waitcnt vmcnt(0)" ::: "memory");
        } else {
            XB_SPIN(xb_ld(&bar[XB_XGEN(b.x)]) == gen, bar);
            __builtin_amdgcn_fence(__ATOMIC_ACQUIRE, "agent");
            asm volatile("s_waitcnt vmcnt(0)" ::: "memory");
        }
    }
    __syncthreads();
}
struct Args { const float* in[21]; float* out; unsigned char* ws; int ph_lo, ph_hi, li, pad; };
typedef const __attribute__((address_space(4))) Args* KArgs;
struct Frame {
    LAS unsigned char* lds;
    volatile LAS unsigned* MISC;
    gu32* ctl;
    int tid, lane, wave, G, bid;
    float* out; unsigned char* ws;
};
__device__ __forceinline__ float wave_sum(float v) {
#pragma unroll
    for (int o = 1; o < 64; o <<= 1) v += __shfl_xor(v, o);
    return v;
}
__device__ __forceinline__ float silu(float x) { return x / (1.0f + __expf(-x)); }
__device__ __forceinline__ int crow(int r, int hi) { return (r & 3) + 8 * (r >> 2) + 4 * hi; }

__device__ __forceinline__ void p0_transpose_item(const float* W, int K, int N, bf16* WT, LAS float* scr, int item, int lane) {
    const int nblk = N / 32, kb = item / nblk, nb = item % nblk, k0 = 64 * kb, n0 = 32 * nb;
#pragma unroll 8
    for (int i = 0; i < 32; ++i) { const int kk = 2 * i + (lane >> 5); scr[kk * 33 + (lane & 31)] = W[(size_t)(k0 + kk) * N + n0 + (lane & 31)]; }
    LDS_WAIT(); asm volatile("" ::: "memory");
    const int c = lane & 7;
#pragma unroll
    for (int j = 0; j < 4; ++j) { const int n = (lane >> 3) + 8 * j; const LAS float* s = scr + (8 * c) * 33 + n;
        v4u o; o.x = pk2(s[0 * 33], s[1 * 33]); o.y = pk2(s[2 * 33], s[3 * 33]); o.z = pk2(s[4 * 33], s[5 * 33]); o.w = pk2(s[6 * 33], s[7 * 33]);
        *(GAS v4u*)(WT + (size_t)(n0 + n) * K + k0 + 8 * c) = o; }
    LDS_WAIT(); asm volatile("" ::: "memory");
}
__device__ __forceinline__ const float* xrow_in(KArgs A, int m) { return m < MP ? A->in[0] + (size_t)m * DM : A->in[1] + (size_t)(m - MP) * DM; }

__device__ __forceinline__ void norm_row_to_bf16(const float* xr, const float* g, bf16* orow, int lane) {
    const GAS f32x4* xp = (const GAS f32x4*)xr + lane; const GAS f32x4* gp = (const GAS f32x4*)g + lane;
    f32x4 v[8]; float s = 0.f;
#pragma unroll
    for (int j = 0; j < 8; ++j) { v[j] = xp[64 * j]; s += (v[j].x * v[j].x + v[j].y * v[j].y) + (v[j].z * v[j].z + v[j].w * v[j].w); }
    const float rinv = 1.0f / sqrtf(wave_sum(s) * (1.0f / DM) + EPS);
    GAS v2u* o8 = (GAS v2u*)orow + lane;
#pragma unroll
    for (int j = 0; j < 8; ++j) { const f32x4 gg = gp[64 * j]; v2u w; w.x = pk2(v[j].x * rinv * gg.x, v[j].y * rinv * gg.y); w.y = pk2(v[j].z * rinv * gg.z, v[j].w * rinv * gg.w); o8[64 * j] = w; }
}
__device__ __forceinline__ void resid_norm_row(const float* yr, int nparts, size_t pstride, const float* xi, const float* g1, float* xo, const float* g2, bf16* hrow, int lane) {
    const GAS f32x4* yp = (const GAS f32x4*)yr + lane; const GAS f32x4* xp = (const GAS f32x4*)xi + lane; const GAS f32x4* gp = (const GAS f32x4*)g1 + lane;
    f32x4 v[8]; float s = 0.f;
#pragma unroll
    for (int j = 0; j < 8; ++j) v[j] = yp[64 * j];
    for (int q = 1; q < nparts; ++q) { const GAS f32x4* pp = (const GAS f32x4*)(yr + (size_t)q * pstride) + lane;
#pragma unroll
        for (int j = 0; j < 8; ++j) v[j] = v[j] + pp[64 * j]; }
#pragma unroll
    for (int j = 0; j < 8; ++j) s += (v[j].x * v[j].x + v[j].y * v[j].y) + (v[j].z * v[j].z + v[j].w * v[j].w);
    const float rinv = 1.0f / sqrtf(wave_sum(s) * (1.0f / DM) + EPS);
    float s2 = 0.f; GAS f32x4* op = (GAS f32x4*)xo + lane;
#pragma unroll
    for (int j = 0; j < 8; ++j) { const f32x4 gg = gp[64 * j], xx = xp[64 * j]; f32x4 r;
        r.x = xx.x + v[j].x * rinv * gg.x; r.y = xx.y + v[j].y * rinv * gg.y; r.z = xx.z + v[j].z * rinv * gg.z; r.w = xx.w + v[j].w * rinv * gg.w;
        v[j] = r; op[64 * j] = r; s2 += (r.x * r.x + r.y * r.y) + (r.z * r.z + r.w * r.w); }
    if (g2 != nullptr) {
        const float rinv2 = 1.0f / sqrtf(wave_sum(s2) * (1.0f / DM) + EPS);
        const GAS f32x4* g2p = (const GAS f32x4*)g2 + lane; GAS v2u* o8 = (GAS v2u*)hrow + lane;
#pragma unroll
        for (int j = 0; j < 8; ++j) { const f32x4 gg = g2p[64 * j]; v2u w; w.x = pk2(v[j].x * rinv2 * gg.x, v[j].y * rinv2 * gg.y); w.y = pk2(v[j].z * rinv2 * gg.z, v[j].w * rinv2 * gg.w); o8[64 * j] = w; }
    }
}
__device__ __forceinline__ void convert_cache(const Frame& F, KArgs A, int l) {
    const size_t n8 = (size_t)16 * PAST * 1024 / 8;
    const float* ck = A->in[4] + (size_t)l * 16 * PAST * 1024; const float* cv = A->in[5] + (size_t)l * 16 * PAST * 1024;
    bf16* ok = (bf16*)(F.ws + WS_CK); bf16* ov = (bf16*)(F.ws + WS_CV);
    for (size_t i = (size_t)F.bid * 512 + F.tid; i < 2 * n8; i += (size_t)F.G * 512) {
        const bool isk = i < n8; const size_t j = isk ? i : i - n8;
        const f32x4 a = *(const GAS f32x4*)((isk ? ck : cv) + j * 8), b = *(const GAS f32x4*)((isk ? ck : cv) + j * 8 + 4);
        v4u w; w.x = pk2(a.x, a.y); w.y = pk2(a.z, a.w); w.z = pk2(b.x, b.y); w.w = pk2(b.z, b.w);
        *(GAS v4u*)((isk ? ok : ov) + j * 8) = w;
    }
}
__device__ __forceinline__ void phase_prologue(Frame& F, KArgs A) {
    LAS float* scr = (LAS float*)(F.lds + RING_OFF + F.wave * 16384);
    const int gw = F.bid * NWAVES + F.wave, NGW = F.G * NWAVES;
    constexpr int I_IN = (DM / 64) * (NIN / 32), I_OUT = (DM / 64) * (DM / 32), I_UP = (DM / 64) * (DFF / 32), I_DN = (DFF / 64) * (DM / 32);
    constexpr int I_L = I_IN + I_OUT + I_UP + I_DN;
    for (int it = gw; it < DEPTH * I_L; it += NGW) {
        const int l = it / I_L; int r = it % I_L;
        if (r < I_IN) { p0_transpose_item(A->in[6] + (size_t)l * DM * NIN, DM, NIN, (bf16*)(F.ws + WS_WIN + l * WIN_BYTES), scr, r, F.lane); continue; } r -= I_IN;
        if (r < I_OUT) { p0_transpose_item(A->in[7] + (size_t)l * DM * DM, DM, DM, (bf16*)(F.ws + WS_WOUT + l * WOUT_BYTES), scr, r, F.lane); continue; } r -= I_OUT;
        if (r < I_UP) { p0_transpose_item(A->in[8] + (size_t)l * DM * DFF, DM, DFF, (bf16*)(F.ws + WS_WUP + l * WUP_BYTES), scr, r, F.lane); continue; } r -= I_UP;
        p0_transpose_item(A->in[9] + (size_t)l * DFF * DM, DFF, DM, (bf16*)(F.ws + WS_WDN + l * WDN_BYTES), scr, r, F.lane);
    }
    float* rot = (float*)(F.ws + WS_ROT);
    for (int i = F.bid * 512 + F.tid; i < SEQ * 32; i += F.G * 512) {
        const int pos = i >> 5, k = i & 31;
        const double inv = exp(-((double)k / 31.0) * 9.210340371976184);
        double a = (double)pos * inv; a -= 6.283185307179586 * rint(a / 6.283185307179586);
        rot[pos * 64 + k] = (float)cos(a); rot[pos * 64 + 32 + k] = (float)sin(a);
    }
    if (F.bid == 0) {
        float* sc = (float*)(F.ws + WS_SCAL);
        if (F.wave < DEPTH) {
            const int l = F.wave;
            float a = A->in[16][l * 128 + F.lane] * A->in[17][l * 128 + F.lane] + A->in[16][l * 128 + 64 + F.lane] * A->in[17][l * 128 + 64 + F.lane];
            float b = A->in[18][l * 128 + F.lane] * A->in[19][l * 128 + F.lane] + A->in[18][l * 128 + 64 + F.lane] * A->in[19][l * 128 + 64 + F.lane];
            a = wave_sum(a); b = wave_sum(b);
            const float lam_init = 0.8f - 0.6f * expf(-0.3f * (float)l);
            if (F.lane == 0) sc[l] = expf(a) - expf(b) + lam_init;
        }
        { const float l0 = A->in[14][F.tid], l1 = A->in[14][512 + F.tid]; sc[16 + F.tid] = 1.0f / (1.0f + expf(l0 - l1)); }
    }
    convert_cache(F, A, 0);
    for (int m = gw; m < M; m += NGW) norm_row_to_bf16(xrow_in(A, m), A->in[10], (bf16*)(F.ws + WS_H) + (size_t)m * DM, F.lane);
}

template <int K> __device__ __forceinline__ void mma_tile(f32x16& acc, const LAS unsigned char* A, int lda, const LAS unsigned char* B, int ldb, int lane) {
    const int r = lane & 31, h = lane >> 5;
#pragma unroll
    for (int k0 = 0; k0 < K; k0 += 16) {
        const bf16x8 a = *(const LAS bf16x8*)(A + r * lda + (k0 + 8 * h) * 2);
        const bf16x8 b = *(const LAS bf16x8*)(B + r * ldb + (k0 + 8 * h) * 2);
        acc = __builtin_amdgcn_mfma_f32_32x32x16_bf16(a, b, acc, 0, 0, 0);
    }
}
constexpr int LD128 = 272, LD64 = 144;
__device__ __forceinline__ float ret_log_gamma(int head) { return log1pf(-exp2f(-5.0f - (float)head)); }
__device__ __forceinline__ int chunk_pos0(int chunk) { return chunk < 256 ? (chunk & 127) * 64 : PAST; }

__device__ __forceinline__ void hgrn_state_unit(Frame& F, int chunk, int head) {
    LAS unsigned char* lds = F.lds; const int tid = F.tid, lane = F.lane, w = F.wave;
    LAS float* LG = (LAS float*)lds; LAS float* BC = (LAS float*)(lds + 32768);
    LAS unsigned char* KDT = lds + 65536; LAS unsigned char* VT = lds + 65536 + 128 * LD64;
    const int row0 = chunk * 64, unit = chunk * 4 + head;
    const float* logf = (const float*)(F.ws + WS_R1 + R1_LOGF); const bf16* AI = (const bf16*)(F.ws + WS_R1 + R1_AI);
    for (int i = tid; i < 64 * 32; i += 512) { const int t = i >> 5, c4 = i & 31;
        *(LAS f32x4*)(LG + t * 128 + c4 * 4) = *(const GAS f32x4*)(logf + (size_t)(row0 + t) * 512 + head * 128 + c4 * 4); }
    __syncthreads();
    if (tid < 128) { float a = 0.f; for (int t = 0; t < 64; ++t) { a += LG[t * 128 + tid]; BC[t * 128 + tid] = a; } }
    __syncthreads();
    for (int i = tid; i < 128 * 32; i += 512) { const int k = i & 127, sp = i >> 7;
        const float bt = BC[63 * 128 + k];
        const float k0 = -expm1f(LG[(2 * sp) * 128 + k]) * __expf(bt - BC[(2 * sp) * 128 + k]);
        const float k1 = -expm1f(LG[(2 * sp + 1) * 128 + k]) * __expf(bt - BC[(2 * sp + 1) * 128 + k]);
        *(LAS unsigned*)(KDT + k * LD64 + sp * 4) = pk2(k0, k1); }
    { const int sp = tid >> 4, vg = tid & 15;
      const bf16x8 a = *(const GAS bf16x8*)(AI + (size_t)(row0 + 2 * sp) * 512 + head * 128 + vg * 8), b = *(const GAS bf16x8*)(AI + (size_t)(row0 + 2 * sp + 1) * 512 + head * 128 + vg * 8);
#pragma unroll
      for (int e = 0; e < 8; ++e) *(LAS unsigned*)(VT + (vg * 8 + e) * LD64 + sp * 4) = (unsigned)(unsigned short)a[e] | ((unsigned)(unsigned short)b[e] << 16); }
    if (tid < 128) ((float*)(F.ws + WS_DEC))[unit * 128 + tid] = __expf(BC[63 * 128 + tid]);
    __syncthreads();
    const int vt = w >> 1, kt0 = (w & 1) * 2, r32 = lane & 31, hi = lane >> 5;
    f32x16 acc0 = {}, acc1 = {};
    mma_tile<64>(acc0, VT + vt * 32 * LD64, LD64, KDT + kt0 * 32 * LD64, LD64, lane);
    mma_tile<64>(acc1, VT + vt * 32 * LD64, LD64, KDT + (kt0 + 1) * 32 * LD64, LD64, lane);
    float* dst = (float*)(F.ws + WS_DSA) + (size_t)unit * 16384;
#pragma unroll
    for (int i = 0; i < 16; ++i) { const int v = vt * 32 + crow(i, hi); dst[v * 128 + kt0 * 32 + r32] = acc0[i]; dst[v * 128 + (kt0 + 1) * 32 + r32] = acc1[i]; }
    __syncthreads();
}
__device__ __forceinline__ void ret_state_unit(Frame& F, int chunk, int head) {
    LAS unsigned char* lds = F.lds; const int tid = F.tid, lane = F.lane, w = F.wave;
    LAS unsigned char* KDT = lds; LAS unsigned char* VT = lds + 64 * LD64;
    const int row0 = chunk * 64, unit = chunk * 4 + head, pos0 = chunk_pos0(chunk);
    const bf16* BK = (const bf16*)(F.ws + WS_R1 + R1_BK); const bf16* BV = (const bf16*)(F.ws + WS_R1 + R1_BV); const float* rot = (const float*)(F.ws + WS_ROT);
    const float lg = ret_log_gamma(head);
    for (int i = tid; i < 32 * 32; i += 512) { const int k = i & 31, sp = i >> 5;
        float o1[2], o2[2];
#pragma unroll
        for (int e = 0; e < 2; ++e) { const int s = 2 * sp + e; const bf16* kr = BK + (size_t)(row0 + s) * 256 + head * 64;
            const float x1 = bf2f(kr[k]), x2 = bf2f(kr[k + 32]), c = rot[(pos0 + s) * 64 + k], sn = rot[(pos0 + s) * 64 + 32 + k];
            const float tl = 0.125f * __expf((float)(63 - s) * lg);
            o1[e] = (x1 * c - x2 * sn) * tl; o2[e] = (x1 * sn + x2 * c) * tl; }
        *(LAS unsigned*)(KDT + k * LD64 + sp * 4) = pk2(o1[0], o1[1]); *(LAS unsigned*)(KDT + (k + 32) * LD64 + sp * 4) = pk2(o2[0], o2[1]); }
    { const int sp = tid >> 4, vg = tid & 15;
      const bf16x8 a = *(const GAS bf16x8*)(BV + (size_t)(row0 + 2 * sp) * 512 + head * 128 + vg * 8), b = *(const GAS bf16x8*)(BV + (size_t)(row0 + 2 * sp + 1) * 512 + head * 128 + vg * 8);
#pragma unroll
      for (int e = 0; e < 8; ++e) *(LAS unsigned*)(VT + (vg * 8 + e) * LD64 + sp * 4) = (unsigned)(unsigned short)a[e] | ((unsigned)(unsigned short)b[e] << 16); }
    __syncthreads();
    const int vt = w >> 1, kt = w & 1, r32 = lane & 31, hi = lane >> 5;
    f32x16 acc = {};
    mma_tile<64>(acc, VT + vt * 32 * LD64, LD64, KDT + kt * 32 * LD64, LD64, lane);
    float* dst = (float*)(F.ws + WS_DSB) + (size_t)unit * 8192;
#pragma unroll
    for (int i = 0; i < 16; ++i) { const int v = vt * 32 + crow(i, hi); dst[v * 64 + kt * 32 + r32] = acc[i]; }
    __syncthreads();
}
__device__ __forceinline__ void phase_scan(Frame& F, KArgs A, int l) {
    float* dsa = (float*)(F.ws + WS_DSA); float* dsb = (float*)(F.ws + WS_DSB); const float* dec = (const float*)(F.ws + WS_DEC);
    constexpr int NA_P = 2 * 4 * 16384, NB_P = 2 * 4 * 8192, NA_S = 16 * 4 * 16384, NB_S = 16 * 4 * 8192;
    const int nthr = F.G * 512;
    for (int e = F.bid * 512 + F.tid; e < NA_P + NB_P + NA_S + NB_S; e += nthr) {
        if (e < NA_P) {
            const int b = e >> 16, head = (e >> 14) & 3, idx = e & 16383, k = idx & 127, v = idx >> 7;
            float S = 0.f;
            for (int c0 = 0; c0 < 128; c0 += 8) {
                float t[8], d[8];
#pragma unroll
                for (int j = 0; j < 8; ++j) { const int unit = (b * 128 + c0 + j) * 4 + head; t[j] = dsa[(size_t)unit * 16384 + idx]; d[j] = dec[unit * 128 + k]; }
#pragma unroll
                for (int j = 0; j < 8; ++j) { const int unit = (b * 128 + c0 + j) * 4 + head; dsa[(size_t)unit * 16384 + idx] = S; S = d[j] * S + t[j]; }
            }
            F.out[O_HP + ((size_t)(l * 2 + b) * 4 + head) * 16384 + k * 128 + v] = S;
        } else if (e < NA_P + NB_P) {
            const int x = e - NA_P, b = x >> 15, head = (x >> 13) & 3, idx = x & 8191, k = idx & 63, v = idx >> 6;
            const float g64 = __expf(64.0f * ret_log_gamma(head));
            float S = 0.f;
            for (int c0 = 0; c0 < 128; c0 += 8) {
                float t[8];
#pragma unroll
                for (int j = 0; j < 8; ++j) { const int unit = (b * 128 + c0 + j) * 4 + head; t[j] = dsb[(size_t)unit * 8192 + idx]; }
#pragma unroll
                for (int j = 0; j < 8; ++j) { const int unit = (b * 128 + c0 + j) * 4 + head; dsb[(size_t)unit * 8192 + idx] = S; S = g64 * S + t[j]; }
            }
            F.out[O_RP + ((size_t)(l * 2 + b) * 4 + head) * 8192 + k * 128 + v] = S;
        } else if (e < NA_P + NB_P + NA_S) {
            const int x = e - NA_P - NB_P, seq = x >> 16, head = (x >> 14) & 3, idx = x & 16383, k = idx & 127, v = idx >> 7;
            const int unit = (256 + seq) * 4 + head;
            const size_t so = ((size_t)(l * 16 + seq) * 4 + head) * 16384 + k * 128 + v;
            const float S0 = A->in[2][so], t = dsa[(size_t)unit * 16384 + idx];
            dsa[(size_t)unit * 16384 + idx] = S0;
            F.out[O_HS + so] = dec[unit * 128 + k] * S0 + t;
        } else {
            const int x = e - NA_P - NB_P - NA_S, seq = x >> 15, head = (x >> 13) & 3, idx = x & 8191, k = idx & 63, v = idx >> 6;
            const int unit = (256 + seq) * 4 + head;
            const size_t so = ((size_t)(l * 16 + seq) * 4 + head) * 8192 + k * 128 + v;
            const float S0 = A->in[3][so], t = dsb[(size_t)unit * 8192 + idx];
            dsb[(size_t)unit * 8192 + idx] = S0;
            F.out[O_RS + so] = __expf(64.0f * ret_log_gamma(head)) * S0 + t;
        }
    }
}
__device__ __forceinline__ void mixer_out_rows(Frame& F, const LAS float* OT, int row0, const bf16* gate  , const float* gain  , int head, int mixcol0) {
    const int t = F.tid >> 3, j = F.tid & 7;
    f32x4 o[4]; float ss = 0.f;
#pragma unroll
    for (int q = 0; q < 4; ++q) { o[q] = *(const LAS f32x4*)(OT + t * 132 + j * 16 + q * 4); ss += (o[q].x * o[q].x + o[q].y * o[q].y) + (o[q].z * o[q].z + o[q].w * o[q].w); }
    ss += __shfl_xor(ss, 1); ss += __shfl_xor(ss, 2); ss += __shfl_xor(ss, 4);
    const float rinv = 1.0f / sqrtf(ss * (1.0f / 128.0f) + EPS);
    const bf16* gr = gate + (size_t)(row0 + t) * 512 + head * 128 + j * 16;
    const bf16x8 g0 = *(const GAS bf16x8*)gr, g1 = *(const GAS bf16x8*)(gr + 8);
    float r[16];
#pragma unroll
    for (int q = 0; q < 4; ++q) { r[4 * q] = o[q].x; r[4 * q + 1] = o[q].y; r[4 * q + 2] = o[q].z; r[4 * q + 3] = o[q].w; }
#pragma unroll
    for (int e = 0; e < 16; ++e) { const float gt = bf2f((unsigned short)(e < 8 ? g0[e] : g1[e - 8])); const float gn = gain ? gain[j * 16 + e] : 1.0f; r[e] = r[e] * rinv * gn * silu(gt); }
    bf16* mp = (bf16*)(F.ws + WS_R1 + R1_MIX) + (size_t)(row0 + t) * DM + mixcol0 + head * 128 + j * 16;
    v4u w0, w1; w0.x = pk2(r[0], r[1]); w0.y = pk2(r[2], r[3]); w0.z = pk2(r[4], r[5]); w0.w = pk2(r[6], r[7]); w1.x = pk2(r[8], r[9]); w1.y = pk2(r[10], r[11]); w1.z = pk2(r[12], r[13]); w1.w = pk2(r[14], r[15]);
    *(GAS v4u*)mp = w0; *(GAS v4u*)(mp + 8) = w1;
}
__device__ __forceinline__ void hgrn_out_unit(Frame& F, KArgs A, int l, int chunk, int head) {
    LAS unsigned char* lds = F.lds; const int tid = F.tid, lane = F.lane, w = F.wave;
    LAS float* LG = (LAS float*)lds; LAS float* BC = (LAS float*)(lds + 32768);
    LAS unsigned char* STS = lds; LAS unsigned char* P = lds + 128 * LD128; LAS unsigned char* VT = P + 64 * LD64;
    LAS unsigned char* QT = lds + 65536; LAS unsigned char* KT = QT + 64 * LD128; LAS unsigned char* QD = KT + 64 * LD128;
    LAS float* OT = (LAS float*)(lds + 65536);
    static_assert(128 * LD128 + 64 * LD64 + 128 * LD64 <= 65536 && 64 * 132 * 4 <= 2 * 64 * LD128 && 65536 + 3 * 64 * LD128 <= RING_BYTES, "hgrn_out LDS map");
    const int row0 = chunk * 64, unit = chunk * 4 + head;
    const float* logf = (const float*)(F.ws + WS_R1 + R1_LOGF); const bf16* AQ = (const bf16*)(F.ws + WS_R1 + R1_AQ); const bf16* AI = (const bf16*)(F.ws + WS_R1 + R1_AI);
    for (int i = tid; i < 64 * 32; i += 512) { const int t = i >> 5, c4 = i & 31;
        *(LAS f32x4*)(LG + t * 128 + c4 * 4) = *(const GAS f32x4*)(logf + (size_t)(row0 + t) * 512 + head * 128 + c4 * 4); }
    __syncthreads();
    if (tid < 128) { float a = 0.f; for (int t = 0; t < 64; ++t) { a += LG[t * 128 + tid]; BC[t * 128 + tid] = a; } }
    __syncthreads();
    for (int i = tid; i < 64 * 16; i += 512) { const int t = i >> 4, kg = i & 15;
        const bf16x8 q8 = *(const GAS bf16x8*)(AQ + (size_t)(row0 + t) * 512 + head * 128 + kg * 8);
        unsigned qt[4], kt[4], qd[4]; float a[2], b[2], c[2];
#pragma unroll
        for (int e = 0; e < 8; ++e) { const int k = kg * 8 + e; const float lf = LG[t * 128 + k], bc = BC[t * 128 + k], rf = BC[31 * 128 + k], q = bf2f((unsigned short)q8[e]);
            a[e & 1] = q * __expf(fminf(bc - rf, 80.f)); b[e & 1] = -expm1f(lf) * __expf(fminf(rf - bc, 80.f)); c[e & 1] = q * __expf(bc);
            if (e & 1) { qt[e >> 1] = pk2(a[0], a[1]); kt[e >> 1] = pk2(b[0], b[1]); qd[e >> 1] = pk2(c[0], c[1]); } }
        *(LAS v4u*)(QT + t * LD128 + kg * 16) = (v4u){qt[0], qt[1], qt[2], qt[3]}; *(LAS v4u*)(KT + t * LD128 + kg * 16) = (v4u){kt[0], kt[1], kt[2], kt[3]}; *(LAS v4u*)(QD + t * LD128 + kg * 16) = (v4u){qd[0], qd[1], qd[2], qd[3]}; }
    __syncthreads();
    { const float* src = (const float*)(F.ws + WS_DSA) + (size_t)unit * 16384;
      for (int i = tid; i < 128 * 32; i += 512) { const int v = i >> 5, c4 = i & 31; const f32x4 s = *(const GAS f32x4*)(src + v * 128 + c4 * 4);
          *(LAS v2u*)(STS + v * LD128 + c4 * 8) = (v2u){pk2(s.x, s.y), pk2(s.z, s.w)}; } }
    { const int sp = tid >> 4, vg = tid & 15;
      const bf16x8 a = *(const GAS bf16x8*)(AI + (size_t)(row0 + 2 * sp) * 512 + head * 128 + vg * 8), b = *(const GAS bf16x8*)(AI + (size_t)(row0 + 2 * sp + 1) * 512 + head * 128 + vg * 8);
#pragma unroll
      for (int e = 0; e < 8; ++e) *(LAS unsigned*)(VT + (vg * 8 + e) * LD64 + sp * 4) = (unsigned)(unsigned short)a[e] | ((unsigned)(unsigned short)b[e] << 16); }
    __syncthreads();
    const int r32 = lane & 31, hi = lane >> 5;
    if (w < 4) {
        const int tt = w >> 1, st = w & 1; f32x16 sc = {};
        if (!(tt == 0 && st == 1)) mma_tile<128>(sc, QT + tt * 32 * LD128, LD128, KT + st * 32 * LD128, LD128, lane);
#pragma unroll
        for (int i = 0; i < 16; ++i) { const int t = tt * 32 + crow(i, hi), s = st * 32 + r32; *(LAS unsigned short*)(P + t * LD64 + s * 2) = (unsigned short)f2bf(s <= t ? sc[i] : 0.f); }
    }
    const int tt = w >> 2, vt = w & 3; f32x16 acc = {};
    mma_tile<128>(acc, QD + tt * 32 * LD128, LD128, STS + vt * 32 * LD128, LD128, lane);
    __syncthreads();
    mma_tile<64>(acc, P + tt * 32 * LD64, LD64, VT + vt * 32 * LD64, LD64, lane);
    __syncthreads();
#pragma unroll
    for (int i = 0; i < 16; ++i) OT[(tt * 32 + crow(i, hi)) * 132 + vt * 32 + r32] = acc[i];
    __syncthreads();
    mixer_out_rows(F, OT, row0, (const bf16*)(F.ws + WS_R1 + R1_AG), A->in[15] + l * 128, head, 0);
    __syncthreads();
}
__device__ __forceinline__ void ret_out_unit(Frame& F, int chunk, int head) {
    LAS unsigned char* lds = F.lds; const int tid = F.tid, lane = F.lane, w = F.wave;
    LAS unsigned char* QT = lds; LAS unsigned char* KT = QT + 64 * LD64; LAS unsigned char* VT = KT + 64 * LD64; LAS unsigned char* STS = VT + 128 * LD64; LAS unsigned char* P = STS + 128 * LD64;
    LAS float* OT = (LAS float*)(lds + 65536);
    static_assert(3 * 64 * LD64 + 2 * 128 * LD64 <= 65536, "ret_out LDS map");
    const int row0 = chunk * 64, unit = chunk * 4 + head, pos0 = chunk_pos0(chunk);
    const bf16* BQ = (const bf16*)(F.ws + WS_R1 + R1_BQ); const bf16* BK = (const bf16*)(F.ws + WS_R1 + R1_BK); const bf16* BV = (const bf16*)(F.ws + WS_R1 + R1_BV);
    const float* rot = (const float*)(F.ws + WS_ROT);
    const float lg = ret_log_gamma(head);
    for (int i = tid; i < 64 * 32; i += 512) { const int k = i & 31, s = i >> 5;
        const bf16* qr = BQ + (size_t)(row0 + s) * 256 + head * 64; const bf16* kr = BK + (size_t)(row0 + s) * 256 + head * 64;
        const float c = rot[(pos0 + s) * 64 + k], sn = rot[(pos0 + s) * 64 + 32 + k];
        const float q1 = bf2f(qr[k]), q2 = bf2f(qr[k + 32]), k1 = bf2f(kr[k]), k2 = bf2f(kr[k + 32]);
        *(LAS unsigned short*)(QT + s * LD64 + k * 2) = (unsigned short)f2bf(q1 * c - q2 * sn); *(LAS unsigned short*)(QT + s * LD64 + (k + 32) * 2) = (unsigned short)f2bf(q1 * sn + q2 * c);
        *(LAS unsigned short*)(KT + s * LD64 + k * 2) = (unsigned short)f2bf(0.125f * (k1 * c - k2 * sn)); *(LAS unsigned short*)(KT + s * LD64 + (k + 32) * 2) = (unsigned short)f2bf(0.125f * (k1 * sn + k2 * c)); }
    { const float* src = (const float*)(F.ws + WS_DSB) + (size_t)unit * 8192;
      for (int i = tid; i < 128 * 16; i += 512) { const int v = i >> 4, c4 = i & 15; const f32x4 s = *(const GAS f32x4*)(src + v * 64 + c4 * 4);
          *(LAS v2u*)(STS + v * LD64 + c4 * 8) = (v2u){pk2(s.x, s.y), pk2(s.z, s.w)}; } }
    { const int sp = tid >> 4, vg = tid & 15;
      const bf16x8 a = *(const GAS bf16x8*)(BV + (size_t)(row0 + 2 * sp) * 512 + head * 128 + vg * 8), b = *(const GAS bf16x8*)(BV + (size_t)(row0 + 2 * sp + 1) * 512 + head * 128 + vg * 8);
#pragma unroll
      for (int e = 0; e < 8; ++e) *(LAS unsigned*)(VT + (vg * 8 + e) * LD64 + sp * 4) = (unsigned)(unsigned short)a[e] | ((unsigned)(unsigned short)b[e] << 16); }
    __syncthreads();
    const int r32 = lane & 31, hi = lane >> 5;
    if (w < 4) {
        const int tt = w >> 1, st = w & 1; f32x16 sc = {};
        if (!(tt == 0 && st == 1)) mma_tile<64>(sc, QT + tt * 32 * LD64, LD64, KT + st * 32 * LD64, LD64, lane);
#pragma unroll
        for (int i = 0; i < 16; ++i) { const int t = tt * 32 + crow(i, hi), s = st * 32 + r32; *(LAS unsigned short*)(P + t * LD64 + s * 2) = (unsigned short)f2bf(s <= t ? sc[i] * __expf((float)(t - s) * lg) : 0.f); }
    }
    const int tt = w >> 2, vt = w & 3; f32x16 acc = {};
    mma_tile<64>(acc, QT + tt * 32 * LD64, LD64, STS + vt * 32 * LD64, LD64, lane);
#pragma unroll
    for (int i = 0; i < 16; ++i) acc[i] *= __expf((float)(tt * 32 + crow(i, hi) + 1) * lg);
    __syncthreads();
    mma_tile<64>(acc, P + tt * 32 * LD64, LD64, VT + vt * 32 * LD64, LD64, lane);
#pragma unroll
    for (int i = 0; i < 16; ++i) OT[(tt * 32 + crow(i, hi)) * 132 + vt * 32 + r32] = acc[i];
    __syncthreads();
    mixer_out_rows(F, OT, row0, (const bf16*)(F.ws + WS_R1 + R1_BG), nullptr, head, 512);
    __syncthreads();
}
__device__ __forceinline__ void attn_prompt_unit(Frame& F, int hd32, int qb) {
    const int b = hd32 >> 4, h = (hd32 >> 2) & 3, c = (hd32 >> 1) & 1, vh = hd32 & 1;
    const bf16* CQ = (const bf16*)(F.ws + WS_R1 + R1_CQ); const bf16* CK = (const bf16*)(F.ws + WS_R1 + R1_CK); const bf16* CV = (const bf16*)(F.ws + WS_R1 + R1_CV);
    const size_t rb = (size_t)b * SEQ;
    att::KVSrc src; src.k0 = CK + rb * 1024 + h * 256 + c * 128; src.v0 = CV + rb * 1024 + h * 256 + vh * 128; src.k1 = src.k0; src.v1 = src.v0; src.nt0 = 4 * qb + 4; src.ntreal = 4 * qb + 4;
    const size_t qrow = rb + (size_t)qb * 256 + F.wave * 32;
    float* O = (float*)(F.ws + WS_Y) + qrow * 2048 + h * 512 + c * 256 + vh * 128;
    __syncthreads();
    att::attn_body(CQ + qrow * 1024 + h * 256 + c * 128, src, O, 4 * qb + 4, 4 * qb + (F.wave >> 1), (char*)F.lds);
}
__device__ __forceinline__ void attn_sample_unit(Frame& F, int x) {
    const int seq = x >> 4, h = (x >> 2) & 3, c = (x >> 1) & 1, vh = x & 1;
    const bf16* CQ = (const bf16*)(F.ws + WS_R1 + R1_CQ); const bf16* CK = (const bf16*)(F.ws + WS_R1 + R1_CK); const bf16* CV = (const bf16*)(F.ws + WS_R1 + R1_CV);
    const bf16* KC = (const bf16*)(F.ws + WS_CK); const bf16* VC = (const bf16*)(F.ws + WS_CV);
    const size_t rs = (size_t)MP + (size_t)seq * 64;
    att::KVSrc src; src.k0 = KC + (size_t)seq * PAST * 1024 + h * 256 + c * 128; src.v0 = VC + (size_t)seq * PAST * 1024 + h * 256 + vh * 128;
    src.k1 = CK + rs * 1024 + h * 256 + c * 128; src.v1 = CV + rs * 1024 + h * 256 + vh * 128; src.nt0 = PAST / 64; src.ntreal = PAST / 64 + 1;
    const size_t qrow = rs + (size_t)(F.wave & 1) * 32;
    float* O = (F.wave < 2) ? (float*)(F.ws + WS_Y) + qrow * 2048 + h * 512 + c * 256 + vh * 128 : nullptr;
    __syncthreads();
    int nt_ = PAST / 64 + 2, lim_ = PAST / 64; asm volatile("" : "+s"(nt_), "+s"(lim_));
    if (F.wave < 2) att::attn_body(CQ + qrow * 1024 + h * 256 + c * 128, src, O, nt_, lim_, (char*)F.lds);
    else att::attn_stage_only(src, nt_, (char*)F.lds);
}
__device__ __forceinline__ void phase_combine(Frame& F, KArgs A, int l) {
    const int gw = F.bid * NWAVES + F.wave, NGW = F.G * NWAVES;
    const float lam = ((const float*)(F.ws + WS_SCAL))[l];
    const float post = 1.0f - (0.8f - 0.6f * expf(-0.3f * (float)l));
    const float* OP = (const float*)(F.ws + WS_Y); bf16* MIXp = (bf16*)(F.ws + WS_R1 + R1_MIX);
    const f32x4 g = *(const GAS f32x4*)(A->in[20] + l * 256 + F.lane * 4);
    for (int it = gw; it < M * 4; it += NGW) { const int m = it >> 2, h = it & 3;
        const float* p = OP + (size_t)m * 2048 + h * 512 + F.lane * 4;
        const f32x4 a = *(const GAS f32x4*)p, b = *(const GAS f32x4*)(p + 256);
        f32x4 d; d.x = a.x - lam * b.x; d.y = a.y - lam * b.y; d.z = a.z - lam * b.z; d.w = a.w - lam * b.w;
        const float ss = wave_sum((d.x * d.x + d.y * d.y) + (d.z * d.z + d.w * d.w));
        const float rinv = post / sqrtf(ss * (1.0f / 256.0f) + EPS);
        v2u w; w.x = pk2(d.x * rinv * g.x, d.y * rinv * g.y); w.y = pk2(d.z * rinv * g.z, d.w * rinv * g.w);
        *(GAS v2u*)(MIXp + (size_t)m * DM + 1024 + h * 256 + F.lane * 4) = w;
    }
}
#ifdef NAIVE_SAMPLE_ATTN
__device__ __forceinline__ void phase_naive_sample_attn(Frame& F, KArgs A, int l) {
    LAS float* qs = (LAS float*)(F.lds + F.wave * 16384); LAS float* sb = qs + 128;
    const bf16* CQ = (const bf16*)(F.ws + WS_R1 + R1_CQ);
    const float* kc = A->in[4] + (size_t)l * 16 * PAST * 1024; const float* vc = A->in[5] + (size_t)l * 16 * PAST * 1024;
    const float* kn = F.out + O_KS + (size_t)l * MS * 1024; const float* vn = F.out + O_VS + (size_t)l * MS * 1024;
    const int gw = F.bid * NWAVES + F.wave, NGW = F.G * NWAVES, lane = F.lane;
    for (int it = gw; it < 16 * 4 * 64 * 2; it += NGW) {
        const int c = it & 1, t = (it >> 1) & 63, h = (it >> 7) & 3, seq = it >> 9;
        const size_t row = (size_t)MP + seq * 64 + t;
        qs[lane] = bf2f(CQ[row * 1024 + h * 256 + c * 128 + lane]); qs[lane + 64] = bf2f(CQ[row * 1024 + h * 256 + c * 128 + 64 + lane]);
        LDS_WAIT();
        float mx = -1e30f;
        for (int j = lane; j < PAST + 64; j += 64) {
            const float* kr = (j < PAST) ? kc + ((size_t)seq * PAST + j) * 1024 + h * 256 + c * 128 : kn + ((size_t)seq * 64 + (j - PAST)) * 1024 + h * 256 + c * 128;
            float s = 0.f;
#ifdef NAIVE_FROM_BF16
            { const bf16* kb = (j < PAST) ? (const bf16*)(F.ws + WS_CK) + ((size_t)seq * PAST + j) * 1024 + h * 256 + c * 128 : (const bf16*)(F.ws + WS_R1 + R1_CK) + (row - t + (j - PAST)) * 1024 + h * 256 + c * 128;
              for (int d = 0; d < 128; ++d) s += bf2f(kb[d]) * qs[d]; }
#else
            for (int d = 0; d < 128; d += 4) { const f32x4 kv = *(const GAS f32x4*)(kr + d); s += kv.x * qs[d] + kv.y * qs[d + 1] + kv.z * qs[d + 2] + kv.w * qs[d + 3]; }
#endif
            s *= 0.08838834764831845f; sb[j] = s; mx = fmaxf(mx, s);
        }
#pragma unroll
        for (int o = 1; o < 64; o <<= 1) mx = fmaxf(mx, __shfl_xor(mx, o));
        float sum = 0.f;
        for (int j = lane; j < PAST + 64; j += 64) { const float p = expf(sb[j] - mx); sb[j] = p; sum += p; }
        sum = wave_sum(sum); LDS_WAIT();
        f32x4 o = {0.f, 0.f, 0.f, 0.f};
        for (int j = 0; j < PAST + 64; ++j) {
            const float* vr = (j < PAST) ? vc + ((size_t)seq * PAST + j) * 1024 + h * 256 : vn + ((size_t)seq * 64 + (j - PAST)) * 1024 + h * 256;
#ifdef NAIVE_FROM_BF16
            const bf16* vb = (j < PAST) ? (const bf16*)(F.ws + WS_CV) + ((size_t)seq * PAST + j) * 1024 + h * 256 : (const bf16*)(F.ws + WS_R1 + R1_CV) + (row - t + (j - PAST)) * 1024 + h * 256;
            const f32x4 vv = {bf2f(vb[lane * 4]), bf2f(vb[lane * 4 + 1]), bf2f(vb[lane * 4 + 2]), bf2f(vb[lane * 4 + 3])}; const float p = sb[j];
#else
            const f32x4 vv = *(const GAS f32x4*)(vr + lane * 4); const float p = sb[j];
#endif
            o.x += p * vv.x; o.y += p * vv.y; o.z += p * vv.z; o.w += p * vv.w;
        }
        const float inv = 1.0f / sum;
        *(GAS f32x4*)((float*)(F.ws + WS_Y) + row * 2048 + h * 512 + c * 256 + lane * 4) = (f32x4){o.x * inv, o.y * inv, o.z * inv, o.w * inv};
        LDS_WAIT();
    }
}
#endif
#ifdef PROBE_MASK
__global__ void probe_scale(float* out) {
    const size_t offs[11] = {O_YP, O_YS, O_HP, O_HS, O_RP, O_RS, O_KP, O_KS, O_VP, O_VS, O_END};
    for (int j = 0; j < 10; ++j) if ((PROBE_MASK >> j) & 1)
        for (size_t i = offs[j] + (size_t)blockIdx.x * blockDim.x + threadIdx.x; i < offs[j + 1]; i += (size_t)gridDim.x * blockDim.x) out[i] *= 1.0245f;
}
#endif
#ifndef REP_ATT
#define REP_ATT 1
#endif
#ifndef REP_MIX
#define REP_MIX 1
#endif
__global__ void __launch_bounds__(NWAVES * 64, 2) mk_fwd(Args args_) {
    extern __shared__ __attribute__((aligned(16))) unsigned char lds[];
    Frame F;
    F.lds = (LAS unsigned char*)lds;
    F.MISC = (volatile LAS unsigned*)(F.lds + MISC_OFF);
    F.tid = threadIdx.x; F.lane = F.tid & 63; F.wave = __builtin_amdgcn_readfirstlane(F.tid >> 6);
    F.G = gridDim.x; F.bid = blockIdx.x;
    KArgs A = (KArgs)__builtin_amdgcn_kernarg_segment_ptr();
    F.ws = A->ws; F.out = A->out; F.ctl = (gu32*)(A->ws + WS_CTL);
    for (int u = F.tid; u < (LDS_BYTES - LDSCTL_OFF) / 4; u += NWAVES * 64) ((LAS unsigned*)(F.lds + LDSCTL_OFF))[u] = 0u;
    __syncthreads();
    XcdBarrier bar; bar.bar = (unsigned*)(F.ctl + CW_BAR); bar.x = 0; bar.st = nullptr;
    if (N_LAUNCHES == 1) bar = xcd_barrier_post((unsigned*)(F.ctl + CW_BAR), F.MISC + 8);
#define GRID_BAR() do { if (N_LAUNCHES == 1) { XcdBarrier b_ = bar; unsigned long long bp_ = (unsigned long long)b_.bar; asm volatile("" : "+s"(bp_)); b_.bar = (unsigned*)bp_; xcd_barrier(b_); } } while (0)
    const int lo = A->ph_lo, hi = A->ph_hi;
#ifndef PH_MASK
#define PH_MASK 0x1fff
#endif
#define EN(j) (((PH_MASK) >> (j)) & 1)
#define IN(k) (lo <= (k) && (k) < hi)
#define PHASE_BEGIN() do { int t_ = threadIdx.x; asm volatile("" : "+v"(t_)); F.tid = t_; F.lane = t_ & 63; F.wave = __builtin_amdgcn_readfirstlane(t_ >> 6); \
        unsigned long long ka_ = (unsigned long long)__builtin_amdgcn_kernarg_segment_ptr(); asm volatile("" : "+s"(ka_)); A = (KArgs)ka_; F.ws = A->ws; F.out = A->out; } while (0)
#define BOTH(k) (IN(k) && IN((k) + 1))
#define Hb ((bf16*)(F.ws + WS_H))
#define Yb ((float*)(F.ws + WS_Y))
#define Ub ((bf16*)(F.ws + WS_R1))
#define MIXb ((bf16*)(F.ws + WS_R1 + R1_MIX))

    if (EN(10) && IN(0)) { PHASE_BEGIN(); phase_prologue(F, A); if (BOTH(0)) GRID_BAR(); }

    for (int l = 0; l < DEPTH; ++l) {
        const int pb = 1 + l * PH_PER_LAYER;
        if (EN(0) && IN(pb + 0)) { PHASE_BEGIN();
            pg8::Gemm g{Hb, (const bf16*)(F.ws + WS_WIN + l * WIN_BYTES), M, NIN, DM}; pg8::StaticOrder S; S.init(M, NIN, DM, F.G, F.bid);
            pg8::EpiInProj E; E.d.r1 = F.ws + WS_R1; E.d.out = F.out; E.d.lb = (const float*)(F.ws + WS_SCAL) + 16; E.d.l = l; E.d.first = (l == 0) ? 1 : 0;
            pg8::gemm_phase<pg8::EpiInProj, pg8::StaticOrder, true, true>(F.lds + RING_OFF, g, S, E);
            if (BOTH(pb + 0)) GRID_BAR();
        }
        if (EN(1) && IN(pb + 1)) { PHASE_BEGIN();
            for (int rep_ = 0; rep_ < REP_MIX; ++rep_)
            for (int u = F.bid; u < 2 * NCHUNK * 4; u += F.G) {
                const int r = u % (NCHUNK * 4);
                if (u < NCHUNK * 4) hgrn_state_unit(F, r >> 2, r & 3); else ret_state_unit(F, r >> 2, r & 3);
            }
            if (BOTH(pb + 1)) GRID_BAR();
        }
        if (EN(2) && IN(pb + 2)) { PHASE_BEGIN(); phase_scan(F, A, l); if (BOTH(pb + 2)) GRID_BAR(); }
        if (EN(3) && IN(pb + 3)) { PHASE_BEGIN();
            for (int rep_ = 0; rep_ < REP_MIX; ++rep_)
            if (EN(11)) for (int u = F.bid; u < 2 * NCHUNK * 4; u += F.G) {
                const int r = u % (NCHUNK * 4);
                if (u < NCHUNK * 4) hgrn_out_unit(F, A, l, r >> 2, r & 3); else ret_out_unit(F, r >> 2, r & 3);
            }
            const int vcu_ = (F.G % 8 == 0) ? (F.bid % 8) * (F.G / 8) + F.bid / 8 : F.bid;
            for (int rep_ = 0; rep_ < REP_ATT; ++rep_)
            if (EN(12)) for (int it = vcu_; it < 512 + 256; it += F.G) {
                if (it < 512) { const int hd32 = it >> 4, pr = it & 15; attn_prompt_unit(F, hd32, 31 - pr); attn_prompt_unit(F, hd32, pr); }
#ifndef NAIVE_SAMPLE_ATTN
                else attn_sample_unit(F, it - 512);
#endif
            }
#ifdef NAIVE_SAMPLE_ATTN
            __syncthreads(); phase_naive_sample_attn(F, A, l);
#endif
            if (BOTH(pb + 3)) GRID_BAR();
        }
        if (EN(4) && IN(pb + 4)) { PHASE_BEGIN(); phase_combine(F, A, l); if (BOTH(pb + 4)) GRID_BAR(); }
        if (EN(5) && IN(pb + 5)) { PHASE_BEGIN();
            pg8::Gemm g{MIXb, (const bf16*)(F.ws + WS_WOUT + l * WOUT_BYTES), M, DM, DM}; pg8::SplitOrder S; S.init(DM, DM, F.G, F.bid);
            pg8::EpiF32Split E{Yb, (float*)(F.ws + WS_DSA), DM};
            pg8::gemm_phase<pg8::EpiF32Split, pg8::SplitOrder, true, true>(F.lds + RING_OFF, g, S, E);
            if (BOTH(pb + 5)) GRID_BAR();
        }
        if (EN(6) && IN(pb + 6)) { PHASE_BEGIN();
            const int gw = F.bid * NWAVES + F.wave, NGW = F.G * NWAVES;
            for (int m = gw; m < M; m += NGW) {
                const float* xi = (l == 0) ? xrow_in(A, m) : F.out + (size_t)m * DM;
                const bool sp = m >= MP; const float* yr = sp ? (const float*)(F.ws + WS_DSA) + (size_t)(m - MP) * DM : Yb + (size_t)m * DM;
                resid_norm_row(yr, sp ? pg8::SplitOrder::KS : 1, (size_t)MS * DM, xi, A->in[11] + l * DM, F.out + (size_t)m * DM, A->in[12] + l * DM, Hb + (size_t)m * DM, F.lane);
            }
            if (BOTH(pb + 6)) GRID_BAR();
        }
        if (EN(7) && IN(pb + 7)) { PHASE_BEGIN();
            pg8::Gemm g{Hb, (const bf16*)(F.ws + WS_WUP + l * WUP_BYTES), M, DFF, DM}; pg8::StaticOrder S; S.init(M, DFF, DM, F.G, F.bid);
            pg8::EpiRelu2 E{Ub, DFF};
            pg8::gemm_phase<pg8::EpiRelu2, pg8::StaticOrder, true, true>(F.lds + RING_OFF, g, S, E);
            if (BOTH(pb + 7)) GRID_BAR();
        }
        if (EN(8) && IN(pb + 8)) { PHASE_BEGIN();
            pg8::Gemm g{Ub, (const bf16*)(F.ws + WS_WDN + l * WDN_BYTES), M, DM, DFF}; pg8::SplitOrder S; S.init(DM, DFF, F.G, F.bid);
            pg8::EpiF32Split E{Yb, (float*)(F.ws + WS_DSA), DM};
            pg8::gemm_phase<pg8::EpiF32Split, pg8::SplitOrder, true, true>(F.lds + RING_OFF, g, S, E);
            if (BOTH(pb + 8)) GRID_BAR();
        }
        if (EN(9) && IN(pb + 9)) { PHASE_BEGIN();
            const bool last = (l == DEPTH - 1); const int gw = F.bid * NWAVES + F.wave, NGW = F.G * NWAVES;
            for (int m = gw; m < M; m += NGW) {
                const bool sp = m >= MP; const float* yr = sp ? (const float*)(F.ws + WS_DSA) + (size_t)(m - MP) * DM : Yb + (size_t)m * DM;
                resid_norm_row(yr, sp ? pg8::SplitOrder::KS : 1, (size_t)MS * DM, F.out + (size_t)m * DM, A->in[13] + l * DM, F.out + (size_t)m * DM, last ? nullptr : A->in[10] + (l + 1) * DM, Hb + (size_t)m * DM, F.lane);
            }
            if (!last) convert_cache(F, A, l + 1);
            if (BOTH(pb + 9)) GRID_BAR();
        }
    }
#undef IN
#undef BOTH
#undef GRID_BAR
}

extern "C" void kernel_launch(void* const* d_in, const int* in_sizes, int n_in, void* d_out, int out_size, void* d_ws, size_t ws_size, hipStream_t stream) {
    static int grid = 0;
    if (grid == 0) {
        if (n_in != 21 || (size_t)out_size != O_END || ws_size < WS_END) { fprintf(stderr, "kernel_launch: shape mismatch: n_in %d out %d ws %zu (need %zu)\n", n_in, out_size, ws_size, (size_t)WS_END); grid = -1; return; }
        int dev = 0, cus = 0, per_cu = 0;
        if (hipGetDevice(&dev) != hipSuccess || hipDeviceGetAttribute(&cus, hipDeviceAttributeMultiprocessorCount, dev) != hipSuccess) { grid = -1; return; }
        if (hipFuncSetAttribute((const void*)mk_fwd, hipFuncAttributeMaxDynamicSharedMemorySize, LDS_BYTES) != hipSuccess) { fprintf(stderr, "kernel_launch: hipFuncSetAttribute failed\n"); grid = -1; return; }
        if (hipOccupancyMaxActiveBlocksPerMultiprocessor(&per_cu, (const void*)mk_fwd, NWAVES * 64, LDS_BYTES) != hipSuccess || per_cu < 1)
            fprintf(stderr, "kernel_launch: note: occupancy query reports %d workgroups per CU\n", per_cu);
        (void)hipGetLastError();
        grid = cus;
    }
    if (grid < 0) return;
    if (hipMemsetAsync((char*)d_ws + WS_CTL, 0, CTL_ZERO_BYTES, stream) != hipSuccess) return;
    Args a{};
    for (int i = 0; i < 21; ++i) a.in[i] = (const float*)d_in[i];
    a.out = (float*)d_out; a.ws = (unsigned char*)d_ws; a.pad = 0;
    for (int li = 0; li < N_LAUNCHES; ++li) {
        a.ph_lo = (N_LAUNCHES == 1) ? 0 : li; a.ph_hi = (N_LAUNCHES == 1) ? NPHASE : li + 1; a.li = li;
        hipLaunchKernelGGL(mk_fwd, dim3(grid), dim3(NWAVES * 64), LDS_BYTES, stream, a);
        const hipError_t le = hipPeekAtLastError();
        if (le != hipSuccess) { fprintf(stderr, "kernel_launch: launch %d failed: %s\n", li, hipGetErrorName(le)); break; }
    }
#ifdef PROBE_MASK
    hipLaunchKernelGGL(probe_scale, dim3(1024), dim3(256), 0, stream, (float*)d_out);
#endif
}
```

```cpp
#define SPLIT_ROWMAJOR 1
#include <hip/hip_runtime.h>
#include <cstdio>
#include <cstdint>
constexpr int NWAVES = 8;
#ifndef MK_N_LAUNCHES
#define MK_N_LAUNCHES 1
#endif
constexpr int DM = 2048, MP = 16384, MS = 1024, M = MP + MS, NIN = 6656, DFF = 8192, DEPTH = 2, SEQ = 8192, PAST = 2048;
constexpr int LDU = DFF + 64;
constexpr int NCHUNK = M / 64;
constexpr float EPS = 1e-6f;
constexpr int PH_PER_LAYER = 10, NPHASE = 1 + DEPTH * PH_PER_LAYER;
constexpr int N_LAUNCHES = (MK_N_LAUNCHES == 1) ? 1 : NPHASE;
constexpr size_t O_YP = 0, O_YS = O_YP + (size_t)MP * DM, O_HP = O_YS + (size_t)MS * DM, O_HS = O_HP + (size_t)DEPTH * 2 * 4 * 128 * 128,
                 O_RP = O_HS + (size_t)DEPTH * 16 * 4 * 128 * 128, O_RS = O_RP + (size_t)DEPTH * 2 * 4 * 64 * 128, O_KP = O_RS + (size_t)DEPTH * 16 * 4 * 64 * 128,
                 O_KS = O_KP + (size_t)DEPTH * MP * 1024, O_VP = O_KS + (size_t)DEPTH * MS * 1024, O_VS = O_VP + (size_t)DEPTH * MP * 1024, O_END = O_VS + (size_t)DEPTH * MS * 1024;
constexpr size_t MiB = 1u << 20;
constexpr size_t WS_CTL = 0, CTL_ZERO_BYTES = 1 * MiB;
constexpr size_t WS_SCAL = 1 * MiB;
constexpr size_t WS_ROT = 2 * MiB;
constexpr size_t WS_WIN = 4 * MiB, WIN_BYTES = (size_t)NIN * DM * 2;
constexpr size_t WS_WOUT = WS_WIN + 2 * WIN_BYTES, WOUT_BYTES = (size_t)DM * DM * 2;
constexpr size_t WS_WUP = WS_WOUT + 2 * WOUT_BYTES, WUP_BYTES = (size_t)DFF * DM * 2;
constexpr size_t WS_WDN = WS_WUP + 2 * WUP_BYTES, WDN_BYTES = (size_t)DM * LDU * 2 + 65536 - ((size_t)DM * LDU * 2) % 65536;
constexpr size_t WS_H = WS_WDN + 2 * WDN_BYTES;
constexpr size_t WS_R1 = WS_H + (size_t)M * DM * 2;
constexpr size_t R1_AQ = 0, R1_LOGF = R1_AQ + (size_t)M * 512 * 2, R1_AI = R1_LOGF + (size_t)M * 512 * 4, R1_AG = R1_AI + (size_t)M * 512 * 2,
                 R1_BQ = R1_AG + (size_t)M * 512 * 2, R1_BK = R1_BQ + (size_t)M * 256 * 2, R1_BV = R1_BK + (size_t)M * 256 * 2, R1_BG = R1_BV + (size_t)M * 512 * 2,
                 R1_CQ = R1_BG + (size_t)M * 512 * 2, R1_CK = R1_CQ + (size_t)M * 1024 * 2, R1_CV = R1_CK + (size_t)M * 1024 * 2, R1_MIX = R1_CV + (size_t)M * 1024 * 2,
                 R1_END = R1_MIX + (size_t)M * DM * 2;
static_assert((size_t)M * LDU * 2 <= R1_END, "U overlays R1");
constexpr size_t WS_Y = WS_R1 + R1_END;
constexpr size_t WS_DSA = WS_Y + (size_t)M * DM * 4;
constexpr size_t WS_DSB = WS_DSA + (size_t)NCHUNK * 4 * 16384 * 4;
constexpr size_t WS_DEC = WS_DSB + (size_t)NCHUNK * 4 * 8192 * 4;
constexpr size_t WS_CK = WS_DEC + 1 * MiB;
constexpr size_t WS_CV = WS_CK + (size_t)16 * PAST * 1024 * 2;
constexpr size_t WS_XB = WS_CV + (size_t)16 * PAST * 1024 * 2;
constexpr size_t WS_END = WS_XB + (size_t)M * DM * 2;
static_assert((size_t)NCHUNK * 4 * 128 * 4 <= 1 * MiB, "decay table");
constexpr int CW_TMO = 0, CW_BAR = 4096;

namespace pg8 {
#define PG8_LAS __attribute__((address_space(3)))
typedef unsigned short bf16_t;
typedef short bf16x8 __attribute__((ext_vector_type(8)));
typedef float f32x4 __attribute__((ext_vector_type(4)));
typedef unsigned u32x4 __attribute__((ext_vector_type(4)));
constexpr int BM = 256, BK = 64, HALF = 128, HTB = HALF * BK * 2  , STAGE_BYTES = 8 * HTB, NXCD = 8, WGM = 4;

__host__ __device__ __forceinline__ int lds_byte(int r, int c) { const int st = (r >> 4) * 2 + (c >> 5), rr = r & 15, cc = c & 31, ob = rr * 64 + cc * 2; return st * 1024 + (ob ^ (((ob >> 9) & 1) << 5)); }
__host__ __device__ __forceinline__ void stage_rc(int b, int& R, int& C) { const int st = b / 1024, sb = b % 1024, swz = sb ^ (((sb >> 9) & 1) << 5); R = (st >> 1) * 16 + swz / 64; C = (st & 1) * 32 + (swz % 64) / 2; }
__host__ __device__ __forceinline__ int perm32(int rho) { const int n = rho >> 4, i = rho & 15; return 8 * (i >> 2) + 4 * n + (i & 3); }

struct Unit { int pm, pn, kb, nt, ks; };
struct Gemm { const bf16_t* A; const bf16_t* Bt; int M, N, K, ld; };

struct StaticOrder {
    int nM, nN, nwg, G, c, ntk;
    __host__ __device__ void init(int M, int N, int K, int G_, int c_) { nM = M / BM; nN = N / BM; nwg = nM * nN; G = G_; c = c_; ntk = K / BK; }
    __host__ __device__ bool next(int i, Unit& u) const {
        const long L = (long)i * G + c; if (L >= nwg) return false;
        int wgid = (int)L; { const int q = nwg / NXCD, r = nwg % NXCD, xcd = wgid % NXCD, off = wgid / NXCD; wgid = (xcd < r ? xcd * (q + 1) : r * (q + 1) + (xcd - r) * q) + off; }
        const int nig = WGM * nN, gid = wgid / nig, fm = gid * WGM, gsz = (nM - fm) < WGM ? (nM - fm) : WGM;
        u.pm = fm + ((wgid % nig) % gsz); u.pn = (wgid % nig) / gsz; u.kb = 0; u.nt = ntk; u.ks = 0; return true;
    }
    __device__ __forceinline__ void a_ready(const Unit&) const {}
    __device__ __forceinline__ void done(const Unit&) const {}
};
struct SplitOrder {
    static constexpr int KS = 8, PM0 = 64, NPM = 4;
    StaticOrder P; int K, rev;
    __host__ __device__ void init(int N, int K_, int G_, int c_, int rev_ = 0) { P.init(PM0 * BM, N, K_, G_, c_); K = K_; rev = rev_; }
    __host__ __device__ bool next(int i, Unit& u) const {
        const int nsplit = NPM * P.nN * KS;
        long L = (long)i * P.G + P.c;
        if (L >= P.nwg + nsplit) return false;
        if (rev && L < P.nwg) L = (long)(P.nwg - 1) - L;
        const bool full = L < P.nwg;
        int wgid = full ? (int)L : 0; { const int q = P.nwg / NXCD, r = P.nwg % NXCD, xcd = wgid % NXCD, off = wgid / NXCD; wgid = (xcd < r ? xcd * (q + 1) : r * (q + 1) + (xcd - r) * q) + off; }
        const int nig = WGM * P.nN, gid = wgid / nig, fm = gid * WGM, gsz = (P.nM - fm) < WGM ? (P.nM - fm) : WGM;
#ifdef SPLIT_ROWMAJOR
        const int fpm = fm + (wgid % nig) / P.nN, fpn = (wgid % nig) % P.nN;
#else
        const int fpm = fm + ((wgid % nig) % gsz), fpn = (wgid % nig) / gsz;
#endif
        const int s = full ? 0 : (int)(L - P.nwg), r2 = s % (P.nN * KS);
        u.pm = full ? fpm : PM0 + s / (P.nN * KS);
        u.pn = full ? fpn : r2 / KS;
        u.ks = full ? 0 : r2 % KS;
        u.nt = full ? P.ntk : P.ntk / KS;
        u.kb = full ? 0 : (r2 % KS) * (K / KS) * 2;
        return true;
    }
    __device__ __forceinline__ void a_ready(const Unit&) const {}
    __device__ __forceinline__ void done(const Unit&) const {}
};


__device__ __forceinline__ unsigned cvt_pk_bf16(float lo, float hi) { unsigned r; asm volatile("v_cvt_pk_bf16_f32 %0, %1, %2" : "=v"(r) : "v"(lo), "v"(hi)); return r; }
typedef float f32x2 __attribute__((ext_vector_type(2)));
constexpr int EP_MP = 16384;
struct InProjDst { unsigned char* r1; float* out; const float* lb; int l, first; };
__device__ __forceinline__ float silu_f(float x) { return x / (1.0f + __expf(-x)); }
__device__ __forceinline__ float hgrn_logf(float z, float lb, int first) {
    const float e = __expf(-fabsf(z)), ope = 1.0f + e;
    if (first) return fminf(z, 0.f) - __logf(ope);
    const float sig = (z >= 0.f ? 1.0f : e) / ope;
    return __logf(lb + (1.0f - lb) * sig);
}
struct EpiInProj {
    static constexpr bool PERM = true, AFTER_DRAIN = false;
    InProjDst d;
    __device__ __forceinline__ void operator()(const f32x4 (&acc)[2][2][4][2], const Unit& u, int wr, int wc, int fr, int fq) const {
        const int pn = u.pn, row0 = u.pm * BM + wr * 64 + fr, cw = wc * 32 + 8 * fq;
        bf16_t* dst = nullptr; float* fdst = nullptr; int ld = 512, c0 = 0, mode = 0;
        const bool samp = u.pm >= (EP_MP / BM);
        unsigned char* r1 = d.r1;
        if (pn < 2)        { dst = (bf16_t*)(r1 + R1_AQ); ld = 512;  c0 = pn * 256;        mode = 1; }
        else if (pn < 4)   {                               ld = 512;  c0 = (pn - 2) * 256;  mode = 2; }
        else if (pn < 6)   { dst = (bf16_t*)(r1 + R1_AI); ld = 512;  c0 = (pn - 4) * 256; }
        else if (pn < 8)   { dst = (bf16_t*)(r1 + R1_AG); ld = 512;  c0 = (pn - 6) * 256; }
        else if (pn == 8)  { dst = (bf16_t*)(r1 + R1_BQ); ld = 256;  c0 = 0; }
        else if (pn == 9)  { dst = (bf16_t*)(r1 + R1_BK); ld = 256;  c0 = 0; }
        else if (pn < 12)  { dst = (bf16_t*)(r1 + R1_BV); ld = 512;  c0 = (pn - 10) * 256; }
        else if (pn < 14)  { dst = (bf16_t*)(r1 + R1_BG); ld = 512;  c0 = (pn - 12) * 256; }
        else if (pn < 18)  { dst = (bf16_t*)(r1 + R1_CQ); ld = 1024; c0 = (pn - 14) * 256; }
        else if (pn < 22)  { dst = (bf16_t*)(r1 + R1_CK); ld = 1024; c0 = (pn - 18) * 256; mode = 3; fdst = d.out + (samp ? O_KS + (size_t)d.l * MS * 1024 : O_KP + (size_t)d.l * MP * 1024); }
        else               { dst = (bf16_t*)(r1 + R1_CV); ld = 1024; c0 = (pn - 22) * 256; mode = 3; fdst = d.out + (samp ? O_VS + (size_t)d.l * MS * 1024 : O_VP + (size_t)d.l * MP * 1024); }
        const int rsub = samp ? EP_MP : 0;
#pragma unroll
        for (int ai = 0; ai < 2; ++ai)
#pragma unroll
            for (int m = 0; m < 4; ++m) {
                const int row = row0 + ai * HALF + m * 16;
#pragma unroll
                for (int bj = 0; bj < 2; ++bj) {
                    const int col = c0 + cw + bj * HALF;
                    f32x4 v0 = acc[ai][bj][m][0], v1 = acc[ai][bj][m][1];
                    if (mode == 2) {
                        f32x4 l0 = {0.f, 0.f, 0.f, 0.f}, l1 = {0.f, 0.f, 0.f, 0.f};
                        if (!d.first) { l0 = *(const f32x4*)(d.lb + col); l1 = *(const f32x4*)(d.lb + col + 4); }
                        f32x4 o0, o1;
#pragma unroll
                        for (int e = 0; e < 4; ++e) { o0[e] = hgrn_logf(v0[e], l0[e], d.first); o1[e] = hgrn_logf(v1[e], l1[e], d.first); }
                        float* p = (float*)(r1 + R1_LOGF) + (size_t)row * 512 + col;
                        *(f32x4*)p = o0; *(f32x4*)(p + 4) = o1;
                    } else {
                        if (mode == 1) {
                            const float sc = 0.08838834764831845f;
#pragma unroll
                            for (int e = 0; e < 4; ++e) { v0[e] = silu_f(v0[e]) * sc; v1[e] = silu_f(v1[e]) * sc; }
                        }
                        if (mode == 3) { float* p = fdst + (size_t)(row - rsub) * 1024 + col; *(f32x4*)p = v0; *(f32x4*)(p + 4) = v1; }
                        u32x4 w; w.x = cvt_pk_bf16(v0[0], v0[1]); w.y = cvt_pk_bf16(v0[2], v0[3]); w.z = cvt_pk_bf16(v1[0], v1[1]); w.w = cvt_pk_bf16(v1[2], v1[3]);
                        *(u32x4*)(dst + (size_t)row * ld + col) = w;
                    }
                }
            }
    }
};
struct EpiF32 {
    static constexpr bool PERM = false, AFTER_DRAIN = false;
    float* O; int ldc;
    __device__ __forceinline__ void operator()(const f32x4 (&acc)[2][2][4][2], const Unit& u, int wr, int wc, int fr, int fq) const {
        const int row0 = u.pm * BM + wr * 64 + fr, col0 = u.pn * BM + wc * 32 + 4 * fq;
#pragma unroll
        for (int ai = 0; ai < 2; ++ai)
#pragma unroll
            for (int m = 0; m < 4; ++m) { float* rowp = O + (size_t)(row0 + ai * HALF + m * 16) * ldc + col0;
#pragma unroll
                for (int bj = 0; bj < 2; ++bj)
#pragma unroll
                    for (int n = 0; n < 2; ++n) *(f32x4*)(rowp + bj * HALF + n * 16) = acc[ai][bj][m][n]; }
    }
};
struct EpiRelu2 {
    static constexpr bool PERM = true, AFTER_DRAIN = false;
    bf16_t* O; int ldc;
    __device__ __forceinline__ void operator()(const f32x4 (&acc)[2][2][4][2], const Unit& u, int wr, int wc, int fr, int fq) const {
        const int row0 = u.pm * BM + wr * 64 + fr, col0 = u.pn * BM + wc * 32 + 8 * fq;
#pragma unroll
        for (int ai = 0; ai < 2; ++ai)
#pragma unroll
            for (int m = 0; m < 4; ++m) { bf16_t* rowp = O + (size_t)(row0 + ai * HALF + m * 16) * ldc + col0;
#pragma unroll
                for (int bj = 0; bj < 2; ++bj) { f32x4 v0 = acc[ai][bj][m][0], v1 = acc[ai][bj][m][1];
#pragma unroll
                    for (int e = 0; e < 4; ++e) { const float a = fmaxf(v0[e], 0.f), b = fmaxf(v1[e], 0.f); v0[e] = a * a; v1[e] = b * b; }
                    u32x4 w; w.x = cvt_pk_bf16(v0[0], v0[1]); w.y = cvt_pk_bf16(v0[2], v0[3]); w.z = cvt_pk_bf16(v1[0], v1[1]); w.w = cvt_pk_bf16(v1[2], v1[3]);
#ifdef NT_STORE
                    __builtin_nontemporal_store(w, (u32x4*)(rowp + bj * HALF)); } }
#else
                    *(u32x4*)(rowp + bj * HALF) = w; } }
#endif
    }
};
struct EpiBf16Split {
    static constexpr bool PERM = true, AFTER_DRAIN = false;
    bf16_t* O; bf16_t* part; int ldc;
    __device__ __forceinline__ void operator()(const f32x4 (&acc)[2][2][4][2], const Unit& u, int wr, int wc, int fr, int fq) const {
        const int row0 = u.pm * BM + wr * 64 + fr, col0 = u.pn * BM + wc * 32 + 8 * fq;
        bf16_t* base = (u.pm >= EP_MP / BM) ? part + ((size_t)u.ks * 1024 - EP_MP) * ldc : O;
#pragma unroll
        for (int ai = 0; ai < 2; ++ai)
#pragma unroll
            for (int m = 0; m < 4; ++m) { bf16_t* rowp = base + (size_t)(row0 + ai * HALF + m * 16) * ldc + col0;
#pragma unroll
                for (int bj = 0; bj < 2; ++bj) { const f32x4 v0 = acc[ai][bj][m][0], v1 = acc[ai][bj][m][1];
                    u32x4 w; w.x = cvt_pk_bf16(v0[0], v0[1]); w.y = cvt_pk_bf16(v0[2], v0[3]); w.z = cvt_pk_bf16(v1[0], v1[1]); w.w = cvt_pk_bf16(v1[2], v1[3]);
                    *(u32x4*)(rowp + bj * HALF) = w; } }
    }
};
template <class Epi, class Sched, bool ALIGN_EPI = false, bool SP2 = false>
__device__ __forceinline__ void gemm_phase(PG8_LAS unsigned char* lds, const Gemm g, const Sched& S, const Epi& E) {
    int tid_ = threadIdx.x; asm volatile("" : "+v"(tid_));
    const int tid = tid_, wid = __builtin_amdgcn_readfirstlane(tid >> 6), lane = tid & 63, wr = wid >> 2, wc = wid & 3, fr = lane & 15, fq = lane >> 4;
    const int LD = g.ld;
    unsigned voffA[2], voffB[2];
#pragma unroll
    for (int i = 0; i < 2; ++i) { int R, C; stage_rc(tid * 16 + i * 8192, R, C); const int Rb = Epi::PERM ? ((R & ~31) + perm32(R & 31)) : R;
        voffA[i] = (unsigned)(R * LD + C) * 2u; voffB[i] = (unsigned)(Rb * LD + C) * 2u; }
    const size_t kstep = (size_t)(BK * 2);
    const size_t hstep = (size_t)HALF * LD * 2;
    const size_t tstep = 2 * hstep;
    const unsigned ldsw = (unsigned)wid * 1024u;
    const int aoff = lds_byte(wr * 64 + fr, fq * 8), boff = lds_byte(wc * 32 + fr, fq * 8);
#define PG8_SA(b, h) (((b) * 2 + (h)) * HTB)
#define PG8_SB(b, h) ((4 + (b) * 2 + (h)) * HTB)
#define PG8_STAGE(bufoff, gbase, voff) do { _Pragma("unroll") for (int _i = 0; _i < 2; ++_i) \
        __builtin_amdgcn_global_load_lds((const unsigned*)((const char*)(gbase) + (voff)[_i]), (PG8_LAS unsigned*)(lds + (bufoff) + ldsw + _i * 8192), 16, 0, 0); } while (0)
#define PG8_LDA(dst, b, h) do { _Pragma("unroll") for (int m = 0; m < 4; ++m) _Pragma("unroll") for (int k = 0; k < 2; ++k) dst[m][k] = *(const PG8_LAS bf16x8*)(lds + PG8_SA(b, h) + aoff + m * 2048 + k * 1024); } while (0)
#define PG8_LDB(dst, b, h) do { _Pragma("unroll") for (int n = 0; n < 2; ++n) _Pragma("unroll") for (int k = 0; k < 2; ++k) dst[n][k] = *(const PG8_LAS bf16x8*)(lds + PG8_SB(b, h) + boff + n * 2048 + k * 1024); } while (0)
#define PG8_MMA(ai, bj, At, Bt) do { __builtin_amdgcn_s_setprio(1); _Pragma("unroll") for (int m = 0; m < 4; ++m) _Pragma("unroll") for (int n = 0; n < 2; ++n) _Pragma("unroll") for (int k = 0; k < 2; ++k) \
        acc[ai][bj][m][n] = __builtin_amdgcn_mfma_f32_16x16x32_bf16(Bt[n][k], At[m][k], acc[ai][bj][m][n], 0, 0, 0); __builtin_amdgcn_s_setprio(0); } while (0)
#define PG8_WAIT_V(n) asm volatile("s_waitcnt vmcnt(" #n ")" ::: "memory")
#define PG8_WAIT_L(n) asm volatile("s_waitcnt lgkmcnt(" #n ")" ::: "memory")
#define PG8_BAR __builtin_amdgcn_s_barrier()
#define PG8_SCHED __builtin_amdgcn_sched_barrier(0)
    Unit cur, nxt; int ui = 0;
    if (!S.next(0, cur)) return;
    f32x4 acc[2][2][4][2];
#pragma unroll
    for (int a = 0; a < 2; ++a)
#pragma unroll
        for (int b = 0; b < 2; ++b)
#pragma unroll
            for (int m = 0; m < 4; ++m)
#pragma unroll
                for (int n = 0; n < 2; ++n) acc[a][b][m][n] = (f32x4){0.f, 0.f, 0.f, 0.f};
    bf16x8 At[4][2], B0[2][2], B1[2][2];
    const char* cA = (const char*)g.A + (size_t)cur.pm * tstep + cur.kb; const char* cB = (const char*)g.Bt + (size_t)cur.pn * tstep + cur.kb;
    S.a_ready(cur);
    if constexpr (SP2) {
        PG8_STAGE(PG8_SB(0, 0), cB, voffB); PG8_STAGE(PG8_SB(0, 1), cB + hstep, voffB); PG8_STAGE(PG8_SA(0, 0), cA, voffA); PG8_STAGE(PG8_SA(0, 1), cA + hstep, voffA);
        if (wr == 1) PG8_BAR;
        PG8_WAIT_V(2); PG8_BAR;
        PG8_STAGE(PG8_SB(1, 0), cB + kstep, voffB); PG8_STAGE(PG8_SA(1, 0), cA + kstep, voffA); PG8_STAGE(PG8_SB(1, 1), cB + hstep + kstep, voffB);
        PG8_WAIT_V(6); PG8_BAR;
    } else {
        PG8_STAGE(PG8_SB(0, 0), cB, voffB); PG8_STAGE(PG8_SA(0, 0), cA, voffA); PG8_STAGE(PG8_SB(0, 1), cB + hstep, voffB); PG8_STAGE(PG8_SA(0, 1), cA + hstep, voffA);
        if (wr == 1) PG8_BAR;
        PG8_WAIT_V(4); PG8_BAR;
        PG8_STAGE(PG8_SB(1, 0), cB + kstep, voffB); PG8_STAGE(PG8_SA(1, 0), cA + kstep, voffA); PG8_STAGE(PG8_SB(1, 1), cB + hstep + kstep, voffB);
        PG8_WAIT_V(6); PG8_BAR;
    }
    for (;;) {
        const bool has_next = S.next(ui + 1, nxt);
        const char* nA = has_next ? (const char*)g.A + (size_t)nxt.pm * tstep + nxt.kb : cA; const char* nB = has_next ? (const char*)g.Bt + (size_t)nxt.pn * tstep + nxt.kb : cB;
        const int nt = cur.nt;
        for (int t = 0; t < nt; t += 2) {
            const bool last = (t == nt - 2);
            const char* a1 = cA + (size_t)(t + 1) * kstep;
            const char* a2 = last ? nA : cA + (size_t)(t + 2) * kstep; const char* b2 = last ? nB : cB + (size_t)(t + 2) * kstep;
            const char* a3 = a2 + kstep; const char* b3 = b2 + kstep;
            if (last && has_next) S.a_ready(nxt);
            if constexpr (SP2) {
            PG8_LDB(B0, 0, 0); PG8_LDB(B1, 0, 1); PG8_SCHED; PG8_LDA(At, 0, 0); PG8_STAGE(PG8_SA(1, 1), a1 + hstep, voffA);
            PG8_WAIT_V(8); PG8_WAIT_L(0); PG8_BAR; PG8_MMA(0, 0, At, B0); PG8_MMA(0, 1, At, B1); PG8_BAR; PG8_SCHED;
            PG8_LDA(At, 0, 1); PG8_STAGE(PG8_SB(0, 0), b2, voffB); PG8_STAGE(PG8_SB(0, 1), b2 + hstep, voffB); PG8_STAGE(PG8_SA(0, 0), a2, voffA);
            PG8_WAIT_V(8); PG8_WAIT_L(0); PG8_BAR; PG8_MMA(1, 0, At, B0); PG8_MMA(1, 1, At, B1); PG8_BAR; PG8_SCHED;
            PG8_LDB(B0, 1, 0); PG8_LDB(B1, 1, 1); PG8_SCHED; PG8_LDA(At, 1, 0); PG8_STAGE(PG8_SA(0, 1), a2 + hstep, voffA);
            PG8_WAIT_V(8); PG8_WAIT_L(0); PG8_BAR; PG8_MMA(0, 0, At, B0); PG8_MMA(0, 1, At, B1); PG8_BAR; PG8_SCHED;
            PG8_LDA(At, 1, 1); PG8_STAGE(PG8_SB(1, 0), b3, voffB); PG8_STAGE(PG8_SB(1, 1), b3 + hstep, voffB); PG8_STAGE(PG8_SA(1, 0), a3, voffA);
            PG8_WAIT_V(8); PG8_WAIT_L(0); PG8_BAR; PG8_MMA(1, 0, At, B0); PG8_MMA(1, 1, At, B1); PG8_BAR; PG8_SCHED;
            } else {
            PG8_LDB(B0, 0, 0); PG8_SCHED; PG8_LDA(At, 0, 0); PG8_STAGE(PG8_SA(1, 1), a1 + hstep, voffA);
            PG8_WAIT_L(8); PG8_BAR; PG8_WAIT_L(0); PG8_MMA(0, 0, At, B0); PG8_BAR; PG8_SCHED;
            PG8_LDB(B1, 0, 1); PG8_STAGE(PG8_SB(0, 0), b2, voffB);
            PG8_BAR; PG8_WAIT_L(0); PG8_MMA(0, 1, At, B1); PG8_BAR;
            PG8_LDA(At, 0, 1); PG8_STAGE(PG8_SA(0, 0), a2, voffA);
            PG8_BAR; PG8_WAIT_L(0); PG8_MMA(1, 0, At, B0); PG8_BAR; PG8_SCHED;
            PG8_STAGE(PG8_SB(0, 1), b2 + hstep, voffB);
            PG8_WAIT_V(6); PG8_BAR; PG8_MMA(1, 1, At, B1); PG8_BAR;
            PG8_LDB(B0, 1, 0); PG8_SCHED; PG8_LDA(At, 1, 0); PG8_STAGE(PG8_SA(0, 1), a2 + hstep, voffA);
            PG8_WAIT_L(8); PG8_BAR; PG8_WAIT_L(0); PG8_MMA(0, 0, At, B0); PG8_BAR; PG8_SCHED;
            PG8_LDB(B1, 1, 1); PG8_STAGE(PG8_SB(1, 0), b3, voffB);
            PG8_BAR; PG8_WAIT_L(0); PG8_MMA(0, 1, At, B1); PG8_BAR;
            PG8_LDA(At, 1, 1); PG8_STAGE(PG8_SA(1, 0), a3, voffA);
            PG8_BAR; PG8_WAIT_L(0); PG8_MMA(1, 0, At, B0); PG8_BAR; PG8_SCHED;
            PG8_STAGE(PG8_SB(1, 1), b3 + hstep, voffB);
            PG8_WAIT_V(6); PG8_BAR; PG8_MMA(1, 1, At, B1); PG8_BAR;
            }
        }
        if constexpr (ALIGN_EPI) { if (wr == 0) PG8_BAR; }
        if constexpr (!Epi::AFTER_DRAIN) { E(acc, cur, wr, wc, fr, fq);
#ifdef EPI_TWICE
            asm volatile("" ::: "memory"); E(acc, cur, wr, wc, fr, fq);
#endif
            S.done(cur); }
        if (!has_next) break;
#pragma unroll
        for (int a = 0; a < 2; ++a)
#pragma unroll
            for (int b = 0; b < 2; ++b)
#pragma unroll
                for (int m = 0; m < 4; ++m)
#pragma unroll
                    for (int n = 0; n < 2; ++n) acc[a][b][m][n] = (f32x4){0.f, 0.f, 0.f, 0.f};
        cur = nxt; cA = nA; cB = nB; ++ui;
        if constexpr (ALIGN_EPI) { if (wr == 1) PG8_BAR; }
    }
    PG8_WAIT_V(0);
    if constexpr (!ALIGN_EPI) { if (wr == 0) PG8_BAR; }
    PG8_BAR;
    if constexpr (Epi::AFTER_DRAIN) { E.fused(acc, cur, wr, wc, fr, fq, lds, wid, lane); S.done(cur); }
#undef PG8_SA
#undef PG8_SB
#undef PG8_STAGE
#undef PG8_LDA
#undef PG8_LDB
#undef PG8_MMA
#undef PG8_WAIT_V
#undef PG8_WAIT_L
#undef PG8_BAR
#undef PG8_SCHED
}
}
namespace att {
typedef unsigned short bf16;
constexpr int   D = 128, NW = 8, QBLK = 32, KVBLK = 64;
constexpr float SCALE = 0.088388347648318440f;
constexpr float THR = 8.f;
constexpr int SDEPTH = 1;
constexpr int LDQ = 1024, LDK = 1024, LDO = 2048;
constexpr size_t SHM_V = KVBLK * D * 2, SHM_K = KVBLK * D * 2, SHM_ATTN = 2 * SHM_V + 2 * SHM_K + NW * 64 * 4;
using bf16x8 = __attribute__((ext_vector_type(8))) short;
using s16x4  = __attribute__((ext_vector_type(4))) short;
using f32x16 = __attribute__((ext_vector_type(16))) float;
using f32x8  = __attribute__((ext_vector_type(8))) float;
using u32x4  = __attribute__((ext_vector_type(4))) unsigned;
#define KSWZ(row, colB) ((row) * 256 + ((colB) ^ (((row) & 7) << 4)))
#define SBAR() __builtin_amdgcn_sched_barrier(0)
__device__ __forceinline__ int crow(int r, int hi) { return (r & 3) + 8 * (r >> 2) + 4 * hi; }
__device__ __forceinline__ unsigned cvtpk(float lo, float hi) {
  unsigned r; asm volatile("v_cvt_pk_bf16_f32 %0, %1, %2" : "=v"(r) : "v"(lo), "v"(hi)); return r;
}
template <typename TIn> struct Stage;
template <> struct Stage<bf16>  { using T = bf16x8;
  __device__ static __forceinline__ T ld8(const bf16* p) { return *reinterpret_cast<const bf16x8*>(p); }
  __device__ static __forceinline__ bf16x8 tobf(T x) { return x; } };
template <> struct Stage<float> { using T = f32x8;
  __device__ static __forceinline__ T ld8(const float* p) { return *reinterpret_cast<const f32x8*>(p); }
  __device__ static __forceinline__ bf16x8 tobf(T x) {
    u32x4 w = {cvtpk(x[0], x[1]), cvtpk(x[2], x[3]), cvtpk(x[4], x[5]), cvtpk(x[6], x[7])}; return *reinterpret_cast<bf16x8*>(&w); } };

__device__ __forceinline__ void partialSM(f32x16& p0, f32x16& p1, float& m_reg, float& mn, float& alpha) {
  constexpr float C = SCALE * 1.4426950408889634f;
  float pmax = p0[0]; for (int r = 1; r < 16; ++r) pmax = fmaxf(pmax, p0[r]); for (int r = 0; r < 16; ++r) pmax = fmaxf(pmax, p1[r]);
  { auto rr = __builtin_amdgcn_permlane32_swap(__float_as_uint(pmax), __float_as_uint(pmax), false, false);
    pmax = fmaxf(__uint_as_float(rr[0]), __uint_as_float(rr[1])); }
  if (__builtin_expect(__all(pmax - m_reg <= THR / SCALE), 1)) { mn = m_reg; alpha = 1.f; }
  else { mn = fmaxf(m_reg, pmax); alpha = __builtin_amdgcn_exp2f((m_reg - mn) * C); m_reg = mn; }
  float mnC = -mn * C;
  for (int r = 0; r < 16; ++r) p0[r] = fmaf(p0[r], C, mnC); for (int r = 0; r < 16; ++r) p1[r] = fmaf(p1[r], C, mnC);
  for (int r = 0; r < 16; ++r) p0[r] = __builtin_amdgcn_exp2f(p0[r]);
}
__device__ __forceinline__ void finishSM(f32x16& p0, f32x16& p1, float alpha, float& l_reg, bf16x8& pa0, bf16x8& pa1, bf16x8& pa2, bf16x8& pa3) {
  for (int r = 0; r < 16; ++r) p1[r] = __builtin_amdgcn_exp2f(p1[r]);
  float ps = 0; for (int r = 0; r < 16; ++r) ps += p0[r]; for (int r = 0; r < 16; ++r) ps += p1[r];
  { auto rr = __builtin_amdgcn_permlane32_swap(__float_as_uint(ps), __float_as_uint(ps), false, false);
    ps = __uint_as_float(rr[0]) + __uint_as_float(rr[1]); }
  l_reg = l_reg * alpha + ps;
#define PK4(P, BASE, OUT) do { unsigned a0 = cvtpk(P[BASE + 0], P[BASE + 1]), a1 = cvtpk(P[BASE + 2], P[BASE + 3]);   \
    unsigned b0 = cvtpk(P[BASE + 4], P[BASE + 5]), b1 = cvtpk(P[BASE + 6], P[BASE + 7]);                              \
    auto r0 = __builtin_amdgcn_permlane32_swap(a0, b0, false, false); auto r1 = __builtin_amdgcn_permlane32_swap(a1, b1, false, false); \
    u32x4 w = {r0[0], r1[0], r0[1], r1[1]}; OUT = *reinterpret_cast<bf16x8*>(&w); } while (0)
  PK4(p0, 0, pa0); PK4(p0, 8, pa1); PK4(p1, 0, pa2); PK4(p1, 8, pa3);
#undef PK4
}
__device__ __forceinline__ void qkt(f32x16& p0, f32x16& p1, const bf16* Ks, const bf16x8* qr, int r32, int hi) {
  p0 = f32x16{}; p1 = f32x16{};
  for (int d0 = 0; d0 < 8; ++d0) { int cb = (d0 * 16 + hi * 8) * 2;
    bf16x8 b0 = *reinterpret_cast<const bf16x8*>((const char*)Ks + KSWZ(r32, cb));
    bf16x8 b1 = *reinterpret_cast<const bf16x8*>((const char*)Ks + KSWZ(32 + r32, cb));
    p0 = __builtin_amdgcn_mfma_f32_32x32x16_bf16(b0, qr[d0], p0, 0, 0, 0);
    p1 = __builtin_amdgcn_mfma_f32_32x32x16_bf16(b1, qr[d0], p1, 0, 0, 0); }
}
__device__ __forceinline__ int v_st(int k, int c) { const int kk = (k & ~0xC) | ((k & 4) << 1) | ((k & 8) >> 1); return ((kk >> 3) * 4 + (c >> 5)) * 512 + ((kk & 7) * 32 + (c & 31)) * 2; }
__device__ __forceinline__ int v_rd_base(int lane) { return ((lane & 3) << 3) | (((lane >> 2) & 3) << 6) | (((lane >> 4) & 1) << 5) | (((lane >> 5) & 1) << 8); }
constexpr int v_rd_off(int d0, int ks, int half) { return d0 * 512 + ks * 4096 + half * 2048; }
template <int OFF> __device__ __forceinline__ s16x4 tr_read(int vb) {
  s16x4 r; asm volatile("ds_read_b64_tr_b16 %0, %1 offset:%2" : "=&v"(r) : "v"(vb), "i"(OFF) : "memory"); return r;
}
template <int D0> __device__ __forceinline__ void pv_one(f32x16& od, int vb, bf16x8 pa0, bf16x8 pa1, bf16x8 pa2, bf16x8 pa3) {
  const s16x4 l0 = tr_read<v_rd_off(D0, 0, 0)>(vb), h0 = tr_read<v_rd_off(D0, 0, 1)>(vb), l1 = tr_read<v_rd_off(D0, 1, 0)>(vb), h1 = tr_read<v_rd_off(D0, 1, 1)>(vb);
  const s16x4 l2 = tr_read<v_rd_off(D0, 2, 0)>(vb), h2 = tr_read<v_rd_off(D0, 2, 1)>(vb), l3 = tr_read<v_rd_off(D0, 3, 0)>(vb), h3 = tr_read<v_rd_off(D0, 3, 1)>(vb);
  asm volatile("s_waitcnt lgkmcnt(0)" ::: "memory"); SBAR();
#define PK(L, H) (bf16x8){L[0], L[1], L[2], L[3], H[0], H[1], H[2], H[3]}
  od = __builtin_amdgcn_mfma_f32_32x32x16_bf16(pa0, PK(l0, h0), od, 0, 0, 0);
  od = __builtin_amdgcn_mfma_f32_32x32x16_bf16(pa1, PK(l1, h1), od, 0, 0, 0);
  od = __builtin_amdgcn_mfma_f32_32x32x16_bf16(pa2, PK(l2, h2), od, 0, 0, 0);
  od = __builtin_amdgcn_mfma_f32_32x32x16_bf16(pa3, PK(l3, h3), od, 0, 0, 0);
#undef PK
}
template <int KS> __device__ __forceinline__ void pv_rd(int vb, s16x4 (&l)[4], s16x4 (&h)[4]) {
  l[0] = tr_read<v_rd_off(0, KS, 0)>(vb); h[0] = tr_read<v_rd_off(0, KS, 1)>(vb); l[1] = tr_read<v_rd_off(1, KS, 0)>(vb); h[1] = tr_read<v_rd_off(1, KS, 1)>(vb);
  l[2] = tr_read<v_rd_off(2, KS, 0)>(vb); h[2] = tr_read<v_rd_off(2, KS, 1)>(vb); l[3] = tr_read<v_rd_off(3, KS, 0)>(vb); h[3] = tr_read<v_rd_off(3, KS, 1)>(vb);
}
__device__ __forceinline__ void pv_mm(f32x16* o, bf16x8 pa, const s16x4 (&l)[4], const s16x4 (&h)[4]) {
#define PK(L, H) (bf16x8){L[0], L[1], L[2], L[3], H[0], H[1], H[2], H[3]}
  o[0] = __builtin_amdgcn_mfma_f32_32x32x16_bf16(pa, PK(l[0], h[0]), o[0], 0, 0, 0);
  o[1] = __builtin_amdgcn_mfma_f32_32x32x16_bf16(pa, PK(l[1], h[1]), o[1], 0, 0, 0);
  o[2] = __builtin_amdgcn_mfma_f32_32x32x16_bf16(pa, PK(l[2], h[2]), o[2], 0, 0, 0);
  o[3] = __builtin_amdgcn_mfma_f32_32x32x16_bf16(pa, PK(l[3], h[3]), o[3], 0, 0, 0);
#undef PK
}
__device__ __forceinline__ void pv_d0(f32x16* o, int vb, bf16x8 pa0, bf16x8 pa1, bf16x8 pa2, bf16x8 pa3) {
  s16x4 la[4], ha[4], lb[4], hb[4];
  pv_rd<0>(vb, la, ha); pv_rd<1>(vb, lb, hb);
  asm volatile("s_waitcnt lgkmcnt(8)" ::: "memory"); SBAR(); pv_mm(o, pa0, la, ha); SBAR();
  pv_rd<2>(vb, la, ha);
  asm volatile("s_waitcnt lgkmcnt(8)" ::: "memory"); SBAR(); pv_mm(o, pa1, lb, hb); SBAR();
  pv_rd<3>(vb, lb, hb);
  asm volatile("s_waitcnt lgkmcnt(8)" ::: "memory"); SBAR(); pv_mm(o, pa2, la, ha); SBAR();
  asm volatile("s_waitcnt lgkmcnt(0)" ::: "memory"); SBAR(); pv_mm(o, pa3, lb, hb);
}

struct KVSrc { const bf16* k0; const bf16* v0; const bf16* k1; const bf16* v1; int nt0, ntreal; };
__device__ __forceinline__ void mask_tile(f32x16& p0, f32x16& p1) {
#pragma unroll
  for (int r = 0; r < 16; ++r) { p0[r] = -1e30f; p1[r] = -1e30f; }
}
constexpr int OST_PITCH = 272, OST_BYTES = 32 * OST_PITCH;
__device__ __forceinline__ void store_o_rows(const f32x16* o, const float* rli, bf16* Owv, char* stage, int lane, int r32, int hi) {
#pragma unroll
  for (int r = 0; r < 16; ++r) { const int orow = crow(r, hi);
#pragma unroll
    for (int d0 = 0; d0 < 4; ++d0) { const float v = o[d0][r] * rli[r]; const unsigned b = __float_as_uint(v);
      *(unsigned short*)(stage + orow * OST_PITCH + (d0 * 32 + r32) * 2) = (unsigned short)((b + 0x7fffu + ((b >> 16) & 1u)) >> 16); } }
  asm volatile("s_waitcnt lgkmcnt(0)" ::: "memory");
  if (Owv != nullptr) {
#pragma unroll
    for (int i = 0; i < 8; ++i) { const int id = lane + 64 * i, row = id >> 4, c16 = id & 15;
      *(u32x4*)(Owv + (long)row * LDO + c16 * 8) = *(const u32x4*)(stage + row * OST_PITCH + c16 * 16); }
  }
}
template <bool STAGE>
__device__ __forceinline__ void attn_body(const bf16* __restrict__ Qwv, const KVSrc src, bf16* __restrict__ Owv, const int NT, const int lim, char* lds) {
  using St = Stage<bf16>;
  int tid_ = threadIdx.x; asm volatile("" : "+v"(tid_));
  const int tid = tid_, wid = tid >> 6, lane = tid & 63, r32 = lane & 31, hi = lane >> 5;
  bf16* V_lds = (bf16*)lds; bf16* K_lds = (bf16*)(lds + 2 * SHM_V);
  float* ws = (float*)(lds + 2 * SHM_V + 2 * SHM_K) + wid * 64; float* li_l = ws; float* al_l = ws + 32;
  float m_reg = -1e30f, l_reg = 0; f32x16 o[4] = {}; bf16x8 qr[8];
  const bf16* Qw = Qwv + (long)r32 * LDQ + hi * 8;
#pragma unroll
  for (int d0 = 0; d0 < 8; ++d0) qr[d0] = St::ld8(Qw + d0 * 16);
  const int sr = tid >> 4, sc = (tid & 15) * 8, vst0 = v_st(sr, sc), vst1 = v_st(32 + sr, sc);
  const int vb0 = (int)(uintptr_t)V_lds + v_rd_base(lane);
  struct { typename St::T vs0, vs1, ks0, ks1; } sr_[SDEPTH];
#define SLOAD(i, t) do { if constexpr (STAGE) { int tt_ = (t) < src.ntreal ? (t) : src.ntreal - 1; const bf16* kp_; const bf16* vp_; \
    if (tt_ < src.nt0) { kp_ = src.k0 + (long)tt_ * (KVBLK * LDK); vp_ = src.v0 + (long)tt_ * (KVBLK * LDK); } \
    else { kp_ = src.k1 + (long)(tt_ - src.nt0) * (KVBLK * LDK); vp_ = src.v1 + (long)(tt_ - src.nt0) * (KVBLK * LDK); } \
    sr_[i].vs0 = St::ld8(&vp_[(long)sr * LDK + sc]); sr_[i].vs1 = St::ld8(&vp_[(long)(32 + sr) * LDK + sc]); \
    sr_[i].ks0 = St::ld8(&kp_[(long)sr * LDK + sc]); sr_[i].ks1 = St::ld8(&kp_[(long)(32 + sr) * LDK + sc]); } } while (0)
#define SWRITE(b, i) do { if constexpr (STAGE) { *(bf16x8*)((char*)V_lds + (b) * SHM_V + vst0) = St::tobf(sr_[i].vs0);          \
    *(bf16x8*)((char*)V_lds + (b) * SHM_V + vst1) = St::tobf(sr_[i].vs1); int kc = sc * 2;               \
    *(bf16x8*)((char*)K_lds + (b) * SHM_K + KSWZ(sr, kc)) = St::tobf(sr_[i].ks0);                       \
    *(bf16x8*)((char*)K_lds + (b) * SHM_K + KSWZ(32 + sr, kc)) = St::tobf(sr_[i].ks1); } } while (0)
#define SWAIT() do { if constexpr (STAGE) { if constexpr (SDEPTH == 2) asm volatile("s_waitcnt vmcnt(4)" ::: "memory"); else asm volatile("s_waitcnt vmcnt(0)" ::: "memory"); } } while (0)
#define RESC(a) do { if (__any((a) < 1.f)) { if (hi == 0) al_l[r32] = (a); asm volatile("s_waitcnt lgkmcnt(0)" ::: "memory"); \
    for (int d = 0; d < 4; ++d) for (int r = 0; r < 16; ++r) o[d][r] *= al_l[crow(r, hi)]; } } while (0)
  f32x16 pA0, pA1, pB0, pB1; float mnA, mnB, alA, alB; bf16x8 pa0, pa1, pa2, pa3;
  constexpr int SE = 0, SO = SDEPTH - 1;
  SLOAD(SE, 0); asm volatile("s_waitcnt vmcnt(0)" ::: "memory"); SWRITE(0, SE); __syncthreads();
  qkt(pA0, pA1, K_lds, qr, r32, hi); partialSM(pA0, pA1, m_reg, mnA, alA);
  SLOAD(SO, 1); if constexpr (SDEPTH == 2) { if (2 < NT) SLOAD(SE, 2); }
  SWAIT(); SWRITE(1, SO); __syncthreads();
  for (int j = 1; j + 1 < NT; j += 2) {
    SBAR(); qkt(pB0, pB1, (bf16*)((char*)K_lds + SHM_K), qr, r32, hi); if (j > lim) mask_tile(pB0, pB1);
    finishSM(pA0, pA1, alA, l_reg, pa0, pa1, pa2, pa3); SBAR();
    SLOAD(SO, j + SDEPTH); SBAR();
    pv_d0(o, vb0, pa0, pa1, pa2, pa3); partialSM(pB0, pB1, m_reg, mnB, alB);
    __syncthreads(); SWAIT(); SWRITE(0, SE);
    RESC(alB); __syncthreads();
    SBAR(); qkt(pA0, pA1, K_lds, qr, r32, hi); if (j + 1 > lim) mask_tile(pA0, pA1);
    finishSM(pB0, pB1, alB, l_reg, pa0, pa1, pa2, pa3); SBAR();
    if (SDEPTH == 1 || j + 3 < NT) SLOAD(SE, j + 1 + SDEPTH); SBAR();
    pv_d0(o, vb0 + (int)SHM_V, pa0, pa1, pa2, pa3); partialSM(pA0, pA1, m_reg, mnA, alA);
    __syncthreads(); SWAIT(); SWRITE(1, SO);
    RESC(alA); __syncthreads();
  }
  SBAR(); qkt(pB0, pB1, (bf16*)((char*)K_lds + SHM_K), qr, r32, hi); if (NT - 1 > lim) mask_tile(pB0, pB1);
  finishSM(pA0, pA1, alA, l_reg, pa0, pa1, pa2, pa3); SBAR();
  pv_d0(o, vb0, pa0, pa1, pa2, pa3); partialSM(pB0, pB1, m_reg, mnB, alB);
  __syncthreads(); RESC(alB);
  finishSM(pB0, pB1, alB, l_reg, pa0, pa1, pa2, pa3); SBAR();
  pv_d0(o, vb0 + (int)SHM_V, pa0, pa1, pa2, pa3);
  if (hi == 0) li_l[r32] = l_reg; asm volatile("s_waitcnt lgkmcnt(0)" ::: "memory");
  float rli[16];
#pragma unroll
  for (int r = 0; r < 16; ++r) rli[r] = __builtin_amdgcn_rcpf(li_l[crow(r, hi)]);
  store_o_rows(o, rli, Owv, lds + 69632 + wid * OST_BYTES, lane, r32, hi);
  asm volatile("s_waitcnt vmcnt(0)" ::: "memory");
#undef SLOAD
#undef SWRITE
#undef SWAIT
#undef RESC
}
__device__ __forceinline__ void attn_body_1b(const bf16* __restrict__ Qwv, bf16* __restrict__ Owv, const int NT, const int lim, char* lds) {
  using St = Stage<bf16>;
  int tid_ = threadIdx.x; asm volatile("" : "+v"(tid_));
  const int tid = tid_, wid = tid >> 6, lane = tid & 63, r32 = lane & 31, hi = lane >> 5;
  bf16* V_lds = (bf16*)lds; bf16* K_lds = (bf16*)(lds + 2 * SHM_V);
  float* ws = (float*)(lds + 2 * SHM_V + 2 * SHM_K) + wid * 64; float* li_l = ws; float* al_l = ws + 32;
  float m_reg = -1e30f, l_reg = 0; f32x16 o[4] = {}; bf16x8 qr[8];
  const bf16* Qw = Qwv + (long)r32 * LDQ + hi * 8;
#pragma unroll
  for (int d0 = 0; d0 < 8; ++d0) qr[d0] = St::ld8(Qw + d0 * 16);
  const int vb0 = (int)(uintptr_t)V_lds + v_rd_base(lane);
#define RESC(a) do { if (__any((a) < 1.f)) { if (hi == 0) al_l[r32] = (a); asm volatile("s_waitcnt lgkmcnt(0)" ::: "memory"); \
    for (int d = 0; d < 4; ++d) for (int r = 0; r < 16; ++r) o[d][r] *= al_l[crow(r, hi)]; } } while (0)
  f32x16 pA0, pA1, pB0, pB1; float mnA, mnB, alA, alB; bf16x8 pa0, pa1, pa2, pa3;
  __syncthreads();
  qkt(pA0, pA1, K_lds, qr, r32, hi); partialSM(pA0, pA1, m_reg, mnA, alA);
  __syncthreads();
  for (int j = 1; j + 1 < NT; j += 2) {
    SBAR(); qkt(pB0, pB1, (bf16*)((char*)K_lds + SHM_K), qr, r32, hi); if (j > lim) mask_tile(pB0, pB1);
    finishSM(pA0, pA1, alA, l_reg, pa0, pa1, pa2, pa3); SBAR();
    pv_d0(o, vb0, pa0, pa1, pa2, pa3); partialSM(pB0, pB1, m_reg, mnB, alB);
    RESC(alB); __syncthreads();
    SBAR(); qkt(pA0, pA1, K_lds, qr, r32, hi); if (j + 1 > lim) mask_tile(pA0, pA1);
    finishSM(pB0, pB1, alB, l_reg, pa0, pa1, pa2, pa3); SBAR();
    pv_d0(o, vb0 + (int)SHM_V, pa0, pa1, pa2, pa3); partialSM(pA0, pA1, m_reg, mnA, alA);
    RESC(alA); __syncthreads();
  }
  SBAR(); qkt(pB0, pB1, (bf16*)((char*)K_lds + SHM_K), qr, r32, hi); if (NT - 1 > lim) mask_tile(pB0, pB1);
  finishSM(pA0, pA1, alA, l_reg, pa0, pa1, pa2, pa3); SBAR();
  pv_d0(o, vb0, pa0, pa1, pa2, pa3); partialSM(pB0, pB1, m_reg, mnB, alB);
  RESC(alB); __syncthreads();
  finishSM(pB0, pB1, alB, l_reg, pa0, pa1, pa2, pa3); SBAR();
  pv_d0(o, vb0 + (int)SHM_V, pa0, pa1, pa2, pa3);
  if (hi == 0) li_l[r32] = l_reg; asm volatile("s_waitcnt lgkmcnt(0)" ::: "memory");
  float rli[16];
#pragma unroll
  for (int r = 0; r < 16; ++r) rli[r] = __builtin_amdgcn_rcpf(li_l[crow(r, hi)]);
  store_o_rows(o, rli, Owv, lds + 69632 + wid * OST_BYTES, lane, r32, hi);
  asm volatile("s_waitcnt vmcnt(0)" ::: "memory");
#undef RESC
}
typedef float f32x4p __attribute__((ext_vector_type(4)));
template <int PAR>
__device__ __forceinline__ void attn_body_par(const bf16* __restrict__ Qwv, bf16* __restrict__ Owv, const int NT, const int lim, char* lds) {
  using St = Stage<bf16>;
  constexpr float C = SCALE * 1.4426950408889634f;
  int tid_ = threadIdx.x; asm volatile("" : "+v"(tid_));
  const int tid = tid_, wid = tid >> 6, lane = tid & 63, r32 = lane & 31, hi = lane >> 5, pw = wid & 1;
  bf16* V_lds = (bf16*)lds; bf16* K_lds = (bf16*)(lds + 2 * SHM_V);
  float* wsb = (float*)(lds + 2 * SHM_V + 2 * SHM_K);
  float* ws = wsb + wid * 64; float* li_l = ws; float* al_l = ws + 32;
  char* X = (char*)K_lds + pw * 16384;
  float m_reg = -1e30f, l_reg = 0; f32x16 o[4] = {}; bf16x8 qr[8];
  const bf16* Qw = Qwv + (long)r32 * LDQ + hi * 8;
#pragma unroll
  for (int d0 = 0; d0 < 8; ++d0) qr[d0] = St::ld8(Qw + d0 * 16);
  const int vb0 = (int)(uintptr_t)V_lds + v_rd_base(lane) + PAR * (int)SHM_V;
  const bf16* Kp = (const bf16*)((const char*)K_lds + PAR * SHM_K);
#define RESC(a) do { if (__any((a) < 1.f)) { if (hi == 0) al_l[r32] = (a); asm volatile("s_waitcnt lgkmcnt(0)" ::: "memory"); \
    for (int d = 0; d < 4; ++d) for (int r = 0; r < 16; ++r) o[d][r] *= al_l[crow(r, hi)]; } } while (0)
  f32x16 p0, p1; float mn, al; bf16x8 pa0, pa1, pa2, pa3;
  __syncthreads();
  if (PAR == 1) __syncthreads();
  for (int t = PAR; t < NT; t += 2) {
    SBAR(); qkt(p0, p1, Kp, qr, r32, hi); if (t > lim) mask_tile(p0, p1);
    partialSM(p0, p1, m_reg, mn, al); SBAR();
    __syncthreads();
    RESC(al); finishSM(p0, p1, al, l_reg, pa0, pa1, pa2, pa3); SBAR();
    pv_d0(o, vb0, pa0, pa1, pa2, pa3);
    if (PAR == 0 || t + 2 < NT) __syncthreads();
  }
  if (PAR == 1) {
    if (hi == 0) { li_l[r32] = l_reg; al_l[r32] = m_reg; }
#pragma unroll
    for (int d = 0; d < 4; ++d)
#pragma unroll
      for (int q = 0; q < 4; ++q) *(f32x4p*)(X + ((d * 4 + q) * 64 + lane) * 16) = (f32x4p){o[d][4 * q], o[d][4 * q + 1], o[d][4 * q + 2], o[d][4 * q + 3]};
    __syncthreads();
  } else {
    __syncthreads();
    float* pws = wsb + (wid + 6) * 64;
    const float l1 = pws[r32], m1 = pws[32 + r32];
    asm volatile("s_waitcnt lgkmcnt(0)" ::: "memory");
    const float m = fmaxf(m_reg, m1), f0 = __builtin_amdgcn_exp2f((m_reg - m) * C), f1 = __builtin_amdgcn_exp2f((m1 - m) * C);
    if (hi == 0) { li_l[r32] = l_reg * f0 + l1 * f1; al_l[r32] = f0; pws[r32] = f1; }
    asm volatile("s_waitcnt lgkmcnt(0)" ::: "memory");
#pragma unroll
    for (int d = 0; d < 4; ++d)
#pragma unroll
      for (int q = 0; q < 4; ++q) { const f32x4p x = *(const f32x4p*)(X + ((d * 4 + q) * 64 + lane) * 16);
#pragma unroll
        for (int e = 0; e < 4; ++e) { const int r = 4 * q + e; o[d][r] = o[d][r] * al_l[crow(r, hi)] + x[e] * pws[crow(r, hi)]; } }
    float rli[16];
#pragma unroll
    for (int r = 0; r < 16; ++r) rli[r] = __builtin_amdgcn_rcpf(li_l[crow(r, hi)]);
    store_o_rows(o, rli, Owv, lds + 69632 + wid * OST_BYTES, lane, r32, hi);
    asm volatile("s_waitcnt vmcnt(0)" ::: "memory");
  }
#undef RESC
}
__device__ __forceinline__ void attn_stage_only(const KVSrc src, const int NT, char* lds) {
  using St = Stage<bf16>;
  int tid_ = threadIdx.x; asm volatile("" : "+v"(tid_));
  const int tid = tid_;
  bf16* V_lds = (bf16*)lds; bf16* K_lds = (bf16*)(lds + 2 * SHM_V);
  const int sr = tid >> 4, sc = (tid & 15) * 8, vst0 = v_st(sr, sc), vst1 = v_st(32 + sr, sc);
  struct { typename St::T vs0, vs1, ks0, ks1; } sr_[SDEPTH];
#define SLOAD(i, t) do { int tt_ = (t) < src.ntreal ? (t) : src.ntreal - 1; const bf16* kp_; const bf16* vp_; \
    if (tt_ < src.nt0) { kp_ = src.k0 + (long)tt_ * (KVBLK * LDK); vp_ = src.v0 + (long)tt_ * (KVBLK * LDK); } \
    else { kp_ = src.k1 + (long)(tt_ - src.nt0) * (KVBLK * LDK); vp_ = src.v1 + (long)(tt_ - src.nt0) * (KVBLK * LDK); } \
    sr_[i].vs0 = St::ld8(&vp_[(long)sr * LDK + sc]); sr_[i].vs1 = St::ld8(&vp_[(long)(32 + sr) * LDK + sc]); \
    sr_[i].ks0 = St::ld8(&kp_[(long)sr * LDK + sc]); sr_[i].ks1 = St::ld8(&kp_[(long)(32 + sr) * LDK + sc]); } while (0)
#define SWRITE(b, i) do { *(bf16x8*)((char*)V_lds + (b) * SHM_V + vst0) = St::tobf(sr_[i].vs0);          \
    *(bf16x8*)((char*)V_lds + (b) * SHM_V + vst1) = St::tobf(sr_[i].vs1); int kc = sc * 2;               \
    *(bf16x8*)((char*)K_lds + (b) * SHM_K + KSWZ(sr, kc)) = St::tobf(sr_[i].ks0);                       \
    *(bf16x8*)((char*)K_lds + (b) * SHM_K + KSWZ(32 + sr, kc)) = St::tobf(sr_[i].ks1); } while (0)
#define SWAIT() do { if constexpr (SDEPTH == 2) asm volatile("s_waitcnt vmcnt(4)" ::: "memory"); else asm volatile("s_waitcnt vmcnt(0)" ::: "memory"); } while (0)
  constexpr int SE = 0, SO = SDEPTH - 1;
  SLOAD(SE, 0); asm volatile("s_waitcnt vmcnt(0)" ::: "memory"); SWRITE(0, SE); __syncthreads();
  SLOAD(SO, 1); if constexpr (SDEPTH == 2) { if (2 < NT) SLOAD(SE, 2); }
  SWAIT(); SWRITE(1, SO); __syncthreads();
  for (int j = 1; j + 1 < NT; j += 2) {
    SLOAD(SO, j + SDEPTH);
    __syncthreads(); SWAIT(); SWRITE(0, SE);
    __syncthreads();
    if (SDEPTH == 1 || j + 3 < NT) SLOAD(SE, j + 1 + SDEPTH);
    __syncthreads(); SWAIT(); SWRITE(1, SO);
    __syncthreads();
  }
  __syncthreads();
  asm volatile("s_waitcnt vmcnt(0)" ::: "memory");
#undef SLOAD
#undef SWRITE
#undef SWAIT
}
struct KVSrcF { const float* k0; const float* v0; const float* k1; const float* v1; int nt0, ntreal; };
__device__ __forceinline__ void attn_stage_f32(const KVSrcF src, const int NT, char* lds) {
  int tid_ = threadIdx.x; asm volatile("" : "+v"(tid_));
  const int st = tid_ - 128;
  bf16* V_lds = (bf16*)lds; bf16* K_lds = (bf16*)(lds + 2 * SHM_V);
  f32x8 krA[4], vrA[4], krB[4], vrB[4];
#define FBASE(t, K0, K1) ({ int tt_ = (t) < src.ntreal ? (t) : src.ntreal - 1; (tt_ < src.nt0) ? (K0) + (long)tt_ * (KVBLK * 1024) : (K1) + (long)(tt_ - src.nt0) * (KVBLK * 1024); })
#define FLOADK(kr, t) do { const float* kp_ = FBASE(t, src.k0, src.k1); \
    _Pragma("unroll") for (int q = 0; q < 4; ++q) { const int ci = st + 256 * q, row = ci >> 4, cg = ci & 15; kr[q] = *reinterpret_cast<const f32x8*>(kp_ + (long)row * 1024 + cg * 8); } } while (0)
#define FLOADV(vr, t) do { const float* vp_ = FBASE(t, src.v0, src.v1); \
    _Pragma("unroll") for (int q = 0; q < 4; ++q) { const int ci = st + 256 * q, row = ci >> 4, cg = ci & 15; vr[q] = *reinterpret_cast<const f32x8*>(vp_ + (long)row * 1024 + cg * 8); } } while (0)
#define FWRITEK(kr, b) do { _Pragma("unroll") for (int q = 0; q < 4; ++q) { const int ci = st + 256 * q, row = ci >> 4, cg = ci & 15; \
      *(bf16x8*)((char*)K_lds + (b) * SHM_K + KSWZ(row, cg * 16)) = Stage<float>::tobf(kr[q]); } } while (0)
#define FWRITEV(vr, b) do { _Pragma("unroll") for (int q = 0; q < 4; ++q) { const int ci = st + 256 * q, row = ci >> 4, cg = ci & 15; \
      *(bf16x8*)((char*)V_lds + (b) * SHM_V + v_st(row, cg * 8)) = Stage<float>::tobf(vr[q]); } } while (0)
#define FORD() asm volatile("" ::: "memory")
  FLOADK(krA, 0); FLOADV(vrA, 0); FLOADK(krB, 1); FLOADV(vrB, 1);
  FWRITEK(krA, 0); FORD(); FLOADK(krA, 2); __syncthreads();
  FWRITEK(krB, 1); FORD(); FLOADK(krB, 3); FWRITEV(vrA, 0); FORD(); FLOADV(vrA, 2); __syncthreads();
  for (int j = 1; j + 1 < NT; j += 2) {
    FWRITEK(krA, 0); FORD(); FLOADK(krA, j + 3); FWRITEV(vrB, 1); FORD(); FLOADV(vrB, j + 2); __syncthreads();
    FWRITEK(krB, 1); FORD(); FLOADK(krB, j + 4); FWRITEV(vrA, 0); FORD(); FLOADV(vrA, j + 3); __syncthreads();
  }
  FWRITEV(vrB, 1); __syncthreads();
  asm volatile("s_waitcnt vmcnt(0)" ::: "memory");
  __syncthreads();
#undef FBASE
#undef FLOADK
#undef FLOADV
#undef FWRITEK
#undef FWRITEV
#undef FORD
}
__device__ __forceinline__ void attn_barriers_only(const int NT) {
  __syncthreads(); __syncthreads();
  for (int j = 1; j + 1 < NT; j += 2) { __syncthreads(); __syncthreads(); }
  __syncthreads();
}

constexpr int B2_V = 0, B2_VBUF = KVBLK * 256 * 2  , B2_K = 2 * B2_VBUF, B2_X = B2_K + 2 * (int)SHM_K, B2_XW = 2048 + 256,
              B2_WS = B2_X + NW * (B2_XW + 64), B2_BYTES = B2_WS + NW * 64 * 4; static_assert(B2_BYTES <= 131072, "P-sharing body fits the 128 KiB phase scratch");
__device__ __forceinline__ void qkt_half(f32x16& p, const char* Ks, const bf16x8* qr, int krow, int hi) {
  p = f32x16{};
#pragma unroll
  for (int d0 = 0; d0 < 8; ++d0) { const int cb = (d0 * 16 + hi * 8) * 2;
    const bf16x8 b = *reinterpret_cast<const bf16x8*>(Ks + KSWZ(krow, cb));
    p = __builtin_amdgcn_mfma_f32_32x32x16_bf16(b, qr[d0], p, 0, 0, 0); }
}
__device__ __forceinline__ void mask_half(f32x16& p) {
#pragma unroll
  for (int r = 0; r < 16; ++r) p[r] = -1e30f;
}
__device__ __forceinline__ void partialSM_half(f32x16& p, float& m_reg, float& mn, float& alpha) {
  constexpr float C = SCALE * 1.4426950408889634f;
  float pmax = p[0];
#pragma unroll
  for (int r = 1; r < 16; ++r) pmax = fmaxf(pmax, p[r]);
  { auto rr = __builtin_amdgcn_permlane32_swap(__float_as_uint(pmax), __float_as_uint(pmax), false, false);
    pmax = fmaxf(__uint_as_float(rr[0]), __uint_as_float(rr[1])); }
  if (__builtin_expect(__all(pmax - m_reg <= THR / SCALE), 1)) { mn = m_reg; alpha = 1.f; }
  else { mn = fmaxf(m_reg, pmax); alpha = __builtin_amdgcn_exp2f((m_reg - mn) * C); m_reg = mn; }
  const float mnC = -mn * C;
#pragma unroll
  for (int r = 0; r < 16; ++r) p[r] = fmaf(p[r], C, mnC);
#pragma unroll
  for (int r = 0; r < 8; ++r) p[r] = __builtin_amdgcn_exp2f(p[r]);
}
__device__ __forceinline__ void finishSM_half(f32x16& p, float alpha, float& l_reg, bf16x8& f0, bf16x8& f1) {
#pragma unroll
  for (int r = 8; r < 16; ++r) p[r] = __builtin_amdgcn_exp2f(p[r]);
  float ps = 0;
#pragma unroll
  for (int r = 0; r < 16; ++r) ps += p[r];
  { auto rr = __builtin_amdgcn_permlane32_swap(__float_as_uint(ps), __float_as_uint(ps), false, false);
    ps = __uint_as_float(rr[0]) + __uint_as_float(rr[1]); }
  l_reg = l_reg * alpha + ps;
#define PK4(P, BASE, OUT) do { unsigned a0 = cvtpk(P[BASE + 0], P[BASE + 1]), a1 = cvtpk(P[BASE + 2], P[BASE + 3]);   \
    unsigned b0 = cvtpk(P[BASE + 4], P[BASE + 5]), b1 = cvtpk(P[BASE + 6], P[BASE + 7]);                              \
    auto r0 = __builtin_amdgcn_permlane32_swap(a0, b0, false, false); auto r1 = __builtin_amdgcn_permlane32_swap(a1, b1, false, false); \
    u32x4 w = {r0[0], r1[0], r0[1], r1[1]}; OUT = *reinterpret_cast<bf16x8*>(&w); } while (0)
  PK4(p, 0, f0); PK4(p, 8, f1);
#undef PK4
}
__device__ __forceinline__ bf16x8 scale_frag(bf16x8 v, float f) {
  u32x4 u = *reinterpret_cast<u32x4*>(&v); u32x4 o;
#pragma unroll
  for (int i = 0; i < 4; ++i) { const float lo = __uint_as_float(u[i] << 16) * f, hi = __uint_as_float(u[i] & 0xffff0000u) * f; o[i] = cvtpk(lo, hi); }
  return *reinterpret_cast<bf16x8*>(&o);
}
__device__ __forceinline__ void attn_body2(const bf16* __restrict__ Qwv, const KVSrc src, bf16* __restrict__ Owv, const int NT, const int lim, char* lds) {
  using St = Stage<bf16>;
  constexpr float C = SCALE * 1.4426950408889634f;
  int tid_ = threadIdx.x; asm volatile("" : "+v"(tid_));
  const int tid = tid_, wid = tid >> 6, lane = tid & 63, r32 = lane & 31, hi = lane >> 5, vh = wid >> 2;
  char* V_lds = lds + B2_V; char* K_lds = lds + B2_K;
  char* Xme = lds + B2_X + wid * (B2_XW + 64); const char* Xpt = lds + B2_X + (wid ^ 4) * (B2_XW + 64); int xseq = 0;
  float* ws = (float*)(lds + B2_WS) + wid * 64; float* li_l = ws; float* al_l = ws + 32;
  float m_reg = -1e30f, l_reg = 0; f32x16 o[4] = {}; bf16x8 qr[8];
  const bf16* Qw = Qwv + (long)r32 * LDQ + hi * 8;
#pragma unroll
  for (int d0 = 0; d0 < 8; ++d0) qr[d0] = St::ld8(Qw + d0 * 16);
  const int sr = tid >> 4, sc = (tid & 15) * 8, vst0 = v_st(sr, sc), vst1 = v_st(32 + sr, sc);
  const int vb0 = (int)(uintptr_t)V_lds + vh * 16384 + v_rd_base(lane);
  const int krow = vh * 32 + r32;
  struct { typename St::T va0, va1, vb0_, vb1_, ks0, ks1; } sr_;
#define SLOAD2(t) do { int tt_ = (t) < src.ntreal ? (t) : src.ntreal - 1; const bf16* kp_; const bf16* vp_; \
    if (tt_ < src.nt0) { kp_ = src.k0 + (long)tt_ * (KVBLK * LDK); vp_ = src.v0 + (long)tt_ * (KVBLK * LDK); } \
    else { kp_ = src.k1 + (long)(tt_ - src.nt0) * (KVBLK * LDK); vp_ = src.v1 + (long)(tt_ - src.nt0) * (KVBLK * LDK); } \
    sr_.va0 = St::ld8(&vp_[(long)sr * LDK + sc]); sr_.va1 = St::ld8(&vp_[(long)(32 + sr) * LDK + sc]); \
    sr_.vb0_ = St::ld8(&vp_[(long)sr * LDK + 128 + sc]); sr_.vb1_ = St::ld8(&vp_[(long)(32 + sr) * LDK + 128 + sc]); \
    sr_.ks0 = St::ld8(&kp_[(long)sr * LDK + sc]); sr_.ks1 = St::ld8(&kp_[(long)(32 + sr) * LDK + sc]); } while (0)
#define SWRITE2V(b) do { *(bf16x8*)(V_lds + (b) * B2_VBUF + vst0) = sr_.va0; *(bf16x8*)(V_lds + (b) * B2_VBUF + vst1) = sr_.va1; \
    *(bf16x8*)(V_lds + (b) * B2_VBUF + 16384 + vst0) = sr_.vb0_; *(bf16x8*)(V_lds + (b) * B2_VBUF + 16384 + vst1) = sr_.vb1_; } while (0)
#define SWRITE2K(b) do { const int kc = sc * 2; *(bf16x8*)(K_lds + (b) * SHM_K + KSWZ(sr, kc)) = sr_.ks0; *(bf16x8*)(K_lds + (b) * SHM_K + KSWZ(32 + sr, kc)) = sr_.ks1; } while (0)
#define SWRITE2(b) do { SWRITE2V(b); SWRITE2K(b); } while (0)
#define SWAIT2() asm volatile("s_waitcnt vmcnt(0)" ::: "memory")
#define RESC2(a) do { if (__any((a) < 1.f)) { if (hi == 0) al_l[r32] = (a); asm volatile("s_waitcnt lgkmcnt(0)" ::: "memory"); \
    for (int d = 0; d < 4; ++d) for (int r = 0; r < 16; ++r) o[d][r] *= al_l[crow(r, hi)]; } } while (0)
#define XPUT(f0, f1, mn) do { char* xb_ = Xme; *(bf16x8*)(xb_ + lane * 16) = (f0); *(bf16x8*)(xb_ + 1024 + lane * 16) = (f1); if (hi == 0) *(float*)(xb_ + 2048 + r32 * 4) = (mn); \
    asm volatile("s_waitcnt lgkmcnt(0)" ::: "memory"); if (lane == 0) *(volatile int*)(Xme + B2_XW) = xseq; } while (0)
#define XGET(f0, f1, mn) do { for (int sp_ = 0; *(volatile const int*)(Xpt + B2_XW) < xseq && sp_ < (1 << 22); ++sp_) __builtin_amdgcn_s_sleep(1);     asm volatile("" ::: "memory"); const char* xb_ = Xpt; \
    bf16x8 g0_ = *(const bf16x8*)(xb_ + lane * 16), g1_ = *(const bf16x8*)(xb_ + 1024 + lane * 16); const float mp_ = *(const float*)(xb_ + 2048 + r32 * 4); ++xseq; \
    asm volatile("s_waitcnt lgkmcnt(0)" ::: "memory"); const float f_ = __builtin_amdgcn_exp2f((mp_ - (mn)) * C); g0_ = scale_frag(g0_, f_); g1_ = scale_frag(g1_, f_); \
    if (vh == 0) { pa0 = (f0); pa1 = (f1); pa2 = g0_; pa3 = g1_; } else { pa0 = g0_; pa1 = g1_; pa2 = (f0); pa3 = (f1); } } while (0)
  f32x16 pA, pB; float mnA, mnB, alA, alB; bf16x8 fa0, fa1, pa0, pa1, pa2, pa3;
  if (lane == 0) *(volatile int*)(Xme + B2_XW) = -1;
  SLOAD2(0); SWAIT2(); SWRITE2(0); __syncthreads();
  qkt_half(pA, K_lds, qr, krow, hi); partialSM_half(pA, m_reg, mnA, alA);
  SLOAD2(1); SWAIT2(); SWRITE2(1); __syncthreads();
  for (int j = 1; j + 1 < NT; j += 2) {
    SLOAD2(j + 1); SBAR();
    qkt_half(pB, K_lds + SHM_K, qr, krow, hi); if (j > lim) mask_half(pB);
    finishSM_half(pA, alA, l_reg, fa0, fa1); XPUT(fa0, fa1, mnA); SBAR();
    XGET(fa0, fa1, mnA); SBAR();
    pv_d0(o, vb0, pa0, pa1, pa2, pa3); partialSM_half(pB, m_reg, mnB, alB);
    SWAIT2(); SWRITE2K(0); __syncthreads(); SWRITE2V(0);
    RESC2(alB);
    SLOAD2(j + 2); SBAR();
    qkt_half(pA, K_lds, qr, krow, hi); if (j + 1 > lim) mask_half(pA);
    finishSM_half(pB, alB, l_reg, fa0, fa1); XPUT(fa0, fa1, mnB); SBAR();
    XGET(fa0, fa1, mnB); SBAR();
    pv_d0(o, vb0 + B2_VBUF, pa0, pa1, pa2, pa3); partialSM_half(pA, m_reg, mnA, alA);
    SWAIT2(); SWRITE2K(1); __syncthreads(); SWRITE2V(1);
    RESC2(alA);
  }
  SBAR(); qkt_half(pB, K_lds + SHM_K, qr, krow, hi); if (NT - 1 > lim) mask_half(pB);
  finishSM_half(pA, alA, l_reg, fa0, fa1); XPUT(fa0, fa1, mnA); SBAR();
  XGET(fa0, fa1, mnA); SBAR();
  pv_d0(o, vb0, pa0, pa1, pa2, pa3); partialSM_half(pB, m_reg, mnB, alB);
  __syncthreads(); RESC2(alB);
  finishSM_half(pB, alB, l_reg, fa0, fa1); XPUT(fa0, fa1, mnB); SBAR();
  XGET(fa0, fa1, mnB); SBAR();
  pv_d0(o, vb0 + B2_VBUF, pa0, pa1, pa2, pa3);
  __syncthreads();
  if (hi == 0) { *(float*)(Xme + r32 * 4) = l_reg; *(float*)(Xme + 2048 + r32 * 4) = m_reg; }
  __syncthreads();
  { const float lp = *(const float*)(Xpt + r32 * 4), mp = *(const float*)(Xpt + 2048 + r32 * 4);
    asm volatile("s_waitcnt lgkmcnt(0)" ::: "memory");
    l_reg += lp * __builtin_amdgcn_exp2f((mp - m_reg) * C); }
  if (hi == 0) li_l[r32] = l_reg; asm volatile("s_waitcnt lgkmcnt(0)" ::: "memory");
  float rli[16];
#pragma unroll
  for (int r = 0; r < 16; ++r) rli[r] = __builtin_amdgcn_rcpf(li_l[crow(r, hi)]);
  store_o_rows(o, rli, Owv, lds + wid * OST_BYTES, lane, r32, hi);
  asm volatile("s_waitcnt vmcnt(0)" ::: "memory");
}
#undef SLOAD2
#undef SWRITE2
#undef SWRITE2K
#undef SWRITE2V
#undef SWAIT2
#undef RESC2
#undef XPUT
#undef XGET
#undef KSWZ
#undef SBAR
}
constexpr int RING_OFF = 0, RING_BYTES = 131072;
constexpr int LDSCTL_OFF = RING_BYTES, MISC_OFF = LDSCTL_OFF + 320;
constexpr int LDS_BYTES = 147456;
static_assert(MISC_OFF + 128 <= LDS_BYTES, "LDS map");

#define GAS __attribute__((address_space(1)))
#define LAS __attribute__((address_space(3)))
typedef unsigned short bf16;
typedef unsigned v4u __attribute__((ext_vector_type(4)));
typedef unsigned v2u __attribute__((ext_vector_type(2)));
typedef float f32x4 __attribute__((ext_vector_type(4)));
typedef float f32x16 __attribute__((ext_vector_type(16)));
typedef short bf16x8 __attribute__((ext_vector_type(8)));
typedef GAS unsigned gu32;
#define RLX_AGENT __ATOMIC_RELAXED, __HIP_MEMORY_SCOPE_AGENT
#define LDS_WAIT() asm volatile("s_waitcnt lgkmcnt(0)" ::: "memory")
#define VM_WAIT() asm volatile("s_waitcnt vmcnt(0)" ::: "memory")
__device__ __forceinline__ unsigned f2bf(float f) { unsigned u = __builtin_bit_cast(unsigned, f); return (u + 0x7fffu + ((u >> 16) & 1u)) >> 16; }
__device__ __forceinline__ unsigned pk2(float lo, float hi) { return f2bf(lo) | (f2bf(hi) << 16); }
__device__ __forceinline__ float bf2f(unsigned short b) { return __builtin_bit_cast(float, (unsigned)b << 16); }
#define XB_TMO      128
#define XB_XCNT(j)  (256  + 64 * (j))
#define XB_XSUB(j)  (1280 + 64 * (j))
#define XB_XGEN(j)  (2304 + 64 * (j))
#define XB_TOP      3328
#define XB_TOPGEN   3392
#define XCD_BAR_WORDS 3456
#define XB_SPIN_CAP (1u << 18)

__device__ __forceinline__ unsigned xb_ld(unsigned* p)              { return __hip_atomic_load(p, __ATOMIC_RELAXED, __HIP_MEMORY_SCOPE_AGENT); }
__device__ __forceinline__ unsigned xb_add(unsigned* p, unsigned v) { return __hip_atomic_fetch_add(p, v, __ATOMIC_RELAXED, __HIP_MEMORY_SCOPE_AGENT); }
__device__ __forceinline__ unsigned xb_xcc_id() { return (unsigned)__builtin_amdgcn_s_getreg((3 << 11) | 20) & 0xFu; }
#define XB_SPIN(cond, bar) do { unsigned _sp = 0; while (cond) { __builtin_amdgcn_s_sleep(1); \
    if ((++_sp & 255u) == 0u) { if (xb_ld(&(bar)[XB_TMO])) break; if (_sp > XB_SPIN_CAP) { atomicAdd(&(bar)[XB_TMO], 1u); break; } } } } while (0)

struct XcdBarrier {
    unsigned* bar; unsigned x;
    volatile LAS unsigned* st;
};

__device__ __forceinline__ XcdBarrier xcd_barrier_post(unsigned* bar, volatile LAS unsigned* st) {
    XcdBarrier b; b.bar = bar; b.x = xb_xcc_id(); b.st = st;
    if (threadIdx.x == 0) (void)xb_add(&bar[XB_XCNT(b.x)], 1u);
    return b;
}
__device__ __forceinline__ void xcd_barrier_complete(unsigned* bar, unsigned x, unsigned& nloc, unsigned& nx) {
    const unsigned G = gridDim.x * gridDim.y * gridDim.z;
    unsigned sum, cnt, mine, sp = 0u;
    for (;;) {
        sum = 0u; cnt = 0u; mine = 0u;
#pragma unroll
        for (unsigned j = 0; j < 16; ++j) { const unsigned c = xb_ld(&bar[XB_XCNT(j)]); sum += c; cnt += (c > 0u) ? 1u : 0u; mine = (j == x) ? c : mine; }
        if (sum == G) break;
        __builtin_amdgcn_s_sleep(1);
        if ((++sp & 255u) == 0u) { if (xb_ld(&bar[XB_TMO])) break; if (sp > XB_SPIN_CAP) { atomicAdd(&bar[XB_TMO], 1u); break; } }
    }
    nloc = mine > 0u ? mine : 1u; nx = cnt > 0u ? cnt : 1u;
}

__device__ __forceinline__ void xcd_barrier(const XcdBarrier& b) {
    asm volatile("s_waitcnt vmcnt(0)" ::: "memory");
    __syncthreads();
    int xb_tid_ = threadIdx.x; asm volatile("" : "+v"(xb_tid_));
    if (xb_tid_ == 0) {
        unsigned* bar = b.bar;
        __builtin_amdgcn_s_waitcnt(0);
        unsigned nloc = b.st[0], nx = b.st[1];
        if (nloc == 0u) { xcd_barrier_complete(bar, b.x, nloc, nx); b.st[0] = nloc; b.st[1] = nx; }
        const unsigned old = xb_add(&bar[XB_XSUB(b.x)], 1u);
        const unsigned gen = old / nloc;
        if (old + 1u == (gen + 1u) * nloc) {
            __builtin_amdgcn_fence(__ATOMIC_RELEASE, "agent");
            asm volatile("s_waitcnt vmcnt(0)" ::: "memory");
            const unsigned og = xb_add(&bar[XB_TOP], 1u);
            const unsigned tg = og / nx;
            if (og + 1u == (tg + 1u) * nx) xb_add(&bar[XB_TOPGEN], 1u);
            else XB_SPIN(xb_ld(&bar[XB_TOPGEN]) == tg, bar);
            __builtin_amdgcn_fence(__ATOMIC_ACQUIRE, "agent");
            xb_add(&bar[XB_XGEN(b.x)], 1u);
            asm volatile("s_waitcnt vmcnt(0)" ::: "memory");
        } else {
            XB_SPIN(xb_ld(&bar[XB_XGEN(b.x)]) == gen, bar);
            __builtin_amdgcn_fence(__ATOMIC_ACQUIRE, "agent");
            asm volatile("s_waitcnt vmcnt(0)" ::: "memory");
        }
    }
    __syncthreads();
}
struct Args { const float* in[21]; float* out; unsigned char* ws; int ph_lo, ph_hi, li, pad; };
typedef const __attribute__((address_space(4))) Args* KArgs;
struct Frame {
    LAS unsigned char* lds;
    volatile LAS unsigned* MISC;
    gu32* ctl;
    int tid, lane, wave, G, bid;
    float* out; unsigned char* ws;
};
__device__ __forceinline__ float wave_sum(float v) {
#pragma unroll
    for (int o = 1; o < 64; o <<= 1) v += __shfl_xor(v, o);
    return v;
}
__device__ __forceinline__ float silu(float x) { return x * __builtin_amdgcn_rcpf(1.0f + __expf(-x)); }
__device__ __forceinline__ int crow(int r, int hi) { return (r & 3) + 8 * (r >> 2) + 4 * hi; }

__device__ __forceinline__ void p0_transpose_item(const float* W, int K, int N, bf16* WT, int ldw, LAS float* scr, int item, int lane) {
    const int nblk = N / 32, kb = item / nblk, nb = item % nblk, k0 = 64 * kb, n0 = 32 * nb;
#pragma unroll 8
    for (int i = 0; i < 32; ++i) { const int kk = 2 * i + (lane >> 5); scr[kk * 33 + (lane & 31)] = W[(size_t)(k0 + kk) * N + n0 + (lane & 31)]; }
    LDS_WAIT(); asm volatile("" ::: "memory");
    const int c = lane & 7;
#pragma unroll
    for (int j = 0; j < 4; ++j) { const int n = (lane >> 3) + 8 * j; const LAS float* s = scr + (8 * c) * 33 + n;
        v4u o; o.x = pk2(s[0 * 33], s[1 * 33]); o.y = pk2(s[2 * 33], s[3 * 33]); o.z = pk2(s[4 * 33], s[5 * 33]); o.w = pk2(s[6 * 33], s[7 * 33]);
        *(GAS v4u*)(WT + (size_t)(n0 + n) * ldw + k0 + 8 * c) = o; }
    LDS_WAIT(); asm volatile("" ::: "memory");
}
__device__ __forceinline__ const float* xrow_in(KArgs A, int m) { return m < MP ? A->in[0] + (size_t)m * DM : A->in[1] + (size_t)(m - MP) * DM; }

__device__ __forceinline__ void norm_row_to_bf16(const float* xr, const f32x4 (&G)[8]  , bf16* orow, int lane) {
    const GAS f32x4* xp = (const GAS f32x4*)xr + lane;
    f32x4 v[8]; float s = 0.f;
#pragma unroll
    for (int j = 0; j < 8; ++j) { v[j] = xp[64 * j]; s += (v[j].x * v[j].x + v[j].y * v[j].y) + (v[j].z * v[j].z + v[j].w * v[j].w); }
    const float rinv = 1.0f / sqrtf(wave_sum(s) * (1.0f / DM) + EPS);
    GAS v2u* o8 = (GAS v2u*)orow + lane;
#pragma unroll
    for (int j = 0; j < 8; ++j) { const f32x4 gg = G[j]; v2u w; w.x = pk2(v[j].x * rinv * gg.x, v[j].y * rinv * gg.y); w.y = pk2(v[j].z * rinv * gg.z, v[j].w * rinv * gg.w); o8[64 * j] = w; }
}
__device__ __forceinline__ void load_gain(const float* g, int lane, f32x4 (&G)[8]) {
#pragma unroll
    for (int j = 0; j < 4; ++j) { G[2 * j] = *(const GAS f32x4*)(g + 512 * j + 8 * lane); G[2 * j + 1] = *(const GAS f32x4*)(g + 512 * j + 8 * lane + 4); }
}
__device__ __forceinline__ void resid_norm_row(const bf16* ybf, int nparts, size_t pstride, const float* xi32, const bf16* xi16, const f32x4 (&G1)[8],
                                               float* xo32, bf16* xo16, const bool has2, const f32x4 (&G2)[8], bf16* hrow, int lane) {
    float v[4][8]; float s = 0.f;
#pragma unroll
    for (int j = 0; j < 4; ++j) { const bf16x8 t = *(const GAS bf16x8*)(ybf + 512 * j + 8 * lane);
#pragma unroll
        for (int i = 0; i < 8; ++i) v[j][i] = bf2f((unsigned short)t[i]); }
    for (int q = 1; q < nparts; ++q) { const bf16* pp = ybf + (size_t)q * pstride;
#pragma unroll
        for (int j = 0; j < 4; ++j) { const bf16x8 t = *(const GAS bf16x8*)(pp + 512 * j + 8 * lane);
#pragma unroll
            for (int i = 0; i < 8; ++i) v[j][i] += bf2f((unsigned short)t[i]); } }
#pragma unroll
    for (int j = 0; j < 4; ++j)
#pragma unroll
        for (int i = 0; i < 8; ++i) s += v[j][i] * v[j][i];
    const float rinv = 1.0f / sqrtf(wave_sum(s) * (1.0f / DM) + EPS);
    float s2 = 0.f;
#pragma unroll
    for (int j = 0; j < 4; ++j) {
        const f32x4 ga = G1[2 * j], gb = G1[2 * j + 1];
        const float gg[8] = {ga.x, ga.y, ga.z, ga.w, gb.x, gb.y, gb.z, gb.w};
        float xx[8];
        if (xi32) { const f32x4 a = *(const GAS f32x4*)(xi32 + 512 * j + 8 * lane), b = *(const GAS f32x4*)(xi32 + 512 * j + 8 * lane + 4);
            xx[0] = a.x; xx[1] = a.y; xx[2] = a.z; xx[3] = a.w; xx[4] = b.x; xx[5] = b.y; xx[6] = b.z; xx[7] = b.w; }
        else { const bf16x8 t = *(const GAS bf16x8*)(xi16 + 512 * j + 8 * lane);
#pragma unroll
            for (int i = 0; i < 8; ++i) xx[i] = bf2f((unsigned short)t[i]); }
#pragma unroll
        for (int i = 0; i < 8; ++i) { v[j][i] = xx[i] + v[j][i] * rinv * gg[i]; s2 += v[j][i] * v[j][i]; }
        if (xo32) { *(GAS f32x4*)(xo32 + 512 * j + 8 * lane) = (f32x4){v[j][0], v[j][1], v[j][2], v[j][3]}; *(GAS f32x4*)(xo32 + 512 * j + 8 * lane + 4) = (f32x4){v[j][4], v[j][5], v[j][6], v[j][7]}; }
        else { v4u w; w.x = pk2(v[j][0], v[j][1]); w.y = pk2(v[j][2], v[j][3]); w.z = pk2(v[j][4], v[j][5]); w.w = pk2(v[j][6], v[j][7]); *(GAS v4u*)(xo16 + 512 * j + 8 * lane) = w;
#pragma unroll
               for (int i = 0; i < 8; ++i) v[j][i] = bf2f((unsigned short)(i & 1 ? ((i < 2 ? w.x : i < 4 ? w.y : i < 6 ? w.z : w.w) >> 16) : ((i < 2 ? w.x : i < 4 ? w.y : i < 6 ? w.z : w.w) & 0xffffu))); }
    }
    if (has2) {
        if (!xo32) { s2 = 0.f;
#pragma unroll
            for (int j = 0; j < 4; ++j)
#pragma unroll
                for (int i = 0; i < 8; ++i) s2 += v[j][i] * v[j][i]; }
        const float rinv2 = 1.0f / sqrtf(wave_sum(s2) * (1.0f / DM) + EPS);
#pragma unroll
        for (int j = 0; j < 4; ++j) {
            const f32x4 ga = G2[2 * j], gb = G2[2 * j + 1];
            v4u w; w.x = pk2(v[j][0] * rinv2 * ga.x, v[j][1] * rinv2 * ga.y); w.y = pk2(v[j][2] * rinv2 * ga.z, v[j][3] * rinv2 * ga.w);
            w.z = pk2(v[j][4] * rinv2 * gb.x, v[j][5] * rinv2 * gb.y); w.w = pk2(v[j][6] * rinv2 * gb.z, v[j][7] * rinv2 * gb.w);
            *(GAS v4u*)(hrow + 512 * j + 8 * lane) = w; }
    }
}
__device__ __forceinline__ void convert_cache(const Frame& F, KArgs A, int l) {
    const size_t n8 = (size_t)16 * PAST * 1024 / 8;
    const float* ck = A->in[4] + (size_t)l * 16 * PAST * 1024; const float* cv = A->in[5] + (size_t)l * 16 * PAST * 1024;
    bf16* ok = (bf16*)(F.ws + WS_CK); bf16* ov = (bf16*)(F.ws + WS_CV);
    for (size_t i = (size_t)F.bid * 512 + F.tid; i < 2 * n8; i += (size_t)F.G * 512) {
        const bool isk = i < n8; const size_t j = isk ? i : i - n8;
        const f32x4 a = *(const GAS f32x4*)((isk ? ck : cv) + j * 8), b = *(const GAS f32x4*)((isk ? ck : cv) + j * 8 + 4);
        v4u w; w.x = pk2(a.x, a.y); w.y = pk2(a.z, a.w); w.z = pk2(b.x, b.y); w.w = pk2(b.z, b.w);
        *(GAS v4u*)((isk ? ok : ov) + j * 8) = w;
    }
}
__device__ __forceinline__ void phase_prologue(Frame& F, KArgs A) {
    LAS float* scr = (LAS float*)(F.lds + RING_OFF + F.wave * 16384);
    const int gw = F.bid * NWAVES + F.wave, NGW = F.G * NWAVES;
    constexpr int I_IN = (DM / 64) * (NIN / 32), I_OUT = (DM / 64) * (DM / 32), I_UP = (DM / 64) * (DFF / 32), I_DN = (DFF / 64) * (DM / 32);
    constexpr int I_L = I_IN + I_OUT + I_UP;
    static_assert(I_DN > 0, "");
    for (int it = gw; it < DEPTH * I_L; it += NGW) {
        const int l = it / I_L; int r = it % I_L;
        if (r < I_IN) { p0_transpose_item(A->in[6] + (size_t)l * DM * NIN, DM, NIN, (bf16*)(F.ws + WS_WIN + l * WIN_BYTES), DM, scr, r, F.lane); continue; } r -= I_IN;
        if (r < I_OUT) { p0_transpose_item(A->in[7] + (size_t)l * DM * DM, DM, DM, (bf16*)(F.ws + WS_WOUT + l * WOUT_BYTES), DM, scr, r, F.lane); continue; } r -= I_OUT;
        p0_transpose_item(A->in[8] + (size_t)l * DM * DFF, DM, DFF, (bf16*)(F.ws + WS_WUP + l * WUP_BYTES), DM, scr, r, F.lane);
    }
    float* rot = (float*)(F.ws + WS_ROT);
    for (int i = F.bid * 512 + F.tid; i < SEQ * 32; i += F.G * 512) {
        const int pos = i >> 5, k = i & 31;
        const double inv = exp(-((double)k / 31.0) * 9.210340371976184);
        double a = (double)pos * inv; a -= 6.283185307179586 * rint(a / 6.283185307179586);
        rot[pos * 64 + k] = (float)cos(a); rot[pos * 64 + 32 + k] = (float)sin(a);
    }
    if (F.bid == 0) {
        float* sc = (float*)(F.ws + WS_SCAL);
        if (F.wave < DEPTH) {
            const int l = F.wave;
            float a = A->in[16][l * 128 + F.lane] * A->in[17][l * 128 + F.lane] + A->in[16][l * 128 + 64 + F.lane] * A->in[17][l * 128 + 64 + F.lane];
            float b = A->in[18][l * 128 + F.lane] * A->in[19][l * 128 + F.lane] + A->in[18][l * 128 + 64 + F.lane] * A->in[19][l * 128 + 64 + F.lane];
            a = wave_sum(a); b = wave_sum(b);
            const float lam_init = 0.8f - 0.6f * expf(-0.3f * (float)l);
            if (F.lane == 0) sc[l] = expf(a) - expf(b) + lam_init;
        }
        { const float l0 = A->in[14][F.tid], l1 = A->in[14][512 + F.tid]; sc[16 + F.tid] = 1.0f / (1.0f + expf(l0 - l1)); }
    }
    { f32x4 G0[8]; const GAS f32x4* gp = (const GAS f32x4*)A->in[10] + F.lane;
#pragma unroll
      for (int j = 0; j < 8; ++j) G0[j] = gp[64 * j];
      for (int m = gw; m < M; m += NGW) norm_row_to_bf16(xrow_in(A, m), G0, (bf16*)(F.ws + WS_H) + (size_t)m * DM, F.lane); }
}

__device__ __forceinline__ void convert_wdn(Frame& F, KArgs A, int l) {
    constexpr int I_DN = (DFF / 64) * (DM / 32), NUNITS = (M / 256) * (DFF / 256);
    const int rounds = (NUNITS + F.G - 1) / F.G; int nfull = NUNITS - (rounds - 1) * F.G; if (nfull >= F.G) nfull = 0;
    if (F.bid < nfull) return;
    LAS float* scr = (LAS float*)(F.lds + RING_OFF + F.wave * 16384);
    const int gw = (F.bid - nfull) * NWAVES + F.wave, NGW = (F.G - nfull) * NWAVES;
    for (int r = gw; r < I_DN; r += NGW) p0_transpose_item(A->in[9] + (size_t)l * DFF * DM, DFF, DM, (bf16*)(F.ws + WS_WDN + l * WDN_BYTES), LDU, scr, r, F.lane);
}
template <int K> __device__ __forceinline__ void mma_tile(f32x16& acc, const LAS unsigned char* A, int lda, const LAS unsigned char* B, int ldb, int lane) {
    const int r = lane & 31, h = lane >> 5;
#pragma unroll
    for (int k0 = 0; k0 < K; k0 += 16) {
        const bf16x8 a = *(const LAS bf16x8*)(A + r * lda + (k0 + 8 * h) * 2);
        const bf16x8 b = *(const LAS bf16x8*)(B + r * ldb + (k0 + 8 * h) * 2);
        acc = __builtin_amdgcn_mfma_f32_32x32x16_bf16(a, b, acc, 0, 0, 0);
    }
}
constexpr int LD128 = 272, LD64 = 144;
__device__ __forceinline__ float ret_log_gamma(int head) { return log1pf(-exp2f(-5.0f - (float)head)); }
__device__ __forceinline__ int chunk_pos0(int chunk) { return chunk < 256 ? (chunk & 127) * 64 : PAST; }

constexpr int SEG_OFF = 126976;
__device__ __forceinline__ void chunk_cumsum(const LAS float* LG, LAS float* BC, LAS float* SEG, int tid) {
    const int k = tid & 127, seg = tid >> 7;
    float pre[16];
#pragma unroll
    for (int i = 0; i < 16; ++i) pre[i] = LG[(seg * 16 + i) * 128 + k];
#pragma unroll
    for (int i = 1; i < 16; ++i) pre[i] += pre[i - 1];
    SEG[seg * 128 + k] = pre[15];
    __syncthreads();
    float off = 0.f;
#pragma unroll
    for (int s = 0; s < 3; ++s) { const float v = SEG[s * 128 + k]; off += (s < seg) ? v : 0.f; }
#pragma unroll
    for (int i = 0; i < 16; ++i) BC[(seg * 16 + i) * 128 + k] = pre[i] + off;
}
__device__ __forceinline__ void hgrn_state_unit(Frame& F, int chunk, int head) {
    LAS unsigned char* lds = F.lds; const int tid = F.tid, lane = F.lane, w = F.wave;
    LAS float* LG = (LAS float*)lds; LAS float* BC = (LAS float*)(lds + 32768); LAS float* SEG = (LAS float*)(lds + SEG_OFF);
    LAS unsigned char* KDT = lds + 65536; LAS unsigned char* VT = lds + 65536 + 128 * LD64;
    const int row0 = chunk * 64, unit = chunk * 4 + head;
    const float* logf = (const float*)(F.ws + WS_R1 + R1_LOGF); const bf16* AI = (const bf16*)(F.ws + WS_R1 + R1_AI);
    f32x4 lgv[4];
#pragma unroll
    for (int q = 0; q < 4; ++q) { const int i = tid + 512 * q, t = i >> 5, c4 = i & 31; lgv[q] = *(const GAS f32x4*)(logf + (size_t)(row0 + t) * 512 + head * 128 + c4 * 4); }
    const int sp = tid >> 4, vg = tid & 15;
    const bf16x8 va = *(const GAS bf16x8*)(AI + (size_t)(row0 + 2 * sp) * 512 + head * 128 + vg * 8), vb = *(const GAS bf16x8*)(AI + (size_t)(row0 + 2 * sp + 1) * 512 + head * 128 + vg * 8);
#pragma unroll
    for (int q = 0; q < 4; ++q) { const int i = tid + 512 * q, t = i >> 5, c4 = i & 31; *(LAS f32x4*)(LG + t * 128 + c4 * 4) = lgv[q]; }
    __syncthreads();
    chunk_cumsum(LG, BC, SEG, tid);
#pragma unroll
    for (int e = 0; e < 8; ++e) *(LAS unsigned*)(VT + (vg * 8 + e) * LD64 + sp * 4) = (unsigned)(unsigned short)va[e] | ((unsigned)(unsigned short)vb[e] << 16);
    __syncthreads();
    for (int i = tid; i < 128 * 32; i += 512) { const int k = i & 127, s2 = i >> 7;
        const float bt = BC[63 * 128 + k];
        const float k0 = (1.0f - __expf(LG[(2 * s2) * 128 + k])) * __expf(bt - BC[(2 * s2) * 128 + k]);
        const float k1 = (1.0f - __expf(LG[(2 * s2 + 1) * 128 + k])) * __expf(bt - BC[(2 * s2 + 1) * 128 + k]);
        *(LAS unsigned*)(KDT + k * LD64 + s2 * 4) = pk2(k0, k1); }
    if (tid < 128) ((float*)(F.ws + WS_DEC))[unit * 128 + tid] = __expf(BC[63 * 128 + tid]);
    __syncthreads();
    const int vt = w >> 1, kt0 = (w & 1) * 2, r32 = lane & 31, hi = lane >> 5;
    f32x16 acc0 = {}, acc1 = {};
    mma_tile<64>(acc0, VT + vt * 32 * LD64, LD64, KDT + kt0 * 32 * LD64, LD64, lane);
    mma_tile<64>(acc1, VT + vt * 32 * LD64, LD64, KDT + (kt0 + 1) * 32 * LD64, LD64, lane);
    LAS unsigned char* TB = lds;
#pragma unroll
    for (int i = 0; i < 16; ++i) { const int v = vt * 32 + crow(i, hi);
        *(LAS unsigned short*)(TB + v * LD128 + (kt0 * 32 + r32) * 2) = (unsigned short)f2bf(acc0[i]); *(LAS unsigned short*)(TB + v * LD128 + ((kt0 + 1) * 32 + r32) * 2) = (unsigned short)f2bf(acc1[i]); }
    __syncthreads();
    bf16* dst = (bf16*)(F.ws + WS_DSA) + (size_t)unit * 16384;
#pragma unroll
    for (int q = 0; q < 4; ++q) { const int i = tid + 512 * q, v = i >> 4, c = i & 15; *(GAS v4u*)(dst + v * 128 + c * 8) = *(const LAS v4u*)(TB + v * LD128 + c * 16); }
    __syncthreads();
}
__device__ __forceinline__ void rot8(const bf16x8 x1, const bf16x8 x2, const float* rt, int g, float sc, float (&o1)[8], float (&o2)[8]) {
    const f32x4 c0 = *(const GAS f32x4*)(rt + 8 * g), c1 = *(const GAS f32x4*)(rt + 8 * g + 4), s0 = *(const GAS f32x4*)(rt + 32 + 8 * g), s1 = *(const GAS f32x4*)(rt + 32 + 8 * g + 4);
    const float cc[8] = {c0.x, c0.y, c0.z, c0.w, c1.x, c1.y, c1.z, c1.w}, ss[8] = {s0.x, s0.y, s0.z, s0.w, s1.x, s1.y, s1.z, s1.w};
#pragma unroll
    for (int e = 0; e < 8; ++e) { const float a = bf2f((unsigned short)x1[e]), b = bf2f((unsigned short)x2[e]); o1[e] = (a * cc[e] - b * ss[e]) * sc; o2[e] = (a * ss[e] + b * cc[e]) * sc; }
}
__device__ __forceinline__ void ret_state_unit(Frame& F, int chunk, int head) {
    LAS unsigned char* lds = F.lds; const int tid = F.tid, lane = F.lane, w = F.wave;
    LAS unsigned char* KDT = lds; LAS unsigned char* VT = lds + 64 * LD64;
    const int row0 = chunk * 64, unit = chunk * 4 + head, pos0 = chunk_pos0(chunk);
    const bf16* BK = (const bf16*)(F.ws + WS_R1 + R1_BK); const bf16* BV = (const bf16*)(F.ws + WS_R1 + R1_BV); const float* rot = (const float*)(F.ws + WS_ROT);
    const float lg = ret_log_gamma(head);
    const int sp = tid >> 4, vg = tid & 15;
    const bf16x8 va = *(const GAS bf16x8*)(BV + (size_t)(row0 + 2 * sp) * 512 + head * 128 + vg * 8), vb = *(const GAS bf16x8*)(BV + (size_t)(row0 + 2 * sp + 1) * 512 + head * 128 + vg * 8);
    if (tid < 128) {
        const int s2 = tid >> 2, g = tid & 3; float a1[8], a2[8], b1[8], b2[8];
        { const bf16* kr = BK + (size_t)(row0 + 2 * s2) * 256 + head * 64; rot8(*(const GAS bf16x8*)(kr + 8 * g), *(const GAS bf16x8*)(kr + 32 + 8 * g), rot + (size_t)(pos0 + 2 * s2) * 64, g, 0.125f * __expf((float)(63 - 2 * s2) * lg), a1, a2); }
        { const bf16* kr = BK + (size_t)(row0 + 2 * s2 + 1) * 256 + head * 64; rot8(*(const GAS bf16x8*)(kr + 8 * g), *(const GAS bf16x8*)(kr + 32 + 8 * g), rot + (size_t)(pos0 + 2 * s2 + 1) * 64, g, 0.125f * __expf((float)(62 - 2 * s2) * lg), b1, b2); }
#pragma unroll
        for (int e = 0; e < 8; ++e) { *(LAS unsigned*)(KDT + (8 * g + e) * LD64 + s2 * 4) = pk2(a1[e], b1[e]); *(LAS unsigned*)(KDT + (32 + 8 * g + e) * LD64 + s2 * 4) = pk2(a2[e], b2[e]); }
    }
#pragma unroll
    for (int e = 0; e < 8; ++e) *(LAS unsigned*)(VT + (vg * 8 + e) * LD64 + sp * 4) = (unsigned)(unsigned short)va[e] | ((unsigned)(unsigned short)vb[e] << 16);
    __syncthreads();
    const int vt = w >> 1, kt = w & 1, r32 = lane & 31, hi = lane >> 5;
    f32x16 acc = {};
    mma_tile<64>(acc, VT + vt * 32 * LD64, LD64, KDT + kt * 32 * LD64, LD64, lane);
    LAS unsigned char* TB = lds + 32768;
#pragma unroll
    for (int i = 0; i < 16; ++i) { const int v = vt * 32 + crow(i, hi); *(LAS unsigned short*)(TB + v * LD64 + (kt * 32 + r32) * 2) = (unsigned short)f2bf(acc[i]); }
    __syncthreads();
    bf16* dst = (bf16*)(F.ws + WS_DSB) + (size_t)unit * 8192;
#pragma unroll
    for (int q = 0; q < 2; ++q) { const int i = tid + 512 * q, v = i >> 3, c = i & 7; *(GAS v4u*)(dst + v * 64 + c * 8) = *(const LAS v4u*)(TB + v * LD64 + c * 16); }
    __syncthreads();
}
__device__ __forceinline__ void phase_scan(Frame& F, KArgs A, int l) {
    unsigned* dsa = (unsigned*)(F.ws + WS_DSA); unsigned* dsb = (unsigned*)(F.ws + WS_DSB); const float* dec = (const float*)(F.ws + WS_DEC);
    constexpr int NA_P = 2 * 4 * 8192, NB_P = 2 * 4 * 4096, NA_S = 16 * 4 * 8192, NB_S = 16 * 4 * 4096;
    const int nthr = F.G * 512;
    for (int e = F.bid * 512 + F.tid; e < NA_P + NB_P + NA_S + NB_S; e += nthr) {
        if (e < NA_P) {
            const int b = e >> 15, head = (e >> 13) & 3, idx = e & 8191, k = (idx & 63) * 2, v = idx >> 6;
            float S0 = 0.f, S1 = 0.f;
            for (int c0 = 0; c0 < 128; c0 += 16) {
                unsigned t[16]; float d0[16], d1[16];
#pragma unroll
                for (int j = 0; j < 16; ++j) { const int unit = (b * 128 + c0 + j) * 4 + head; t[j] = dsa[(size_t)unit * 8192 + idx]; d0[j] = dec[unit * 128 + k]; d1[j] = dec[unit * 128 + k + 1]; }
#pragma unroll
                for (int j = 0; j < 16; ++j) { const int unit = (b * 128 + c0 + j) * 4 + head; dsa[(size_t)unit * 8192 + idx] = pk2(S0, S1);
                    S0 = d0[j] * S0 + __uint_as_float(t[j] << 16); S1 = d1[j] * S1 + __uint_as_float(t[j] & 0xffff0000u); }
            }
            float* o = F.out + O_HP + ((size_t)(l * 2 + b) * 4 + head) * 16384; o[k * 128 + v] = S0; o[(k + 1) * 128 + v] = S1;
        } else if (e < NA_P + NB_P) {
            const int x = e - NA_P, b = x >> 14, head = (x >> 12) & 3, idx = x & 4095, k = (idx & 31) * 2, v = idx >> 5;
            const float g64 = __expf(64.0f * ret_log_gamma(head));
            float S0 = 0.f, S1 = 0.f;
            for (int c0 = 0; c0 < 128; c0 += 16) {
                unsigned t[16];
#pragma unroll
                for (int j = 0; j < 16; ++j) { const int unit = (b * 128 + c0 + j) * 4 + head; t[j] = dsb[(size_t)unit * 4096 + idx]; }
#pragma unroll
                for (int j = 0; j < 16; ++j) { const int unit = (b * 128 + c0 + j) * 4 + head; dsb[(size_t)unit * 4096 + idx] = pk2(S0, S1);
                    S0 = g64 * S0 + __uint_as_float(t[j] << 16); S1 = g64 * S1 + __uint_as_float(t[j] & 0xffff0000u); }
            }
            float* o = F.out + O_RP + ((size_t)(l * 2 + b) * 4 + head) * 8192; o[k * 128 + v] = S0; o[(k + 1) * 128 + v] = S1;
        } else if (e < NA_P + NB_P + NA_S) {
            const int x = e - NA_P - NB_P, seq = x >> 15, head = (x >> 13) & 3, idx = x & 8191, k = (idx & 63) * 2, v = idx >> 6;
            const int unit = (256 + seq) * 4 + head;
            const size_t so = ((size_t)(l * 16 + seq) * 4 + head) * 16384;
            const float a0 = A->in[2][so + k * 128 + v], a1 = A->in[2][so + (k + 1) * 128 + v]; const unsigned t = dsa[(size_t)unit * 8192 + idx];
            dsa[(size_t)unit * 8192 + idx] = pk2(a0, a1);
            F.out[O_HS + so + k * 128 + v] = dec[unit * 128 + k] * a0 + __uint_as_float(t << 16); F.out[O_HS + so + (k + 1) * 128 + v] = dec[unit * 128 + k + 1] * a1 + __uint_as_float(t & 0xffff0000u);
        } else {
            const int x = e - NA_P - NB_P - NA_S, seq = x >> 14, head = (x >> 12) & 3, idx = x & 4095, k = (idx & 31) * 2, v = idx >> 5;
            const int unit = (256 + seq) * 4 + head;
            const size_t so = ((size_t)(l * 16 + seq) * 4 + head) * 8192;
            const float a0 = A->in[3][so + k * 128 + v], a1 = A->in[3][so + (k + 1) * 128 + v]; const unsigned t = dsb[(size_t)unit * 4096 + idx];
            dsb[(size_t)unit * 4096 + idx] = pk2(a0, a1);
            const float g64 = __expf(64.0f * ret_log_gamma(head));
            F.out[O_RS + so + k * 128 + v] = g64 * a0 + __uint_as_float(t << 16); F.out[O_RS + so + (k + 1) * 128 + v] = g64 * a1 + __uint_as_float(t & 0xffff0000u);
        }
    }
}
__device__ __forceinline__ void mixer_out_rows(Frame& F, const LAS float* OT, int row0, const bf16x8 g0, const bf16x8 g1, const float* gain  , int head, int mixcol0) {
    const int t = F.tid >> 3, j = F.tid & 7;
    f32x4 o[4]; float ss = 0.f;
#pragma unroll
    for (int q = 0; q < 4; ++q) { o[q] = *(const LAS f32x4*)(OT + t * 132 + j * 16 + q * 4); ss += (o[q].x * o[q].x + o[q].y * o[q].y) + (o[q].z * o[q].z + o[q].w * o[q].w); }
    ss += __shfl_xor(ss, 1); ss += __shfl_xor(ss, 2); ss += __shfl_xor(ss, 4);
    const float rinv = 1.0f / sqrtf(ss * (1.0f / 128.0f) + EPS);
    float r[16];
#pragma unroll
    for (int q = 0; q < 4; ++q) { r[4 * q] = o[q].x; r[4 * q + 1] = o[q].y; r[4 * q + 2] = o[q].z; r[4 * q + 3] = o[q].w; }
#pragma unroll
    for (int e = 0; e < 16; ++e) { const float gt = bf2f((unsigned short)(e < 8 ? g0[e] : g1[e - 8])); const float gn = gain ? gain[j * 16 + e] : 1.0f; r[e] = r[e] * rinv * gn * silu(gt); }
    bf16* mp = (bf16*)(F.ws + WS_R1 + R1_MIX) + (size_t)(row0 + t) * DM + mixcol0 + head * 128 + j * 16;
    v4u w0, w1; w0.x = pk2(r[0], r[1]); w0.y = pk2(r[2], r[3]); w0.z = pk2(r[4], r[5]); w0.w = pk2(r[6], r[7]); w1.x = pk2(r[8], r[9]); w1.y = pk2(r[10], r[11]); w1.z = pk2(r[12], r[13]); w1.w = pk2(r[14], r[15]);
    *(GAS v4u*)mp = w0; *(GAS v4u*)(mp + 8) = w1;
}
__device__ __forceinline__ void hgrn_out_unit(Frame& F, KArgs A, int l, int chunk, int head) {
    LAS unsigned char* lds = F.lds; const int tid = F.tid, lane = F.lane, w = F.wave;
    LAS float* LG = (LAS float*)lds; LAS float* BC = (LAS float*)(lds + 32768); LAS float* SEG = (LAS float*)(lds + SEG_OFF);
    LAS unsigned char* STS = lds; LAS unsigned char* P = lds + 128 * LD128; LAS unsigned char* VT = P + 64 * LD64;
    LAS unsigned char* QT = lds + 65536; LAS unsigned char* KT = QT + 64 * LD128; LAS unsigned char* QD = KT + 64 * LD128;
    LAS float* OT = (LAS float*)(lds + 65536);
    static_assert(128 * LD128 + 64 * LD64 + 128 * LD64 <= 65536 && 64 * 132 * 4 <= 2 * 64 * LD128 && 65536 + 3 * 64 * LD128 <= SEG_OFF && SEG_OFF + 2048 <= RING_BYTES, "hgrn_out LDS map");
    const int row0 = chunk * 64, unit = chunk * 4 + head;
    const float* logf = (const float*)(F.ws + WS_R1 + R1_LOGF); const bf16* AQ = (const bf16*)(F.ws + WS_R1 + R1_AQ); const bf16* AI = (const bf16*)(F.ws + WS_R1 + R1_AI);
    const bf16* AG = (const bf16*)(F.ws + WS_R1 + R1_AG);
    f32x4 lgv[4];
#pragma unroll
    for (int q = 0; q < 4; ++q) { const int i = tid + 512 * q, t = i >> 5, c4 = i & 31; lgv[q] = *(const GAS f32x4*)(logf + (size_t)(row0 + t) * 512 + head * 128 + c4 * 4); }
    bf16x8 q8[2];
#pragma unroll
    for (int q = 0; q < 2; ++q) { const int i = tid + 512 * q, t = i >> 4, kg = i & 15; q8[q] = *(const GAS bf16x8*)(AQ + (size_t)(row0 + t) * 512 + head * 128 + kg * 8); }
    const int sp = tid >> 4, vg = tid & 15;
    const bf16x8 va = *(const GAS bf16x8*)(AI + (size_t)(row0 + 2 * sp) * 512 + head * 128 + vg * 8), vb = *(const GAS bf16x8*)(AI + (size_t)(row0 + 2 * sp + 1) * 512 + head * 128 + vg * 8);
    const bf16* gr = AG + (size_t)(row0 + (tid >> 3)) * 512 + head * 128 + (tid & 7) * 16;
    const bf16x8 g0 = *(const GAS bf16x8*)gr, g1 = *(const GAS bf16x8*)(gr + 8);
    v4u stv[4];
    { const bf16* src = (const bf16*)(F.ws + WS_DSA) + (size_t)unit * 16384;
#pragma unroll
      for (int q = 0; q < 4; ++q) { const int i = tid + 512 * q, v = i >> 4, c = i & 15; stv[q] = *(const GAS v4u*)(src + v * 128 + c * 8); } }
#pragma unroll
    for (int q = 0; q < 4; ++q) { const int i = tid + 512 * q, t = i >> 5, c4 = i & 31; *(LAS f32x4*)(LG + t * 128 + c4 * 4) = lgv[q]; }
    __syncthreads();
    chunk_cumsum(LG, BC, SEG, tid);
    __syncthreads();
#pragma unroll
    for (int q = 0; q < 2; ++q) { const int i = tid + 512 * q, t = i >> 4, kg = i & 15;
        unsigned qt[4], kt[4], qd[4]; float a[2], b[2], c[2];
#pragma unroll
        for (int e = 0; e < 8; ++e) { const int k = kg * 8 + e; const float lf = LG[t * 128 + k], bc = BC[t * 128 + k], rf = BC[31 * 128 + k], qv = bf2f((unsigned short)q8[q][e]);
            a[e & 1] = qv * __expf(fminf(bc - rf, 80.f)); b[e & 1] = (1.0f - __expf(lf)) * __expf(fminf(rf - bc, 80.f)); c[e & 1] = qv * __expf(bc);
            if (e & 1) { qt[e >> 1] = pk2(a[0], a[1]); kt[e >> 1] = pk2(b[0], b[1]); qd[e >> 1] = pk2(c[0], c[1]); } }
        *(LAS v4u*)(QT + t * LD128 + kg * 16) = (v4u){qt[0], qt[1], qt[2], qt[3]}; *(LAS v4u*)(KT + t * LD128 + kg * 16) = (v4u){kt[0], kt[1], kt[2], kt[3]}; *(LAS v4u*)(QD + t * LD128 + kg * 16) = (v4u){qd[0], qd[1], qd[2], qd[3]}; }
    __syncthreads();
#pragma unroll
    for (int q = 0; q < 4; ++q) { const int i = tid + 512 * q, v = i >> 4, c = i & 15; *(LAS v4u*)(STS + v * LD128 + c * 16) = stv[q]; }
#pragma unroll
    for (int e = 0; e < 8; ++e) *(LAS unsigned*)(VT + (vg * 8 + e) * LD64 + sp * 4) = (unsigned)(unsigned short)va[e] | ((unsigned)(unsigned short)vb[e] << 16);
    __syncthreads();
    const int r32 = lane & 31, hi = lane >> 5;
    if (w < 4) {
        const int tt = w >> 1, st = w & 1; f32x16 sc = {};
        if (!(tt == 0 && st == 1)) mma_tile<128>(sc, QT + tt * 32 * LD128, LD128, KT + st * 32 * LD128, LD128, lane);
#pragma unroll
        for (int i = 0; i < 16; ++i) { const int t = tt * 32 + crow(i, hi), s = st * 32 + r32; *(LAS unsigned short*)(P + t * LD64 + s * 2) = (unsigned short)f2bf(s <= t ? sc[i] : 0.f); }
    }
    const int tt = w >> 2, vt = w & 3; f32x16 acc = {};
    mma_tile<128>(acc, QD + tt * 32 * LD128, LD128, STS + vt * 32 * LD128, LD128, lane);
    __syncthreads();
    mma_tile<64>(acc, P + tt * 32 * LD64, LD64, VT + vt * 32 * LD64, LD64, lane);
#pragma unroll
    for (int i = 0; i < 16; ++i) OT[(tt * 32 + crow(i, hi)) * 132 + vt * 32 + r32] = acc[i];
    __syncthreads();
    mixer_out_rows(F, OT, row0, g0, g1, A->in[15] + l * 128, head, 0);
    __syncthreads();
}
__device__ __forceinline__ void ret_out_unit(Frame& F, int chunk, int head) {
    LAS unsigned char* lds = F.lds; const int tid = F.tid, lane = F.lane, w = F.wave;
    LAS unsigned char* QT = lds; LAS unsigned char* KT = QT + 64 * LD64; LAS unsigned char* VT = KT + 64 * LD64; LAS unsigned char* STS = VT + 128 * LD64; LAS unsigned char* P = STS + 128 * LD64;
    LAS float* OT = (LAS float*)(lds + 65536);
    static_assert(3 * 64 * LD64 + 2 * 128 * LD64 <= 65536, "ret_out LDS map");
    const int row0 = chunk * 64, unit = chunk * 4 + head, pos0 = chunk_pos0(chunk);
    const bf16* BQ = (const bf16*)(F.ws + WS_R1 + R1_BQ); const bf16* BK = (const bf16*)(F.ws + WS_R1 + R1_BK); const bf16* BV = (const bf16*)(F.ws + WS_R1 + R1_BV);
    const bf16* BG = (const bf16*)(F.ws + WS_R1 + R1_BG);
    const float* rot = (const float*)(F.ws + WS_ROT);
    const float lg = ret_log_gamma(head);
    const int sp = tid >> 4, vg = tid & 15;
    const bf16x8 va = *(const GAS bf16x8*)(BV + (size_t)(row0 + 2 * sp) * 512 + head * 128 + vg * 8), vb = *(const GAS bf16x8*)(BV + (size_t)(row0 + 2 * sp + 1) * 512 + head * 128 + vg * 8);
    const bf16* gr = BG + (size_t)(row0 + (tid >> 3)) * 512 + head * 128 + (tid & 7) * 16;
    const bf16x8 g0 = *(const GAS bf16x8*)gr, g1 = *(const GAS bf16x8*)(gr + 8);
    v4u stv[2];
    { const bf16* src = (const bf16*)(F.ws + WS_DSB) + (size_t)unit * 8192;
#pragma unroll
      for (int q = 0; q < 2; ++q) { const int i = tid + 512 * q, v = i >> 3, c = i & 7; stv[q] = *(const GAS v4u*)(src + v * 64 + c * 8); } }
    { const int s = tid >> 3, g = (tid >> 1) & 3, isk = tid & 1;
      const bf16* xr = (isk ? BK : BQ) + (size_t)(row0 + s) * 256 + head * 64; float o1[8], o2[8];
      rot8(*(const GAS bf16x8*)(xr + 8 * g), *(const GAS bf16x8*)(xr + 32 + 8 * g), rot + (size_t)(pos0 + s) * 64, g, isk ? 0.125f : 1.0f, o1, o2);
      LAS unsigned char* dst = (isk ? KT : QT) + s * LD64;
      *(LAS v4u*)(dst + 16 * g) = (v4u){pk2(o1[0], o1[1]), pk2(o1[2], o1[3]), pk2(o1[4], o1[5]), pk2(o1[6], o1[7])};
      *(LAS v4u*)(dst + 64 + 16 * g) = (v4u){pk2(o2[0], o2[1]), pk2(o2[2], o2[3]), pk2(o2[4], o2[5]), pk2(o2[6], o2[7])}; }
#pragma unroll
    for (int q = 0; q < 2; ++q) { const int i = tid + 512 * q, v = i >> 3, c = i & 7; *(LAS v4u*)(STS + v * LD64 + c * 16) = stv[q]; }
#pragma unroll
    for (int e = 0; e < 8; ++e) *(LAS unsigned*)(VT + (vg * 8 + e) * LD64 + sp * 4) = (unsigned)(unsigned short)va[e] | ((unsigned)(unsigned short)vb[e] << 16);
    __syncthreads();
    const int r32 = lane & 31, hi = lane >> 5;
    if (w < 4) {
        const int tt = w >> 1, st = w & 1; f32x16 sc = {};
        if (!(tt == 0 && st == 1)) mma_tile<64>(sc, QT + tt * 32 * LD64, LD64, KT + st * 32 * LD64, LD64, lane);
#pragma unroll
        for (int i = 0; i < 16; ++i) { const int t = tt * 32 + crow(i, hi), s = st * 32 + r32; *(LAS unsigned short*)(P + t * LD64 + s * 2) = (unsigned short)f2bf(s <= t ? sc[i] * __expf((float)(t - s) * lg) : 0.f); }
    }
    const int tt = w >> 2, vt = w & 3; f32x16 acc = {};
    mma_tile<64>(acc, QT + tt * 32 * LD64, LD64, STS + vt * 32 * LD64, LD64, lane);
#pragma unroll
    for (int i = 0; i < 16; ++i) acc[i] *= __expf((float)(tt * 32 + crow(i, hi) + 1) * lg);
    __syncthreads();
    mma_tile<64>(acc, P + tt * 32 * LD64, LD64, VT + vt * 32 * LD64, LD64, lane);
#pragma unroll
    for (int i = 0; i < 16; ++i) OT[(tt * 32 + crow(i, hi)) * 132 + vt * 32 + r32] = acc[i];
    __syncthreads();
    mixer_out_rows(F, OT, row0, g0, g1, nullptr, head, 512);
    __syncthreads();
}
__device__ __forceinline__ void attn_prompt_unit(Frame& F, int hd16, int qb) {
    const int b = hd16 >> 3, h = (hd16 >> 1) & 3, c = hd16 & 1, rg = F.wave & 3, vh = F.wave >> 2;
    const bf16* CQ = (const bf16*)(F.ws + WS_R1 + R1_CQ); const bf16* CK = (const bf16*)(F.ws + WS_R1 + R1_CK); const bf16* CV = (const bf16*)(F.ws + WS_R1 + R1_CV);
    const size_t rb = (size_t)b * SEQ;
    att::KVSrc src; src.k0 = CK + rb * 1024 + h * 256 + c * 128; src.v0 = CV + rb * 1024 + h * 256; src.k1 = src.k0; src.v1 = src.v0; src.nt0 = 2 * qb + 2; src.ntreal = 2 * qb + 2;
    const size_t qrow = rb + (size_t)qb * 128 + rg * 32;
    bf16* O = (bf16*)(F.ws + WS_Y) + qrow * 2048 + h * 512 + c * 256 + vh * 128;
    int nt_ = 2 * qb + 2, lim_ = 2 * qb + (rg >> 1); asm volatile("" : "+s"(nt_), "+s"(lim_));
    __syncthreads();
    att::attn_body2(CQ + qrow * 1024 + h * 256 + c * 128, src, O, nt_, lim_, (char*)F.lds);
}
__device__ __forceinline__ void attn_sample_unit(Frame& F, KArgs A, int l, int x) {
    const int seq = x >> 4, h = (x >> 2) & 3, c = (x >> 1) & 1, vh = x & 1;
    const bf16* CQ = (const bf16*)(F.ws + WS_R1 + R1_CQ);
    const float* kc = A->in[4] + ((size_t)l * 16 + seq) * PAST * 1024; const float* vc = A->in[5] + ((size_t)l * 16 + seq) * PAST * 1024;
    const float* kn = F.out + O_KS + ((size_t)l * MS + seq * 64) * 1024; const float* vn = F.out + O_VS + ((size_t)l * MS + seq * 64) * 1024;
    att::KVSrcF srcf; srcf.k0 = kc + h * 256 + c * 128; srcf.v0 = vc + h * 256 + vh * 128; srcf.k1 = kn + h * 256 + c * 128; srcf.v1 = vn + h * 256 + vh * 128; srcf.nt0 = PAST / 64; srcf.ntreal = PAST / 64 + 1;
    att::KVSrc none; none.k0 = nullptr; none.v0 = nullptr; none.k1 = nullptr; none.v1 = nullptr; none.nt0 = 0; none.ntreal = 1;
    const size_t rs = (size_t)MP + (size_t)seq * 64;
    const size_t qrow = rs + (size_t)(F.wave & 1) * 32;
    bf16* O = (bf16*)(F.ws + WS_Y) + qrow * 2048 + h * 512 + c * 256 + vh * 128;
    int nt_ = PAST / 64 + 2, lim_ = PAST / 64; asm volatile("" : "+s"(nt_), "+s"(lim_));
    __syncthreads();
    if (F.wave < 2) att::attn_body_par<0>(CQ + qrow * 1024 + h * 256 + c * 128, O, nt_, lim_, (char*)F.lds);
    else if (F.wave < 6) att::attn_stage_f32(srcf, nt_, (char*)F.lds);
    else att::attn_body_par<1>(CQ + qrow * 1024 + h * 256 + c * 128, O, nt_, lim_, (char*)F.lds);
}
__device__ __forceinline__ void phase_combine(Frame& F, KArgs A, int l) {
    const int gw = F.bid * NWAVES + F.wave, NGW = F.G * NWAVES;
    const float lam = ((const float*)(F.ws + WS_SCAL))[l];
    const float post = 1.0f - (0.8f - 0.6f * expf(-0.3f * (float)l));
    const bf16* OP = (const bf16*)(F.ws + WS_Y); bf16* MIXp = (bf16*)(F.ws + WS_R1 + R1_MIX);
    const f32x4 g = *(const GAS f32x4*)(A->in[20] + l * 256 + F.lane * 4);
    for (int it = gw; it < M * 4; it += NGW) { const int m = it >> 2, h = it & 3;
        const bf16* p = OP + (size_t)m * 2048 + h * 512 + F.lane * 4;
        const v2u ua = *(const GAS v2u*)p, ub = *(const GAS v2u*)(p + 256);
        f32x4 a, b; a.x = __uint_as_float(ua.x << 16); a.y = __uint_as_float(ua.x & 0xffff0000u); a.z = __uint_as_float(ua.y << 16); a.w = __uint_as_float(ua.y & 0xffff0000u);
        b.x = __uint_as_float(ub.x << 16); b.y = __uint_as_float(ub.x & 0xffff0000u); b.z = __uint_as_float(ub.y << 16); b.w = __uint_as_float(ub.y & 0xffff0000u);
        f32x4 d; d.x = a.x - lam * b.x; d.y = a.y - lam * b.y; d.z = a.z - lam * b.z; d.w = a.w - lam * b.w;
        const float ss = wave_sum((d.x * d.x + d.y * d.y) + (d.z * d.z + d.w * d.w));
        const float rinv = post / sqrtf(ss * (1.0f / 256.0f) + EPS);
        v2u w; w.x = pk2(d.x * rinv * g.x, d.y * rinv * g.y); w.y = pk2(d.z * rinv * g.z, d.w * rinv * g.w);
        *(GAS v2u*)(MIXp + (size_t)m * DM + 1024 + h * 256 + F.lane * 4) = w;
    }
}
#ifdef NAIVE_SAMPLE_ATTN
__device__ __forceinline__ void phase_naive_sample_attn(Frame& F, KArgs A, int l) {
    LAS float* qs = (LAS float*)(F.lds + F.wave * 16384); LAS float* sb = qs + 128;
    const bf16* CQ = (const bf16*)(F.ws + WS_R1 + R1_CQ);
    const float* kc = A->in[4] + (size_t)l * 16 * PAST * 1024; const float* vc = A->in[5] + (size_t)l * 16 * PAST * 1024;
    const float* kn = F.out + O_KS + (size_t)l * MS * 1024; const float* vn = F.out + O_VS + (size_t)l * MS * 1024;
    const int gw = F.bid * NWAVES + F.wave, NGW = F.G * NWAVES, lane = F.lane;
    for (int it = gw; it < 16 * 4 * 64 * 2; it += NGW) {
        const int c = it & 1, t = (it >> 1) & 63, h = (it >> 7) & 3, seq = it >> 9;
        const size_t row = (size_t)MP + seq * 64 + t;
        qs[lane] = bf2f(CQ[row * 1024 + h * 256 + c * 128 + lane]); qs[lane + 64] = bf2f(CQ[row * 1024 + h * 256 + c * 128 + 64 + lane]);
        LDS_WAIT();
        float mx = -1e30f;
        for (int j = lane; j < PAST + 64; j += 64) {
            const float* kr = (j < PAST) ? kc + ((size_t)seq * PAST + j) * 1024 + h * 256 + c * 128 : kn + ((size_t)seq * 64 + (j - PAST)) * 1024 + h * 256 + c * 128;
            float s = 0.f;
#ifdef NAIVE_FROM_BF16
            { const bf16* kb = (j < PAST) ? (const bf16*)(F.ws + WS_CK) + ((size_t)seq * PAST + j) * 1024 + h * 256 + c * 128 : (const bf16*)(F.ws + WS_R1 + R1_CK) + (row - t + (j - PAST)) * 1024 + h * 256 + c * 128;
              for (int d = 0; d < 128; ++d) s += bf2f(kb[d]) * qs[d]; }
#else
            for (int d = 0; d < 128; d += 4) { const f32x4 kv = *(const GAS f32x4*)(kr + d); s += kv.x * qs[d] + kv.y * qs[d + 1] + kv.z * qs[d + 2] + kv.w * qs[d + 3]; }
#endif
            s *= 0.08838834764831845f; sb[j] = s; mx = fmaxf(mx, s);
        }
#pragma unroll
        for (int o = 1; o < 64; o <<= 1) mx = fmaxf(mx, __shfl_xor(mx, o));
        float sum = 0.f;
        for (int j = lane; j < PAST + 64; j += 64) { const float p = expf(sb[j] - mx); sb[j] = p; sum += p; }
        sum = wave_sum(sum); LDS_WAIT();
        f32x4 o = {0.f, 0.f, 0.f, 0.f};
        for (int j = 0; j < PAST + 64; ++j) {
            const float* vr = (j < PAST) ? vc + ((size_t)seq * PAST + j) * 1024 + h * 256 : vn + ((size_t)seq * 64 + (j - PAST)) * 1024 + h * 256;
#ifdef NAIVE_FROM_BF16
            const bf16* vb = (j < PAST) ? (const bf16*)(F.ws + WS_CV) + ((size_t)seq * PAST + j) * 1024 + h * 256 : (const bf16*)(F.ws + WS_R1 + R1_CV) + (row - t + (j - PAST)) * 1024 + h * 256;
            const f32x4 vv = {bf2f(vb[lane * 4]), bf2f(vb[lane * 4 + 1]), bf2f(vb[lane * 4 + 2]), bf2f(vb[lane * 4 + 3])}; const float p = sb[j];
#else
            const f32x4 vv = *(const GAS f32x4*)(vr + lane * 4); const float p = sb[j];
#endif
            o.x += p * vv.x; o.y += p * vv.y; o.z += p * vv.z; o.w += p * vv.w;
        }
        const float inv = 1.0f / sum;
        *(GAS f32x4*)((float*)(F.ws + WS_Y) + row * 2048 + h * 512 + c * 256 + lane * 4) = (f32x4){o.x * inv, o.y * inv, o.z * inv, o.w * inv};
        LDS_WAIT();
    }
}
#endif
#ifdef PROBE_MASK
__global__ void probe_scale(float* out) {
    const size_t offs[11] = {O_YP, O_YS, O_HP, O_HS, O_RP, O_RS, O_KP, O_KS, O_VP, O_VS, O_END};
    for (int j = 0; j < 10; ++j) if ((PROBE_MASK >> j) & 1)
        for (size_t i = offs[j] + (size_t)blockIdx.x * blockDim.x + threadIdx.x; i < offs[j + 1]; i += (size_t)gridDim.x * blockDim.x) out[i] *= 1.0245f;
}
#endif
#ifndef REP_PRO
#define REP_PRO 1
#endif
#ifndef REP_G0
#define REP_G0 1
#endif
#ifndef REP_G5
#define REP_G5 1
#endif
#ifndef REP_G7
#define REP_G7 1
#endif
#ifndef REP_G8
#define REP_G8 1
#endif
#ifndef REP_ATT
#define REP_ATT 1
#endif
#ifndef REP_MIX
#define REP_MIX 1
#endif
#define GRID_BAR() do { if (N_LAUNCHES == 1) { XcdBarrier b_ = bar; unsigned long long bp_ = (unsigned long long)b_.bar; asm volatile("" : "+s"(bp_)); b_.bar = (unsigned*)bp_; xcd_barrier(b_); } } while (0)
#ifndef PH_MASK
#define PH_MASK 0x1fff
#endif
#define EN(j) (((PH_MASK) >> (j)) & 1)
#define IN(k) (lo <= (k) && (k) < hi)
#define PHASE_BEGIN() do { int t_ = threadIdx.x; asm volatile("" : "+v"(t_)); F.tid = t_; F.lane = t_ & 63; F.wave = __builtin_amdgcn_readfirstlane(t_ >> 6); \
        unsigned long long ka_ = (unsigned long long)__builtin_amdgcn_kernarg_segment_ptr(); asm volatile("" : "+s"(ka_)); A = (KArgs)ka_; F.ws = A->ws; F.out = A->out; } while (0)
#define BOTH(k) (IN(k) && IN((k) + 1))
#define Hb ((bf16*)(F.ws + WS_H))
#define Yb ((bf16*)(F.ws + WS_Y))
#define XBb ((bf16*)(F.ws + WS_XB))
#define Ub ((bf16*)(F.ws + WS_R1))
#define MIXb ((bf16*)(F.ws + WS_R1 + R1_MIX))

template <int l> __device__ __forceinline__ void run_layer(Frame& F, KArgs& A, const int lo, const int hi, const XcdBarrier& bar) {
        const int pb = 1 + l * PH_PER_LAYER;
        if (EN(0) && IN(pb + 0)) { PHASE_BEGIN();
            pg8::Gemm g{Hb, (const bf16*)(F.ws + WS_WIN + l * WIN_BYTES), M, NIN, DM, DM}; pg8::StaticOrder S; S.init(M, NIN, DM, F.G, F.bid);
            pg8::EpiInProj E; E.d.r1 = F.ws + WS_R1; E.d.out = F.out; E.d.lb = (const float*)(F.ws + WS_SCAL) + 16; E.d.l = l; E.d.first = (l == 0) ? 1 : 0;
            for (int rep_ = 0; rep_ < REP_G0; ++rep_) { pg8::gemm_phase<pg8::EpiInProj, pg8::StaticOrder, true, true>(F.lds + RING_OFF, g, S, E); __syncthreads(); }
            if (BOTH(pb + 0)) GRID_BAR();
        }
        if (EN(1) && IN(pb + 1)) { PHASE_BEGIN();
            for (int rep_ = 0; rep_ < REP_MIX; ++rep_)
            for (int u = F.bid; u < 2 * NCHUNK * 4; u += F.G) {
                const int r = u % (NCHUNK * 4);
                if (u < NCHUNK * 4) hgrn_state_unit(F, r >> 2, r & 3); else ret_state_unit(F, r >> 2, r & 3);
            }
            if (BOTH(pb + 1)) GRID_BAR();
        }
        if (EN(2) && IN(pb + 2)) { PHASE_BEGIN(); phase_scan(F, A, l); if (BOTH(pb + 2)) GRID_BAR(); }
        if (EN(3) && IN(pb + 3)) { PHASE_BEGIN();
            for (int rep_ = 0; rep_ < REP_MIX; ++rep_)
            if (EN(11)) for (int u = F.bid; u < 2 * NCHUNK * 4; u += F.G) {
                const int r = u % (NCHUNK * 4);
                if (u < NCHUNK * 4) hgrn_out_unit(F, A, l, r >> 2, r & 3); else ret_out_unit(F, r >> 2, r & 3);
            }
            const int vcu_ = (F.G % 8 == 0) ? (F.bid % 8) * (F.G / 8) + F.bid / 8 : F.bid;
            for (int rep_ = 0; rep_ < REP_ATT; ++rep_)
            if (EN(12)) {
                const int nit = 512 + 256; int nmine = 0; for (int it = vcu_; it < nit; it += F.G) ++nmine;
                if (F.G == 256) {
                    const int pos = (vcu_ >> 2) % 5;
                    for (int q = 0; q < 5; ++q) {
                        if (q == pos) { attn_sample_unit(F, A, l, vcu_); continue; }
                        const int pu = q < pos ? q : q - 1, it = vcu_ + (pu >> 1) * 256, hd16 = it >> 5, pr = it & 31;
                        attn_prompt_unit(F, hd16, (pu & 1) ? pr : 63 - pr);
                    }
                } else {
                const int rot = (nmine > 0) ? ((vcu_ >> 2) % 3) % nmine : 0;
                for (int q = 0; q < nmine; ++q) {
                    int e = q; if (nmine > 1) { if (q == rot) e = nmine - 1; else if (q > rot) e = q - 1; }
                    const int it = vcu_ + e * F.G;
                    if (it < 512) { const int hd16 = it >> 5, pr = it & 31; attn_prompt_unit(F, hd16, 63 - pr); attn_prompt_unit(F, hd16, pr); }
#ifndef NAIVE_SAMPLE_ATTN
                    else attn_sample_unit(F, A, l, it - 512);
#endif
                }
                }
            }
            if (BOTH(pb + 3)) GRID_BAR();
        }
        if (EN(4) && IN(pb + 4)) { PHASE_BEGIN(); for (int rep_ = 0; rep_ < REP_PRO; ++rep_) phase_combine(F, A, l); if (BOTH(pb + 4)) GRID_BAR(); }
        if (EN(5) && IN(pb + 5)) { PHASE_BEGIN();
            pg8::Gemm g{MIXb, (const bf16*)(F.ws + WS_WOUT + l * WOUT_BYTES), M, DM, DM, DM}; pg8::SplitOrder S; S.init(DM, DM, F.G, F.bid);
            pg8::EpiBf16Split E{Yb, (bf16*)(F.ws + WS_DSA), DM};
            for (int rep_ = 0; rep_ < REP_G5; ++rep_) { pg8::gemm_phase<pg8::EpiBf16Split, pg8::SplitOrder, true, true>(F.lds + RING_OFF, g, S, E); __syncthreads(); }
            if (BOTH(pb + 5)) GRID_BAR();
        }
        if (EN(6) && IN(pb + 6)) { PHASE_BEGIN();
            const int gw = F.bid * NWAVES + F.wave, NGW = F.G * NWAVES;
            f32x4 G1[8], G2[8]; load_gain(A->in[11] + l * DM, F.lane, G1); load_gain(A->in[12] + l * DM, F.lane, G2);
            for (int m = gw; m < M; m += NGW) {
                const bool sp = m >= MP;
                resid_norm_row(sp ? (const bf16*)(F.ws + WS_DSA) + (size_t)(m - MP) * DM : Yb + (size_t)m * DM, sp ? pg8::SplitOrder::KS : 1, (size_t)MS * DM,
                               (l == 0) ? xrow_in(A, m) : nullptr, XBb + (size_t)m * DM, G1, nullptr, XBb + (size_t)m * DM, true, G2, Hb + (size_t)m * DM, F.lane);
            }
            if (BOTH(pb + 6)) GRID_BAR();
        }
        if (EN(7) && IN(pb + 7)) { PHASE_BEGIN();
            pg8::Gemm g{Hb, (const bf16*)(F.ws + WS_WUP + l * WUP_BYTES), M, DFF, DM, DM}; pg8::StaticOrder S; S.init(M, DFF, DM, F.G, F.bid);
            pg8::EpiRelu2 E{Ub, LDU};
#ifdef STAG_UP
            if ((F.bid >> 3) & 1) { const unsigned long long t0_ = __builtin_amdgcn_s_memrealtime(); while (__builtin_amdgcn_s_memrealtime() - t0_ < (unsigned long long)(STAG_UP * 100)) __builtin_amdgcn_s_sleep(8); }
#endif
            for (int rep_ = 0; rep_ < REP_G7; ++rep_) { pg8::gemm_phase<pg8::EpiRelu2, pg8::StaticOrder, true, true>(F.lds + RING_OFF, g, S, E); __syncthreads(); }
            convert_wdn(F, A, l);
            if (BOTH(pb + 7)) GRID_BAR();
        }
        if (EN(8) && IN(pb + 8)) { PHASE_BEGIN();
            pg8::Gemm g{Ub, (const bf16*)(F.ws + WS_WDN + l * WDN_BYTES), M, DM, DFF, LDU}; pg8::SplitOrder S; S.init(DM, DFF, F.G, F.bid);
            pg8::EpiBf16Split E{Yb, (bf16*)(F.ws + WS_DSA), DM};
            for (int rep_ = 0; rep_ < REP_G8; ++rep_) { pg8::gemm_phase<pg8::EpiBf16Split, pg8::SplitOrder, true, true>(F.lds + RING_OFF, g, S, E); __syncthreads(); }
            if (BOTH(pb + 8)) GRID_BAR();
        }
        if (EN(9) && IN(pb + 9)) { PHASE_BEGIN();
            const bool last = (l == DEPTH - 1); const int gw = F.bid * NWAVES + F.wave, NGW = F.G * NWAVES;
            f32x4 G1[8], G2[8]; load_gain(A->in[13] + l * DM, F.lane, G1); load_gain(A->in[10] + (last ? l : l + 1) * DM, F.lane, G2);
            for (int m = gw; m < M; m += NGW) {
                const bool sp = m >= MP;
                resid_norm_row(sp ? (const bf16*)(F.ws + WS_DSA) + (size_t)(m - MP) * DM : Yb + (size_t)m * DM, sp ? pg8::SplitOrder::KS : 1, (size_t)MS * DM,
                               nullptr, XBb + (size_t)m * DM, G1, last ? F.out + (size_t)m * DM : nullptr, XBb + (size_t)m * DM, !last, G2, Hb + (size_t)m * DM, F.lane);
            }
            if (BOTH(pb + 9)) GRID_BAR();
        }

}
__global__ void __launch_bounds__(NWAVES * 64, 2) mk_fwd(Args args_) {
    extern __shared__ __attribute__((aligned(16))) unsigned char lds[];
    Frame F;
    F.lds = (LAS unsigned char*)lds;
    F.MISC = (volatile LAS unsigned*)(F.lds + MISC_OFF);
    F.tid = threadIdx.x; F.lane = F.tid & 63; F.wave = __builtin_amdgcn_readfirstlane(F.tid >> 6);
    F.G = gridDim.x; F.bid = blockIdx.x;
    KArgs A = (KArgs)__builtin_amdgcn_kernarg_segment_ptr();
    F.ws = A->ws; F.out = A->out; F.ctl = (gu32*)(A->ws + WS_CTL);
    for (int u = F.tid; u < (LDS_BYTES - LDSCTL_OFF) / 4; u += NWAVES * 64) ((LAS unsigned*)(F.lds + LDSCTL_OFF))[u] = 0u;
    __syncthreads();
    XcdBarrier bar; bar.bar = (unsigned*)(F.ctl + CW_BAR); bar.x = 0; bar.st = nullptr;
    if (N_LAUNCHES == 1) bar = xcd_barrier_post((unsigned*)(F.ctl + CW_BAR), F.MISC + 8);
    const int lo = A->ph_lo, hi = A->ph_hi;
    if (EN(10) && IN(0)) { PHASE_BEGIN(); for (int rep_ = 0; rep_ < REP_PRO; ++rep_) { phase_prologue(F, A); __syncthreads(); } if (BOTH(0)) GRID_BAR(); }

#ifdef REP_BAR
    for (int rep_ = 0; rep_ < REP_BAR; ++rep_) GRID_BAR();
#endif
    run_layer<0>(F, A, lo, hi, bar);
    run_layer<1>(F, A, lo, hi, bar);
#undef IN
#undef BOTH
#undef GRID_BAR
}

extern "C" void kernel_launch(void* const* d_in, const int* in_sizes, int n_in, void* d_out, int out_size, void* d_ws, size_t ws_size, hipStream_t stream) {
    static int grid = 0;
    if (grid == 0) {
        if (n_in != 21 || (size_t)out_size != O_END || ws_size < WS_END) { fprintf(stderr, "kernel_launch: shape mismatch: n_in %d out %d ws %zu (need %zu)\n", n_in, out_size, ws_size, (size_t)WS_END); grid = -1; return; }
        int dev = 0, cus = 0, per_cu = 0;
        if (hipGetDevice(&dev) != hipSuccess || hipDeviceGetAttribute(&cus, hipDeviceAttributeMultiprocessorCount, dev) != hipSuccess) { grid = -1; return; }
        if (hipFuncSetAttribute((const void*)mk_fwd, hipFuncAttributeMaxDynamicSharedMemorySize, LDS_BYTES) != hipSuccess) { fprintf(stderr, "kernel_launch: hipFuncSetAttribute failed\n"); grid = -1; return; }
        if (hipOccupancyMaxActiveBlocksPerMultiprocessor(&per_cu, (const void*)mk_fwd, NWAVES * 64, LDS_BYTES) != hipSuccess || per_cu < 1)
            fprintf(stderr, "kernel_launch: note: occupancy query reports %d workgroups per CU\n", per_cu);
        (void)hipGetLastError();
        grid = cus;
    }
    if (grid < 0) return;
    if (hipMemsetAsync((char*)d_ws + WS_CTL, 0, CTL_ZERO_BYTES, stream) != hipSuccess) return;
    Args a{};
    for (int i = 0; i < 21; ++i) a.in[i] = (const float*)d_in[i];
    a.out = (float*)d_out; a.ws = (unsigned char*)d_ws; a.pad = 0;
    for (int li = 0; li < N_LAUNCHES; ++li) {
        a.ph_lo = (N_LAUNCHES == 1) ? 0 : li; a.ph_hi = (N_LAUNCHES == 1) ? NPHASE : li + 1; a.li = li;
        hipLaunchKernelGGL(mk_fwd, dim3(grid), dim3(NWAVES * 64), LDS_BYTES, stream, a);
        const hipError_t le = hipPeekAtLastError();
        if (le != hipSuccess) { fprintf(stderr, "kernel_launch: launch %d failed: %s\n", li, hipGetErrorName(le)); break; }
    }
#ifdef PROBE_MASK
    hipLaunchKernelGGL(probe_scale, dim3(1024), dim3(256), 0, stream, (float*)d_out);
#endif
}
```

```cpp
#define SPLIT_ROWMAJOR 1
#include <hip/hip_runtime.h>
#include <cstdio>
#include <cstdint>
constexpr int NWAVES = 8;
#ifndef MK_N_LAUNCHES
#define MK_N_LAUNCHES 1
#endif
constexpr int DM = 2048, MP = 16384, MS = 1024, M = MP + MS, NIN = 6656, DFF = 8192, DEPTH = 2, SEQ = 8192, PAST = 2048;
constexpr int LDU = DFF + 64;
constexpr int NCHUNK = M / 64;
constexpr float EPS = 1e-6f;
constexpr int PH_PER_LAYER = 10, NPHASE = 1 + DEPTH * PH_PER_LAYER;
constexpr int N_LAUNCHES = (MK_N_LAUNCHES == 1) ? 1 : NPHASE;
constexpr size_t O_YP = 0, O_YS = O_YP + (size_t)MP * DM, O_HP = O_YS + (size_t)MS * DM, O_HS = O_HP + (size_t)DEPTH * 2 * 4 * 128 * 128,
                 O_RP = O_HS + (size_t)DEPTH * 16 * 4 * 128 * 128, O_RS = O_RP + (size_t)DEPTH * 2 * 4 * 64 * 128, O_KP = O_RS + (size_t)DEPTH * 16 * 4 * 64 * 128,
                 O_KS = O_KP + (size_t)DEPTH * MP * 1024, O_VP = O_KS + (size_t)DEPTH * MS * 1024, O_VS = O_VP + (size_t)DEPTH * MP * 1024, O_END = O_VS + (size_t)DEPTH * MS * 1024;
constexpr size_t MiB = 1u << 20;
constexpr size_t WS_CTL = 0, CTL_ZERO_BYTES = 1 * MiB;
constexpr size_t WS_SCAL = 1 * MiB;
constexpr size_t WS_ROT = 2 * MiB;
constexpr size_t WS_WIN = 4 * MiB, WIN_BYTES = (size_t)NIN * DM * 2;
constexpr size_t WS_WOUT = WS_WIN + 2 * WIN_BYTES, WOUT_BYTES = (size_t)DM * DM * 2;
constexpr size_t WS_WUP = WS_WOUT + 2 * WOUT_BYTES, WUP_BYTES = (size_t)DFF * DM * 2;
constexpr size_t WS_WDN = WS_WUP + 2 * WUP_BYTES, WDN_BYTES = (size_t)DM * LDU * 2 + 65536 - ((size_t)DM * LDU * 2) % 65536;
constexpr size_t WS_H = WS_WDN + 2 * WDN_BYTES;
constexpr size_t WS_R1 = WS_H + (size_t)M * DM * 2;
constexpr size_t R1_AQ = 0, R1_LOGF = R1_AQ + (size_t)M * 512 * 2, R1_AI = R1_LOGF + (size_t)M * 512 * 4, R1_AG = R1_AI + (size_t)M * 512 * 2,
                 R1_BQ = R1_AG + (size_t)M * 512 * 2, R1_BK = R1_BQ + (size_t)M * 256 * 2, R1_BV = R1_BK + (size_t)M * 256 * 2, R1_BG = R1_BV + (size_t)M * 512 * 2,
                 R1_CQ = R1_BG + (size_t)M * 512 * 2, R1_CK = R1_CQ + (size_t)M * 1024 * 2, R1_CV = R1_CK + (size_t)M * 1024 * 2, R1_MIX = R1_CV + (size_t)M * 1024 * 2,
                 R1_END = R1_MIX + (size_t)M * DM * 2;
static_assert((size_t)M * LDU * 2 <= R1_END, "U overlays R1");
constexpr size_t WS_Y = WS_R1 + R1_END;
constexpr size_t WS_DSA = WS_Y + (size_t)M * DM * 4;
constexpr size_t WS_DSB = WS_DSA + (size_t)NCHUNK * 4 * 16384 * 4;
constexpr size_t WS_DEC = WS_DSB + (size_t)NCHUNK * 4 * 8192 * 4;
constexpr size_t WS_CK = WS_DEC + 1 * MiB;
constexpr size_t WS_CV = WS_CK + (size_t)16 * PAST * 1024 * 2;
constexpr size_t WS_XB = WS_CV + (size_t)16 * PAST * 1024 * 2;
constexpr size_t WS_END = WS_XB + (size_t)M * DM * 2;
static_assert((size_t)NCHUNK * 4 * 128 * 4 <= 1 * MiB, "decay table");
constexpr int CW_TMO = 0, CW_BAR = 4096;

namespace pg8 {
#define PG8_LAS __attribute__((address_space(3)))
typedef unsigned short bf16_t;
typedef short bf16x8 __attribute__((ext_vector_type(8)));
typedef float f32x4 __attribute__((ext_vector_type(4)));
typedef unsigned u32x4 __attribute__((ext_vector_type(4)));
constexpr int BM = 256, BK = 64, HALF = 128, HTB = HALF * BK * 2  , STAGE_BYTES = 8 * HTB, NXCD = 8, WGM = 4;

__host__ __device__ __forceinline__ int lds_byte(int r, int c) { const int st = (r >> 4) * 2 + (c >> 5), rr = r & 15, cc = c & 31, ob = rr * 64 + cc * 2; return st * 1024 + (ob ^ (((ob >> 9) & 1) << 5)); }
__host__ __device__ __forceinline__ void stage_rc(int b, int& R, int& C) { const int st = b / 1024, sb = b % 1024, swz = sb ^ (((sb >> 9) & 1) << 5); R = (st >> 1) * 16 + swz / 64; C = (st & 1) * 32 + (swz % 64) / 2; }
__host__ __device__ __forceinline__ int perm32(int rho) { const int n = rho >> 4, i = rho & 15; return 8 * (i >> 2) + 4 * n + (i & 3); }

struct Unit { int pm, pn, kb, nt, ks; };
struct Gemm { const bf16_t* A; const bf16_t* Bt; int M, N, K, ld; };

struct StaticOrder {
    int nM, nN, nwg, G, c, ntk;
    __host__ __device__ void init(int M, int N, int K, int G_, int c_) { nM = M / BM; nN = N / BM; nwg = nM * nN; G = G_; c = c_; ntk = K / BK; }
    __host__ __device__ bool next(int i, Unit& u) const {
        const long L = (long)i * G + c; if (L >= nwg) return false;
        int wgid = (int)L; { const int q = nwg / NXCD, r = nwg % NXCD, xcd = wgid % NXCD, off = wgid / NXCD; wgid = (xcd < r ? xcd * (q + 1) : r * (q + 1) + (xcd - r) * q) + off; }
        const int nig = WGM * nN, gid = wgid / nig, fm = gid * WGM, gsz = (nM - fm) < WGM ? (nM - fm) : WGM;
        u.pm = fm + ((wgid % nig) % gsz); u.pn = (wgid % nig) / gsz; u.kb = 0; u.nt = ntk; u.ks = 0; return true;
    }
    __device__ __forceinline__ void a_ready(const Unit&) const {}
    __device__ __forceinline__ void done(const Unit&) const {}
};
struct SplitOrder {
    static constexpr int KS = 8, PM0 = 64, NPM = 4;
    StaticOrder P; int K, rev;
    __host__ __device__ void init(int N, int K_, int G_, int c_, int rev_ = 0) { P.init(PM0 * BM, N, K_, G_, c_); K = K_; rev = rev_; }
    __host__ __device__ bool next(int i, Unit& u) const {
        const int nsplit = NPM * P.nN * KS;
        long L = (long)i * P.G + P.c;
        if (L >= P.nwg + nsplit) return false;
        if (rev && L < P.nwg) L = (long)(P.nwg - 1) - L;
        const bool full = L < P.nwg;
        int wgid = full ? (int)L : 0; { const int q = P.nwg / NXCD, r = P.nwg % NXCD, xcd = wgid % NXCD, off = wgid / NXCD; wgid = (xcd < r ? xcd * (q + 1) : r * (q + 1) + (xcd - r) * q) + off; }
        const int nig = WGM * P.nN, gid = wgid / nig, fm = gid * WGM, gsz = (P.nM - fm) < WGM ? (P.nM - fm) : WGM;
#ifdef SPLIT_ROWMAJOR
        const int fpm = fm + (wgid % nig) / P.nN, fpn = (wgid % nig) % P.nN;
#else
        const int fpm = fm + ((wgid % nig) % gsz), fpn = (wgid % nig) / gsz;
#endif
        const int s = full ? 0 : (int)(L - P.nwg), r2 = s % (P.nN * KS);
        u.pm = full ? fpm : PM0 + s / (P.nN * KS);
        u.pn = full ? fpn : r2 / KS;
        u.ks = full ? 0 : r2 % KS;
        u.nt = full ? P.ntk : P.ntk / KS;
        u.kb = full ? 0 : (r2 % KS) * (K / KS) * 2;
        return true;
    }
    __device__ __forceinline__ void a_ready(const Unit&) const {}
    __device__ __forceinline__ void done(const Unit&) const {}
};


__device__ __forceinline__ unsigned cvt_pk_bf16(float lo, float hi) { unsigned r; asm volatile("v_cvt_pk_bf16_f32 %0, %1, %2" : "=v"(r) : "v"(lo), "v"(hi)); return r; }
typedef float f32x2 __attribute__((ext_vector_type(2)));
constexpr int EP_MP = 16384;
struct InProjDst { unsigned char* r1; float* out; const float* lb; int l, first; };
__device__ __forceinline__ float silu_f(float x) { return x / (1.0f + __expf(-x)); }
__device__ __forceinline__ float hgrn_logf(float z, float lb, int first) {
    const float e = __expf(-fabsf(z)), ope = 1.0f + e;
    if (first) return fminf(z, 0.f) - __logf(ope);
    const float sig = (z >= 0.f ? 1.0f : e) / ope;
    return __logf(lb + (1.0f - lb) * sig);
}
struct EpiInProj {
    static constexpr bool PERM = true, AFTER_DRAIN = false;
    InProjDst d;
    __device__ __forceinline__ void operator()(const f32x4 (&acc)[2][2][4][2], const Unit& u, int wr, int wc, int fr, int fq) const {
        const int pn = u.pn, row0 = u.pm * BM + wr * 64 + fr, cw = wc * 32 + 8 * fq;
        bf16_t* dst = nullptr; float* fdst = nullptr; int ld = 512, c0 = 0, mode = 0;
        const bool samp = u.pm >= (EP_MP / BM);
        unsigned char* r1 = d.r1;
        if (pn < 2)        { dst = (bf16_t*)(r1 + R1_AQ); ld = 512;  c0 = pn * 256;        mode = 1; }
        else if (pn < 4)   {                               ld = 512;  c0 = (pn - 2) * 256;  mode = 2; }
        else if (pn < 6)   { dst = (bf16_t*)(r1 + R1_AI); ld = 512;  c0 = (pn - 4) * 256; }
        else if (pn < 8)   { dst = (bf16_t*)(r1 + R1_AG); ld = 512;  c0 = (pn - 6) * 256; }
        else if (pn == 8)  { dst = (bf16_t*)(r1 + R1_BQ); ld = 256;  c0 = 0; }
        else if (pn == 9)  { dst = (bf16_t*)(r1 + R1_BK); ld = 256;  c0 = 0; }
        else if (pn < 12)  { dst = (bf16_t*)(r1 + R1_BV); ld = 512;  c0 = (pn - 10) * 256; }
        else if (pn < 14)  { dst = (bf16_t*)(r1 + R1_BG); ld = 512;  c0 = (pn - 12) * 256; }
        else if (pn < 18)  { dst = (bf16_t*)(r1 + R1_CQ); ld = 1024; c0 = (pn - 14) * 256; }
        else if (pn < 22)  { dst = (bf16_t*)(r1 + R1_CK); ld = 1024; c0 = (pn - 18) * 256; mode = 3; fdst = d.out + (samp ? O_KS + (size_t)d.l * MS * 1024 : O_KP + (size_t)d.l * MP * 1024); }
        else               { dst = (bf16_t*)(r1 + R1_CV); ld = 1024; c0 = (pn - 22) * 256; mode = 3; fdst = d.out + (samp ? O_VS + (size_t)d.l * MS * 1024 : O_VP + (size_t)d.l * MP * 1024); }
        const int rsub = samp ? EP_MP : 0;
#pragma unroll
        for (int ai = 0; ai < 2; ++ai)
#pragma unroll
            for (int m = 0; m < 4; ++m) {
                const int row = row0 + ai * HALF + m * 16;
#pragma unroll
                for (int bj = 0; bj < 2; ++bj) {
                    const int col = c0 + cw + bj * HALF;
                    f32x4 v0 = acc[ai][bj][m][0], v1 = acc[ai][bj][m][1];
                    if (mode == 2) {
                        f32x4 l0 = {0.f, 0.f, 0.f, 0.f}, l1 = {0.f, 0.f, 0.f, 0.f};
                        if (!d.first) { l0 = *(const f32x4*)(d.lb + col); l1 = *(const f32x4*)(d.lb + col + 4); }
                        f32x4 o0, o1;
#pragma unroll
                        for (int e = 0; e < 4; ++e) { o0[e] = hgrn_logf(v0[e], l0[e], d.first); o1[e] = hgrn_logf(v1[e], l1[e], d.first); }
                        float* p = (float*)(r1 + R1_LOGF) + (size_t)row * 512 + col;
                        *(f32x4*)p = o0; *(f32x4*)(p + 4) = o1;
                    } else {
                        if (mode == 1) {
                            const float sc = 0.08838834764831845f;
#pragma unroll
                            for (int e = 0; e < 4; ++e) { v0[e] = silu_f(v0[e]) * sc; v1[e] = silu_f(v1[e]) * sc; }
                        }
                        if (mode == 3) { float* p = fdst + (size_t)(row - rsub) * 1024 + col; *(f32x4*)p = v0; *(f32x4*)(p + 4) = v1; }
                        u32x4 w; w.x = cvt_pk_bf16(v0[0], v0[1]); w.y = cvt_pk_bf16(v0[2], v0[3]); w.z = cvt_pk_bf16(v1[0], v1[1]); w.w = cvt_pk_bf16(v1[2], v1[3]);
                        *(u32x4*)(dst + (size_t)row * ld + col) = w;
                    }
                }
            }
    }
};
struct EpiF32 {
    static constexpr bool PERM = false, AFTER_DRAIN = false;
    float* O; int ldc;
    __device__ __forceinline__ void operator()(const f32x4 (&acc)[2][2][4][2], const Unit& u, int wr, int wc, int fr, int fq) const {
        const int row0 = u.pm * BM + wr * 64 + fr, col0 = u.pn * BM + wc * 32 + 4 * fq;
#pragma unroll
        for (int ai = 0; ai < 2; ++ai)
#pragma unroll
            for (int m = 0; m < 4; ++m) { float* rowp = O + (size_t)(row0 + ai * HALF + m * 16) * ldc + col0;
#pragma unroll
                for (int bj = 0; bj < 2; ++bj)
#pragma unroll
                    for (int n = 0; n < 2; ++n) *(f32x4*)(rowp + bj * HALF + n * 16) = acc[ai][bj][m][n]; }
    }
};
struct EpiRelu2 {
    static constexpr bool PERM = true, AFTER_DRAIN = false;
    bf16_t* O; int ldc;
    __device__ __forceinline__ void operator()(const f32x4 (&acc)[2][2][4][2], const Unit& u, int wr, int wc, int fr, int fq) const {
        const int row0 = u.pm * BM + wr * 64 + fr, col0 = u.pn * BM + wc * 32 + 8 * fq;
#pragma unroll
        for (int ai = 0; ai < 2; ++ai)
#pragma unroll
            for (int m = 0; m < 4; ++m) { bf16_t* rowp = O + (size_t)(row0 + ai * HALF + m * 16) * ldc + col0;
#pragma unroll
                for (int bj = 0; bj < 2; ++bj) { f32x4 v0 = acc[ai][bj][m][0], v1 = acc[ai][bj][m][1];
#pragma unroll
                    for (int e = 0; e < 4; ++e) { const float a = fmaxf(v0[e], 0.f), b = fmaxf(v1[e], 0.f); v0[e] = a * a; v1[e] = b * b; }
                    u32x4 w; w.x = cvt_pk_bf16(v0[0], v0[1]); w.y = cvt_pk_bf16(v0[2], v0[3]); w.z = cvt_pk_bf16(v1[0], v1[1]); w.w = cvt_pk_bf16(v1[2], v1[3]);
#ifdef NT_STORE
                    __builtin_nontemporal_store(w, (u32x4*)(rowp + bj * HALF)); } }
#else
                    *(u32x4*)(rowp + bj * HALF) = w; } }
#endif
    }
};
struct EpiBf16Split {
    static constexpr bool PERM = true, AFTER_DRAIN = false;
    bf16_t* O; bf16_t* part; int ldc;
    __device__ __forceinline__ void operator()(const f32x4 (&acc)[2][2][4][2], const Unit& u, int wr, int wc, int fr, int fq) const {
        const int row0 = u.pm * BM + wr * 64 + fr, col0 = u.pn * BM + wc * 32 + 8 * fq;
        bf16_t* base = (u.pm >= EP_MP / BM) ? part + ((size_t)u.ks * 1024 - EP_MP) * ldc : O;
#pragma unroll
        for (int ai = 0; ai < 2; ++ai)
#pragma unroll
            for (int m = 0; m < 4; ++m) { bf16_t* rowp = base + (size_t)(row0 + ai * HALF + m * 16) * ldc + col0;
#pragma unroll
                for (int bj = 0; bj < 2; ++bj) { const f32x4 v0 = acc[ai][bj][m][0], v1 = acc[ai][bj][m][1];
                    u32x4 w; w.x = cvt_pk_bf16(v0[0], v0[1]); w.y = cvt_pk_bf16(v0[2], v0[3]); w.z = cvt_pk_bf16(v1[0], v1[1]); w.w = cvt_pk_bf16(v1[2], v1[3]);
                    *(u32x4*)(rowp + bj * HALF) = w; } }
    }
};
template <class Epi, class Sched, bool ALIGN_EPI = false, bool SP2 = false>
__device__ __forceinline__ void gemm_phase(PG8_LAS unsigned char* lds, const Gemm g, const Sched& S, const Epi& E) {
    int tid_ = threadIdx.x; asm volatile("" : "+v"(tid_));
    const int tid = tid_, wid = __builtin_amdgcn_readfirstlane(tid >> 6), lane = tid & 63, wr = wid >> 2, wc = wid & 3, fr = lane & 15, fq = lane >> 4;
    const int LD = g.ld;
    unsigned voffA[2], voffB[2];
#pragma unroll
    for (int i = 0; i < 2; ++i) { int R, C; stage_rc(tid * 16 + i * 8192, R, C); const int Rb = Epi::PERM ? ((R & ~31) + perm32(R & 31)) : R;
        voffA[i] = (unsigned)(R * LD + C) * 2u; voffB[i] = (unsigned)(Rb * LD + C) * 2u; }
    const size_t kstep = (size_t)(BK * 2);
    const size_t hstep = (size_t)HALF * LD * 2;
    const size_t tstep = 2 * hstep;
    const unsigned ldsw = (unsigned)wid * 1024u;
    const int aoff = lds_byte(wr * 64 + fr, fq * 8), boff = lds_byte(wc * 32 + fr, fq * 8);
#define PG8_SA(b, h) (((b) * 2 + (h)) * HTB)
#define PG8_SB(b, h) ((4 + (b) * 2 + (h)) * HTB)
#define PG8_STAGE(bufoff, gbase, voff) do { _Pragma("unroll") for (int _i = 0; _i < 2; ++_i) \
        __builtin_amdgcn_global_load_lds((const unsigned*)((const char*)(gbase) + (voff)[_i]), (PG8_LAS unsigned*)(lds + (bufoff) + ldsw + _i * 8192), 16, 0, 0); } while (0)
#define PG8_LDA(dst, b, h) do { _Pragma("unroll") for (int m = 0; m < 4; ++m) _Pragma("unroll") for (int k = 0; k < 2; ++k) dst[m][k] = *(const PG8_LAS bf16x8*)(lds + PG8_SA(b, h) + aoff + m * 2048 + k * 1024); } while (0)
#define PG8_LDB(dst, b, h) do { _Pragma("unroll") for (int n = 0; n < 2; ++n) _Pragma("unroll") for (int k = 0; k < 2; ++k) dst[n][k] = *(const PG8_LAS bf16x8*)(lds + PG8_SB(b, h) + boff + n * 2048 + k * 1024); } while (0)
#define PG8_MMA(ai, bj, At, Bt) do { __builtin_amdgcn_s_setprio(1); _Pragma("unroll") for (int m = 0; m < 4; ++m) _Pragma("unroll") for (int n = 0; n < 2; ++n) _Pragma("unroll") for (int k = 0; k < 2; ++k) \
        acc[ai][bj][m][n] = __builtin_amdgcn_mfma_f32_16x16x32_bf16(Bt[n][k], At[m][k], acc[ai][bj][m][n], 0, 0, 0); __builtin_amdgcn_s_setprio(0); } while (0)
#define PG8_WAIT_V(n) asm volatile("s_waitcnt vmcnt(" #n ")" ::: "memory")
#define PG8_WAIT_L(n) asm volatile("s_waitcnt lgkmcnt(" #n ")" ::: "memory")
#define PG8_BAR __builtin_amdgcn_s_barrier()
#define PG8_SCHED __builtin_amdgcn_sched_barrier(0)
    Unit cur, nxt; int ui = 0;
    if (!S.next(0, cur)) return;
    f32x4 acc[2][2][4][2];
#pragma unroll
    for (int a = 0; a < 2; ++a)
#pragma unroll
        for (int b = 0; b < 2; ++b)
#pragma unroll
            for (int m = 0; m < 4; ++m)
#pragma unroll
                for (int n = 0; n < 2; ++n) acc[a][b][m][n] = (f32x4){0.f, 0.f, 0.f, 0.f};
    bf16x8 At[4][2], B0[2][2], B1[2][2];
    const char* cA = (const char*)g.A + (size_t)cur.pm * tstep + cur.kb; const char* cB = (const char*)g.Bt + (size_t)cur.pn * tstep + cur.kb;
    S.a_ready(cur);
    if constexpr (SP2) {
        PG8_STAGE(PG8_SB(0, 0), cB, voffB); PG8_STAGE(PG8_SB(0, 1), cB + hstep, voffB); PG8_STAGE(PG8_SA(0, 0), cA, voffA); PG8_STAGE(PG8_SA(0, 1), cA + hstep, voffA);
        if (wr == 1) PG8_BAR;
        PG8_WAIT_V(2); PG8_BAR;
        PG8_STAGE(PG8_SB(1, 0), cB + kstep, voffB); PG8_STAGE(PG8_SA(1, 0), cA + kstep, voffA); PG8_STAGE(PG8_SB(1, 1), cB + hstep + kstep, voffB);
        PG8_WAIT_V(6); PG8_BAR;
    } else {
        PG8_STAGE(PG8_SB(0, 0), cB, voffB); PG8_STAGE(PG8_SA(0, 0), cA, voffA); PG8_STAGE(PG8_SB(0, 1), cB + hstep, voffB); PG8_STAGE(PG8_SA(0, 1), cA + hstep, voffA);
        if (wr == 1) PG8_BAR;
        PG8_WAIT_V(4); PG8_BAR;
        PG8_STAGE(PG8_SB(1, 0), cB + kstep, voffB); PG8_STAGE(PG8_SA(1, 0), cA + kstep, voffA); PG8_STAGE(PG8_SB(1, 1), cB + hstep + kstep, voffB);
        PG8_WAIT_V(6); PG8_BAR;
    }
    for (;;) {
        const bool has_next = S.next(ui + 1, nxt);
        const char* nA = has_next ? (const char*)g.A + (size_t)nxt.pm * tstep + nxt.kb : cA; const char* nB = has_next ? (const char*)g.Bt + (size_t)nxt.pn * tstep + nxt.kb : cB;
        const int nt = cur.nt;
        for (int t = 0; t < nt; t += 2) {
            const bool last = (t == nt - 2);
            const char* a1 = cA + (size_t)(t + 1) * kstep;
            const char* a2 = last ? nA : cA + (size_t)(t + 2) * kstep; const char* b2 = last ? nB : cB + (size_t)(t + 2) * kstep;
            const char* a3 = a2 + kstep; const char* b3 = b2 + kstep;
            if (last && has_next) S.a_ready(nxt);
            if constexpr (SP2) {
            PG8_LDB(B0, 0, 0); PG8_LDB(B1, 0, 1); PG8_SCHED; PG8_LDA(At, 0, 0); PG8_STAGE(PG8_SA(1, 1), a1 + hstep, voffA);
            PG8_WAIT_V(8); PG8_WAIT_L(0); PG8_BAR; PG8_MMA(0, 0, At, B0); PG8_MMA(0, 1, At, B1); PG8_BAR; PG8_SCHED;
            PG8_LDA(At, 0, 1); PG8_STAGE(PG8_SB(0, 0), b2, voffB); PG8_STAGE(PG8_SB(0, 1), b2 + hstep, voffB); PG8_STAGE(PG8_SA(0, 0), a2, voffA);
            PG8_WAIT_V(8); PG8_WAIT_L(0); PG8_BAR; PG8_MMA(1, 0, At, B0); PG8_MMA(1, 1, At, B1); PG8_BAR; PG8_SCHED;
            PG8_LDB(B0, 1, 0); PG8_LDB(B1, 1, 1); PG8_SCHED; PG8_LDA(At, 1, 0); PG8_STAGE(PG8_SA(0, 1), a2 + hstep, voffA);
            PG8_WAIT_V(8); PG8_WAIT_L(0); PG8_BAR; PG8_MMA(0, 0, At, B0); PG8_MMA(0, 1, At, B1); PG8_BAR; PG8_SCHED;
            PG8_LDA(At, 1, 1); PG8_STAGE(PG8_SB(1, 0), b3, voffB); PG8_STAGE(PG8_SB(1, 1), b3 + hstep, voffB); PG8_STAGE(PG8_SA(1, 0), a3, voffA);
            PG8_WAIT_V(8); PG8_WAIT_L(0); PG8_BAR; PG8_MMA(1, 0, At, B0); PG8_MMA(1, 1, At, B1); PG8_BAR; PG8_SCHED;
            } else {
            PG8_LDB(B0, 0, 0); PG8_SCHED; PG8_LDA(At, 0, 0); PG8_STAGE(PG8_SA(1, 1), a1 + hstep, voffA);
            PG8_WAIT_L(8); PG8_BAR; PG8_WAIT_L(0); PG8_MMA(0, 0, At, B0); PG8_BAR; PG8_SCHED;
            PG8_LDB(B1, 0, 1); PG8_STAGE(PG8_SB(0, 0), b2, voffB);
            PG8_BAR; PG8_WAIT_L(0); PG8_MMA(0, 1, At, B1); PG8_BAR;
            PG8_LDA(At, 0, 1); PG8_STAGE(PG8_SA(0, 0), a2, voffA);
            PG8_BAR; PG8_WAIT_L(0); PG8_MMA(1, 0, At, B0); PG8_BAR; PG8_SCHED;
            PG8_STAGE(PG8_SB(0, 1), b2 + hstep, voffB);
            PG8_WAIT_V(6); PG8_BAR; PG8_MMA(1, 1, At, B1); PG8_BAR;
            PG8_LDB(B0, 1, 0); PG8_SCHED; PG8_LDA(At, 1, 0); PG8_STAGE(PG8_SA(0, 1), a2 + hstep, voffA);
            PG8_WAIT_L(8); PG8_BAR; PG8_WAIT_L(0); PG8_MMA(0, 0, At, B0); PG8_BAR; PG8_SCHED;
            PG8_LDB(B1, 1, 1); PG8_STAGE(PG8_SB(1, 0), b3, voffB);
            PG8_BAR; PG8_WAIT_L(0); PG8_MMA(0, 1, At, B1); PG8_BAR;
            PG8_LDA(At, 1, 1); PG8_STAGE(PG8_SA(1, 0), a3, voffA);
            PG8_BAR; PG8_WAIT_L(0); PG8_MMA(1, 0, At, B0); PG8_BAR; PG8_SCHED;
            PG8_STAGE(PG8_SB(1, 1), b3 + hstep, voffB);
            PG8_WAIT_V(6); PG8_BAR; PG8_MMA(1, 1, At, B1); PG8_BAR;
            }
        }
        if constexpr (ALIGN_EPI) { if (wr == 0) PG8_BAR; }
        if constexpr (!Epi::AFTER_DRAIN) { E(acc, cur, wr, wc, fr, fq);
#ifdef EPI_TWICE
            asm volatile("" ::: "memory"); E(acc, cur, wr, wc, fr, fq);
#endif
            S.done(cur); }
        if (!has_next) break;
#pragma unroll
        for (int a = 0; a < 2; ++a)
#pragma unroll
            for (int b = 0; b < 2; ++b)
#pragma unroll
                for (int m = 0; m < 4; ++m)
#pragma unroll
                    for (int n = 0; n < 2; ++n) acc[a][b][m][n] = (f32x4){0.f, 0.f, 0.f, 0.f};
        cur = nxt; cA = nA; cB = nB; ++ui;
        if constexpr (ALIGN_EPI) { if (wr == 1) PG8_BAR; }
    }
    PG8_WAIT_V(0);
    if constexpr (!ALIGN_EPI) { if (wr == 0) PG8_BAR; }
    PG8_BAR;
    if constexpr (Epi::AFTER_DRAIN) { E.fused(acc, cur, wr, wc, fr, fq, lds, wid, lane); S.done(cur); }
#undef PG8_SA
#undef PG8_SB
#undef PG8_STAGE
#undef PG8_LDA
#undef PG8_LDB
#undef PG8_MMA
#undef PG8_WAIT_V
#undef PG8_WAIT_L
#undef PG8_BAR
#undef PG8_SCHED
}
}
namespace att {
typedef unsigned short bf16;
constexpr int   D = 128, NW = 8, QBLK = 32, KVBLK = 64;
constexpr float SCALE = 0.088388347648318440f;
constexpr float THR = 8.f;
constexpr int SDEPTH = 1;
constexpr int LDQ = 1024, LDK = 1024, LDO = 2048;
constexpr size_t SHM_V = KVBLK * D * 2, SHM_K = KVBLK * D * 2, SHM_ATTN = 2 * SHM_V + 2 * SHM_K + NW * 64 * 4;
using bf16x8 = __attribute__((ext_vector_type(8))) short;
using s16x4  = __attribute__((ext_vector_type(4))) short;
using f32x16 = __attribute__((ext_vector_type(16))) float;
using f32x8  = __attribute__((ext_vector_type(8))) float;
using u32x4  = __attribute__((ext_vector_type(4))) unsigned;
#define KSWZ(row, colB) ((row) * 256 + ((colB) ^ (((row) & 7) << 4)))
#define SBAR() __builtin_amdgcn_sched_barrier(0)
__device__ __forceinline__ int crow(int r, int hi) { return (r & 3) + 8 * (r >> 2) + 4 * hi; }
__device__ __forceinline__ unsigned cvtpk(float lo, float hi) {
  unsigned r; asm volatile("v_cvt_pk_bf16_f32 %0, %1, %2" : "=v"(r) : "v"(lo), "v"(hi)); return r;
}
template <typename TIn> struct Stage;
template <> struct Stage<bf16>  { using T = bf16x8;
  __device__ static __forceinline__ T ld8(const bf16* p) { return *reinterpret_cast<const bf16x8*>(p); }
  __device__ static __forceinline__ bf16x8 tobf(T x) { return x; } };
template <> struct Stage<float> { using T = f32x8;
  __device__ static __forceinline__ T ld8(const float* p) { return *reinterpret_cast<const f32x8*>(p); }
  __device__ static __forceinline__ bf16x8 tobf(T x) {
    u32x4 w = {cvtpk(x[0], x[1]), cvtpk(x[2], x[3]), cvtpk(x[4], x[5]), cvtpk(x[6], x[7])}; return *reinterpret_cast<bf16x8*>(&w); } };

__device__ __forceinline__ void partialSM(f32x16& p0, f32x16& p1, float& m_reg, float& mn, float& alpha) {
  constexpr float C = SCALE * 1.4426950408889634f;
  float pmax = p0[0]; for (int r = 1; r < 16; ++r) pmax = fmaxf(pmax, p0[r]); for (int r = 0; r < 16; ++r) pmax = fmaxf(pmax, p1[r]);
  { auto rr = __builtin_amdgcn_permlane32_swap(__float_as_uint(pmax), __float_as_uint(pmax), false, false);
    pmax = fmaxf(__uint_as_float(rr[0]), __uint_as_float(rr[1])); }
  if (__builtin_expect(__all(pmax - m_reg <= THR / SCALE), 1)) { mn = m_reg; alpha = 1.f; }
  else { mn = fmaxf(m_reg, pmax); alpha = __builtin_amdgcn_exp2f((m_reg - mn) * C); m_reg = mn; }
  float mnC = -mn * C;
  for (int r = 0; r < 16; ++r) p0[r] = fmaf(p0[r], C, mnC); for (int r = 0; r < 16; ++r) p1[r] = fmaf(p1[r], C, mnC);
  for (int r = 0; r < 16; ++r) p0[r] = __builtin_amdgcn_exp2f(p0[r]);
}
__device__ __forceinline__ void finishSM(f32x16& p0, f32x16& p1, float alpha, float& l_reg, bf16x8& pa0, bf16x8& pa1, bf16x8& pa2, bf16x8& pa3) {
  for (int r = 0; r < 16; ++r) p1[r] = __builtin_amdgcn_exp2f(p1[r]);
  float ps = 0; for (int r = 0; r < 16; ++r) ps += p0[r]; for (int r = 0; r < 16; ++r) ps += p1[r];
  { auto rr = __builtin_amdgcn_permlane32_swap(__float_as_uint(ps), __float_as_uint(ps), false, false);
    ps = __uint_as_float(rr[0]) + __uint_as_float(rr[1]); }
  l_reg = l_reg * alpha + ps;
#define PK4(P, BASE, OUT) do { unsigned a0 = cvtpk(P[BASE + 0], P[BASE + 1]), a1 = cvtpk(P[BASE + 2], P[BASE + 3]);   \
    unsigned b0 = cvtpk(P[BASE + 4], P[BASE + 5]), b1 = cvtpk(P[BASE + 6], P[BASE + 7]);                              \
    auto r0 = __builtin_amdgcn_permlane32_swap(a0, b0, false, false); auto r1 = __builtin_amdgcn_permlane32_swap(a1, b1, false, false); \
    u32x4 w = {r0[0], r1[0], r0[1], r1[1]}; OUT = *reinterpret_cast<bf16x8*>(&w); } while (0)
  PK4(p0, 0, pa0); PK4(p0, 8, pa1); PK4(p1, 0, pa2); PK4(p1, 8, pa3);
#undef PK4
}
__device__ __forceinline__ void qkt(f32x16& p0, f32x16& p1, const bf16* Ks, const bf16x8* qr, int r32, int hi) {
  p0 = f32x16{}; p1 = f32x16{};
  for (int d0 = 0; d0 < 8; ++d0) { int cb = (d0 * 16 + hi * 8) * 2;
    bf16x8 b0 = *reinterpret_cast<const bf16x8*>((const char*)Ks + KSWZ(r32, cb));
    bf16x8 b1 = *reinterpret_cast<const bf16x8*>((const char*)Ks + KSWZ(32 + r32, cb));
    p0 = __builtin_amdgcn_mfma_f32_32x32x16_bf16(b0, qr[d0], p0, 0, 0, 0);
    p1 = __builtin_amdgcn_mfma_f32_32x32x16_bf16(b1, qr[d0], p1, 0, 0, 0); }
}
__device__ __forceinline__ int v_st(int k, int c) { const int kk = (k & ~0xC) | ((k & 4) << 1) | ((k & 8) >> 1); return ((kk >> 3) * 4 + (c >> 5)) * 512 + ((kk & 7) * 32 + (c & 31)) * 2; }
__device__ __forceinline__ int v_rd_base(int lane) { return ((lane & 3) << 3) | (((lane >> 2) & 3) << 6) | (((lane >> 4) & 1) << 5) | (((lane >> 5) & 1) << 8); }
constexpr int v_rd_off(int d0, int ks, int half) { return d0 * 512 + ks * 4096 + half * 2048; }
template <int OFF> __device__ __forceinline__ s16x4 tr_read(int vb) {
  s16x4 r; asm volatile("ds_read_b64_tr_b16 %0, %1 offset:%2" : "=&v"(r) : "v"(vb), "i"(OFF) : "memory"); return r;
}
template <int D0> __device__ __forceinline__ void pv_one(f32x16& od, int vb, bf16x8 pa0, bf16x8 pa1, bf16x8 pa2, bf16x8 pa3) {
  const s16x4 l0 = tr_read<v_rd_off(D0, 0, 0)>(vb), h0 = tr_read<v_rd_off(D0, 0, 1)>(vb), l1 = tr_read<v_rd_off(D0, 1, 0)>(vb), h1 = tr_read<v_rd_off(D0, 1, 1)>(vb);
  const s16x4 l2 = tr_read<v_rd_off(D0, 2, 0)>(vb), h2 = tr_read<v_rd_off(D0, 2, 1)>(vb), l3 = tr_read<v_rd_off(D0, 3, 0)>(vb), h3 = tr_read<v_rd_off(D0, 3, 1)>(vb);
  asm volatile("s_waitcnt lgkmcnt(0)" ::: "memory"); SBAR();
#define PK(L, H) (bf16x8){L[0], L[1], L[2], L[3], H[0], H[1], H[2], H[3]}
  od = __builtin_amdgcn_mfma_f32_32x32x16_bf16(pa0, PK(l0, h0), od, 0, 0, 0);
  od = __builtin_amdgcn_mfma_f32_32x32x16_bf16(pa1, PK(l1, h1), od, 0, 0, 0);
  od = __builtin_amdgcn_mfma_f32_32x32x16_bf16(pa2, PK(l2, h2), od, 0, 0, 0);
  od = __builtin_amdgcn_mfma_f32_32x32x16_bf16(pa3, PK(l3, h3), od, 0, 0, 0);
#undef PK
}
template <int KS> __device__ __forceinline__ void pv_rd(int vb, s16x4 (&l)[4], s16x4 (&h)[4]) {
  l[0] = tr_read<v_rd_off(0, KS, 0)>(vb); h[0] = tr_read<v_rd_off(0, KS, 1)>(vb); l[1] = tr_read<v_rd_off(1, KS, 0)>(vb); h[1] = tr_read<v_rd_off(1, KS, 1)>(vb);
  l[2] = tr_read<v_rd_off(2, KS, 0)>(vb); h[2] = tr_read<v_rd_off(2, KS, 1)>(vb); l[3] = tr_read<v_rd_off(3, KS, 0)>(vb); h[3] = tr_read<v_rd_off(3, KS, 1)>(vb);
}
__device__ __forceinline__ void pv_mm(f32x16* o, bf16x8 pa, const s16x4 (&l)[4], const s16x4 (&h)[4]) {
#define PK(L, H) (bf16x8){L[0], L[1], L[2], L[3], H[0], H[1], H[2], H[3]}
  o[0] = __builtin_amdgcn_mfma_f32_32x32x16_bf16(pa, PK(l[0], h[0]), o[0], 0, 0, 0);
  o[1] = __builtin_amdgcn_mfma_f32_32x32x16_bf16(pa, PK(l[1], h[1]), o[1], 0, 0, 0);
  o[2] = __builtin_amdgcn_mfma_f32_32x32x16_bf16(pa, PK(l[2], h[2]), o[2], 0, 0, 0);
  o[3] = __builtin_amdgcn_mfma_f32_32x32x16_bf16(pa, PK(l[3], h[3]), o[3], 0, 0, 0);
#undef PK
}
__device__ __forceinline__ void pv_d0(f32x16* o, int vb, bf16x8 pa0, bf16x8 pa1, bf16x8 pa2, bf16x8 pa3) {
  s16x4 la[4], ha[4], lb[4], hb[4];
  pv_rd<0>(vb, la, ha); pv_rd<1>(vb, lb, hb);
  asm volatile("s_waitcnt lgkmcnt(8)" ::: "memory"); SBAR(); pv_mm(o, pa0, la, ha); SBAR();
  pv_rd<2>(vb, la, ha);
  asm volatile("s_waitcnt lgkmcnt(8)" ::: "memory"); SBAR(); pv_mm(o, pa1, lb, hb); SBAR();
  pv_rd<3>(vb, lb, hb);
  asm volatile("s_waitcnt lgkmcnt(8)" ::: "memory"); SBAR(); pv_mm(o, pa2, la, ha); SBAR();
  asm volatile("s_waitcnt lgkmcnt(0)" ::: "memory"); SBAR(); pv_mm(o, pa3, lb, hb);
}

struct KVSrc { const bf16* k0; const bf16* v0; const bf16* k1; const bf16* v1; int nt0, ntreal; };
__device__ __forceinline__ void mask_tile(f32x16& p0, f32x16& p1) {
#pragma unroll
  for (int r = 0; r < 16; ++r) { p0[r] = -1e30f; p1[r] = -1e30f; }
}
constexpr int OST_PITCH = 272, OST_BYTES = 32 * OST_PITCH;
__device__ __forceinline__ void store_o_rows(const f32x16* o, const float* rli, bf16* Owv, char* stage, int lane, int r32, int hi) {
#pragma unroll
  for (int r = 0; r < 16; ++r) { const int orow = crow(r, hi);
#pragma unroll
    for (int d0 = 0; d0 < 4; ++d0) { const float v = o[d0][r] * rli[r]; const unsigned b = __float_as_uint(v);
      *(unsigned short*)(stage + orow * OST_PITCH + (d0 * 32 + r32) * 2) = (unsigned short)((b + 0x7fffu + ((b >> 16) & 1u)) >> 16); } }
  asm volatile("s_waitcnt lgkmcnt(0)" ::: "memory");
  if (Owv != nullptr) {
#pragma unroll
    for (int i = 0; i < 8; ++i) { const int id = lane + 64 * i, row = id >> 4, c16 = id & 15;
      *(u32x4*)(Owv + (long)row * LDO + c16 * 8) = *(const u32x4*)(stage + row * OST_PITCH + c16 * 16); }
  }
}
template <bool STAGE>
__device__ __forceinline__ void attn_body(const bf16* __restrict__ Qwv, const KVSrc src, bf16* __restrict__ Owv, const int NT, const int lim, char* lds) {
  using St = Stage<bf16>;
  int tid_ = threadIdx.x; asm volatile("" : "+v"(tid_));
  const int tid = tid_, wid = tid >> 6, lane = tid & 63, r32 = lane & 31, hi = lane >> 5;
  bf16* V_lds = (bf16*)lds; bf16* K_lds = (bf16*)(lds + 2 * SHM_V);
  float* ws = (float*)(lds + 2 * SHM_V + 2 * SHM_K) + wid * 64; float* li_l = ws; float* al_l = ws + 32;
  float m_reg = -1e30f, l_reg = 0; f32x16 o[4] = {}; bf16x8 qr[8];
  const bf16* Qw = Qwv + (long)r32 * LDQ + hi * 8;
#pragma unroll
  for (int d0 = 0; d0 < 8; ++d0) qr[d0] = St::ld8(Qw + d0 * 16);
  const int sr = tid >> 4, sc = (tid & 15) * 8, vst0 = v_st(sr, sc), vst1 = v_st(32 + sr, sc);
  const int vb0 = (int)(uintptr_t)V_lds + v_rd_base(lane);
  struct { typename St::T vs0, vs1, ks0, ks1; } sr_[SDEPTH];
#define SLOAD(i, t) do { if constexpr (STAGE) { int tt_ = (t) < src.ntreal ? (t) : src.ntreal - 1; const bf16* kp_; const bf16* vp_; \
    if (tt_ < src.nt0) { kp_ = src.k0 + (long)tt_ * (KVBLK * LDK); vp_ = src.v0 + (long)tt_ * (KVBLK * LDK); } \
    else { kp_ = src.k1 + (long)(tt_ - src.nt0) * (KVBLK * LDK); vp_ = src.v1 + (long)(tt_ - src.nt0) * (KVBLK * LDK); } \
    sr_[i].vs0 = St::ld8(&vp_[(long)sr * LDK + sc]); sr_[i].vs1 = St::ld8(&vp_[(long)(32 + sr) * LDK + sc]); \
    sr_[i].ks0 = St::ld8(&kp_[(long)sr * LDK + sc]); sr_[i].ks1 = St::ld8(&kp_[(long)(32 + sr) * LDK + sc]); } } while (0)
#define SWRITE(b, i) do { if constexpr (STAGE) { *(bf16x8*)((char*)V_lds + (b) * SHM_V + vst0) = St::tobf(sr_[i].vs0);          \
    *(bf16x8*)((char*)V_lds + (b) * SHM_V + vst1) = St::tobf(sr_[i].vs1); int kc = sc * 2;               \
    *(bf16x8*)((char*)K_lds + (b) * SHM_K + KSWZ(sr, kc)) = St::tobf(sr_[i].ks0);                       \
    *(bf16x8*)((char*)K_lds + (b) * SHM_K + KSWZ(32 + sr, kc)) = St::tobf(sr_[i].ks1); } } while (0)
#define SWAIT() do { if constexpr (STAGE) { if constexpr (SDEPTH == 2) asm volatile("s_waitcnt vmcnt(4)" ::: "memory"); else asm volatile("s_waitcnt vmcnt(0)" ::: "memory"); } } while (0)
#define RESC(a) do { if (__any((a) < 1.f)) { if (hi == 0) al_l[r32] = (a); asm volatile("s_waitcnt lgkmcnt(0)" ::: "memory"); \
    for (int d = 0; d < 4; ++d) for (int r = 0; r < 16; ++r) o[d][r] *= al_l[crow(r, hi)]; } } while (0)
  f32x16 pA0, pA1, pB0, pB1; float mnA, mnB, alA, alB; bf16x8 pa0, pa1, pa2, pa3;
  constexpr int SE = 0, SO = SDEPTH - 1;
  SLOAD(SE, 0); asm volatile("s_waitcnt vmcnt(0)" ::: "memory"); SWRITE(0, SE); __syncthreads();
  qkt(pA0, pA1, K_lds, qr, r32, hi); partialSM(pA0, pA1, m_reg, mnA, alA);
  SLOAD(SO, 1); if constexpr (SDEPTH == 2) { if (2 < NT) SLOAD(SE, 2); }
  SWAIT(); SWRITE(1, SO); __syncthreads();
  for (int j = 1; j + 1 < NT; j += 2) {
    SBAR(); qkt(pB0, pB1, (bf16*)((char*)K_lds + SHM_K), qr, r32, hi); if (j > lim) mask_tile(pB0, pB1);
    finishSM(pA0, pA1, alA, l_reg, pa0, pa1, pa2, pa3); SBAR();
    SLOAD(SO, j + SDEPTH); SBAR();
    pv_d0(o, vb0, pa0, pa1, pa2, pa3); partialSM(pB0, pB1, m_reg, mnB, alB);
    __syncthreads(); SWAIT(); SWRITE(0, SE);
    RESC(alB); __syncthreads();
    SBAR(); qkt(pA0, pA1, K_lds, qr, r32, hi); if (j + 1 > lim) mask_tile(pA0, pA1);
    finishSM(pB0, pB1, alB, l_reg, pa0, pa1, pa2, pa3); SBAR();
    if (SDEPTH == 1 || j + 3 < NT) SLOAD(SE, j + 1 + SDEPTH); SBAR();
    pv_d0(o, vb0 + (int)SHM_V, pa0, pa1, pa2, pa3); partialSM(pA0, pA1, m_reg, mnA, alA);
    __syncthreads(); SWAIT(); SWRITE(1, SO);
    RESC(alA); __syncthreads();
  }
  SBAR(); qkt(pB0, pB1, (bf16*)((char*)K_lds + SHM_K), qr, r32, hi); if (NT - 1 > lim) mask_tile(pB0, pB1);
  finishSM(pA0, pA1, alA, l_reg, pa0, pa1, pa2, pa3); SBAR();
  pv_d0(o, vb0, pa0, pa1, pa2, pa3); partialSM(pB0, pB1, m_reg, mnB, alB);
  __syncthreads(); RESC(alB);
  finishSM(pB0, pB1, alB, l_reg, pa0, pa1, pa2, pa3); SBAR();
  pv_d0(o, vb0 + (int)SHM_V, pa0, pa1, pa2, pa3);
  if (hi == 0) li_l[r32] = l_reg; asm volatile("s_waitcnt lgkmcnt(0)" ::: "memory");
  float rli[16];
#pragma unroll
  for (int r = 0; r < 16; ++r) rli[r] = __builtin_amdgcn_rcpf(li_l[crow(r, hi)]);
  store_o_rows(o, rli, Owv, lds + 69632 + wid * OST_BYTES, lane, r32, hi);
  asm volatile("s_waitcnt vmcnt(0)" ::: "memory");
#undef SLOAD
#undef SWRITE
#undef SWAIT
#undef RESC
}
__device__ __forceinline__ void attn_body_1b(const bf16* __restrict__ Qwv, bf16* __restrict__ Owv, const int NT, const int lim, char* lds) {
  using St = Stage<bf16>;
  int tid_ = threadIdx.x; asm volatile("" : "+v"(tid_));
  const int tid = tid_, wid = tid >> 6, lane = tid & 63, r32 = lane & 31, hi = lane >> 5;
  bf16* V_lds = (bf16*)lds; bf16* K_lds = (bf16*)(lds + 2 * SHM_V);
  float* ws = (float*)(lds + 2 * SHM_V + 2 * SHM_K) + wid * 64; float* li_l = ws; float* al_l = ws + 32;
  float m_reg = -1e30f, l_reg = 0; f32x16 o[4] = {}; bf16x8 qr[8];
  const bf16* Qw = Qwv + (long)r32 * LDQ + hi * 8;
#pragma unroll
  for (int d0 = 0; d0 < 8; ++d0) qr[d0] = St::ld8(Qw + d0 * 16);
  const int vb0 = (int)(uintptr_t)V_lds + v_rd_base(lane);
#define RESC(a) do { if (__any((a) < 1.f)) { if (hi == 0) al_l[r32] = (a); asm volatile("s_waitcnt lgkmcnt(0)" ::: "memory"); \
    for (int d = 0; d < 4; ++d) for (int r = 0; r < 16; ++r) o[d][r] *= al_l[crow(r, hi)]; } } while (0)
  f32x16 pA0, pA1, pB0, pB1; float mnA, mnB, alA, alB; bf16x8 pa0, pa1, pa2, pa3;
  __syncthreads();
  qkt(pA0, pA1, K_lds, qr, r32, hi); partialSM(pA0, pA1, m_reg, mnA, alA);
  __syncthreads();
  for (int j = 1; j + 1 < NT; j += 2) {
    SBAR(); qkt(pB0, pB1, (bf16*)((char*)K_lds + SHM_K), qr, r32, hi); if (j > lim) mask_tile(pB0, pB1);
    finishSM(pA0, pA1, alA, l_reg, pa0, pa1, pa2, pa3); SBAR();
    pv_d0(o, vb0, pa0, pa1, pa2, pa3); partialSM(pB0, pB1, m_reg, mnB, alB);
    RESC(alB); __syncthreads();
    SBAR(); qkt(pA0, pA1, K_lds, qr, r32, hi); if (j + 1 > lim) mask_tile(pA0, pA1);
    finishSM(pB0, pB1, alB, l_reg, pa0, pa1, pa2, pa3); SBAR();
    pv_d0(o, vb0 + (int)SHM_V, pa0, pa1, pa2, pa3); partialSM(pA0, pA1, m_reg, mnA, alA);
    RESC(alA); __syncthreads();
  }
  SBAR(); qkt(pB0, pB1, (bf16*)((char*)K_lds + SHM_K), qr, r32, hi); if (NT - 1 > lim) mask_tile(pB0, pB1);
  finishSM(pA0, pA1, alA, l_reg, pa0, pa1, pa2, pa3); SBAR();
  pv_d0(o, vb0, pa0, pa1, pa2, pa3); partialSM(pB0, pB1, m_reg, mnB, alB);
  RESC(alB); __syncthreads();
  finishSM(pB0, pB1, alB, l_reg, pa0, pa1, pa2, pa3); SBAR();
  pv_d0(o, vb0 + (int)SHM_V, pa0, pa1, pa2, pa3);
  if (hi == 0) li_l[r32] = l_reg; asm volatile("s_waitcnt lgkmcnt(0)" ::: "memory");
  float rli[16];
#pragma unroll
  for (int r = 0; r < 16; ++r) rli[r] = __builtin_amdgcn_rcpf(li_l[crow(r, hi)]);
  store_o_rows(o, rli, Owv, lds + 69632 + wid * OST_BYTES, lane, r32, hi);
  asm volatile("s_waitcnt vmcnt(0)" ::: "memory");
#undef RESC
}
typedef float f32x4p __attribute__((ext_vector_type(4)));
template <int PAR>
__device__ __forceinline__ void attn_body_par(const bf16* __restrict__ Qwv, bf16* __restrict__ Owv, const int NT, const int lim, char* lds) {
  using St = Stage<bf16>;
  constexpr float C = SCALE * 1.4426950408889634f;
  int tid_ = threadIdx.x; asm volatile("" : "+v"(tid_));
  const int tid = tid_, wid = tid >> 6, lane = tid & 63, r32 = lane & 31, hi = lane >> 5, pw = wid & 1;
  bf16* V_lds = (bf16*)lds; bf16* K_lds = (bf16*)(lds + 2 * SHM_V);
  float* wsb = (float*)(lds + 2 * SHM_V + 2 * SHM_K);
  float* ws = wsb + wid * 64; float* li_l = ws; float* al_l = ws + 32;
  char* X = (char*)K_lds + pw * 16384;
  float m_reg = -1e30f, l_reg = 0; f32x16 o[4] = {}; bf16x8 qr[8];
  const bf16* Qw = Qwv + (long)r32 * LDQ + hi * 8;
#pragma unroll
  for (int d0 = 0; d0 < 8; ++d0) qr[d0] = St::ld8(Qw + d0 * 16);
  const int vb0 = (int)(uintptr_t)V_lds + v_rd_base(lane) + PAR * (int)SHM_V;
  const bf16* Kp = (const bf16*)((const char*)K_lds + PAR * SHM_K);
#define RESC(a) do { if (__any((a) < 1.f)) { if (hi == 0) al_l[r32] = (a); asm volatile("s_waitcnt lgkmcnt(0)" ::: "memory"); \
    for (int d = 0; d < 4; ++d) for (int r = 0; r < 16; ++r) o[d][r] *= al_l[crow(r, hi)]; } } while (0)
  f32x16 p0, p1; float mn, al; bf16x8 pa0, pa1, pa2, pa3;
  __syncthreads();
  if (PAR == 1) __syncthreads();
  for (int t = PAR; t < NT; t += 2) {
    SBAR(); qkt(p0, p1, Kp, qr, r32, hi); if (t > lim) mask_tile(p0, p1);
    partialSM(p0, p1, m_reg, mn, al); SBAR();
    __syncthreads();
    RESC(al); finishSM(p0, p1, al, l_reg, pa0, pa1, pa2, pa3); SBAR();
    pv_d0(o, vb0, pa0, pa1, pa2, pa3);
    if (PAR == 0 || t + 2 < NT) __syncthreads();
  }
  if (PAR == 1) {
    if (hi == 0) { li_l[r32] = l_reg; al_l[r32] = m_reg; }
#pragma unroll
    for (int d = 0; d < 4; ++d)
#pragma unroll
      for (int q = 0; q < 4; ++q) *(f32x4p*)(X + ((d * 4 + q) * 64 + lane) * 16) = (f32x4p){o[d][4 * q], o[d][4 * q + 1], o[d][4 * q + 2], o[d][4 * q + 3]};
    __syncthreads();
  } else {
    __syncthreads();
    float* pws = wsb + (wid + 6) * 64;
    const float l1 = pws[r32], m1 = pws[32 + r32];
    asm volatile("s_waitcnt lgkmcnt(0)" ::: "memory");
    const float m = fmaxf(m_reg, m1), f0 = __builtin_amdgcn_exp2f((m_reg - m) * C), f1 = __builtin_amdgcn_exp2f((m1 - m) * C);
    if (hi == 0) { li_l[r32] = l_reg * f0 + l1 * f1; al_l[r32] = f0; pws[r32] = f1; }
    asm volatile("s_waitcnt lgkmcnt(0)" ::: "memory");
#pragma unroll
    for (int d = 0; d < 4; ++d)
#pragma unroll
      for (int q = 0; q < 4; ++q) { const f32x4p x = *(const f32x4p*)(X + ((d * 4 + q) * 64 + lane) * 16);
#pragma unroll
        for (int e = 0; e < 4; ++e) { const int r = 4 * q + e; o[d][r] = o[d][r] * al_l[crow(r, hi)] + x[e] * pws[crow(r, hi)]; } }
    float rli[16];
#pragma unroll
    for (int r = 0; r < 16; ++r) rli[r] = __builtin_amdgcn_rcpf(li_l[crow(r, hi)]);
    store_o_rows(o, rli, Owv, lds + 69632 + wid * OST_BYTES, lane, r32, hi);
    asm volatile("s_waitcnt vmcnt(0)" ::: "memory");
  }
#undef RESC
}
__device__ __forceinline__ void attn_stage_only(const KVSrc src, const int NT, char* lds) {
  using St = Stage<bf16>;
  int tid_ = threadIdx.x; asm volatile("" : "+v"(tid_));
  const int tid = tid_;
  bf16* V_lds = (bf16*)lds; bf16* K_lds = (bf16*)(lds + 2 * SHM_V);
  const int sr = tid >> 4, sc = (tid & 15) * 8, vst0 = v_st(sr, sc), vst1 = v_st(32 + sr, sc);
  struct { typename St::T vs0, vs1, ks0, ks1; } sr_[SDEPTH];
#define SLOAD(i, t) do { int tt_ = (t) < src.ntreal ? (t) : src.ntreal - 1; const bf16* kp_; const bf16* vp_; \
    if (tt_ < src.nt0) { kp_ = src.k0 + (long)tt_ * (KVBLK * LDK); vp_ = src.v0 + (long)tt_ * (KVBLK * LDK); } \
    else { kp_ = src.k1 + (long)(tt_ - src.nt0) * (KVBLK * LDK); vp_ = src.v1 + (long)(tt_ - src.nt0) * (KVBLK * LDK); } \
    sr_[i].vs0 = St::ld8(&vp_[(long)sr * LDK + sc]); sr_[i].vs1 = St::ld8(&vp_[(long)(32 + sr) * LDK + sc]); \
    sr_[i].ks0 = St::ld8(&kp_[(long)sr * LDK + sc]); sr_[i].ks1 = St::ld8(&kp_[(long)(32 + sr) * LDK + sc]); } while (0)
#define SWRITE(b, i) do { *(bf16x8*)((char*)V_lds + (b) * SHM_V + vst0) = St::tobf(sr_[i].vs0);          \
    *(bf16x8*)((char*)V_lds + (b) * SHM_V + vst1) = St::tobf(sr_[i].vs1); int kc = sc * 2;               \
    *(bf16x8*)((char*)K_lds + (b) * SHM_K + KSWZ(sr, kc)) = St::tobf(sr_[i].ks0);                       \
    *(bf16x8*)((char*)K_lds + (b) * SHM_K + KSWZ(32 + sr, kc)) = St::tobf(sr_[i].ks1); } while (0)
#define SWAIT() do { if constexpr (SDEPTH == 2) asm volatile("s_waitcnt vmcnt(4)" ::: "memory"); else asm volatile("s_waitcnt vmcnt(0)" ::: "memory"); } while (0)
  constexpr int SE = 0, SO = SDEPTH - 1;
  SLOAD(SE, 0); asm volatile("s_waitcnt vmcnt(0)" ::: "memory"); SWRITE(0, SE); __syncthreads();
  SLOAD(SO, 1); if constexpr (SDEPTH == 2) { if (2 < NT) SLOAD(SE, 2); }
  SWAIT(); SWRITE(1, SO); __syncthreads();
  for (int j = 1; j + 1 < NT; j += 2) {
    SLOAD(SO, j + SDEPTH);
    __syncthreads(); SWAIT(); SWRITE(0, SE);
    __syncthreads();
    if (SDEPTH == 1 || j + 3 < NT) SLOAD(SE, j + 1 + SDEPTH);
    __syncthreads(); SWAIT(); SWRITE(1, SO);
    __syncthreads();
  }
  __syncthreads();
  asm volatile("s_waitcnt vmcnt(0)" ::: "memory");
#undef SLOAD
#undef SWRITE
#undef SWAIT
}
struct KVSrcF { const float* k0; const float* v0; const float* k1; const float* v1; int nt0, ntreal; };
__device__ __forceinline__ void attn_stage_f32(const KVSrcF src, const int NT, char* lds) {
  int tid_ = threadIdx.x; asm volatile("" : "+v"(tid_));
  const int st = tid_ - 128;
  bf16* V_lds = (bf16*)lds; bf16* K_lds = (bf16*)(lds + 2 * SHM_V);
  f32x8 krA[4], vrA[4], krB[4], vrB[4];
#define FBASE(t, K0, K1) ({ int tt_ = (t) < src.ntreal ? (t) : src.ntreal - 1; (tt_ < src.nt0) ? (K0) + (long)tt_ * (KVBLK * 1024) : (K1) + (long)(tt_ - src.nt0) * (KVBLK * 1024); })
#define FLOADK(kr, t) do { const float* kp_ = FBASE(t, src.k0, src.k1); \
    _Pragma("unroll") for (int q = 0; q < 4; ++q) { const int ci = st + 256 * q, row = ci >> 4, cg = ci & 15; kr[q] = *reinterpret_cast<const f32x8*>(kp_ + (long)row * 1024 + cg * 8); } } while (0)
#define FLOADV(vr, t) do { const float* vp_ = FBASE(t, src.v0, src.v1); \
    _Pragma("unroll") for (int q = 0; q < 4; ++q) { const int ci = st + 256 * q, row = ci >> 4, cg = ci & 15; vr[q] = *reinterpret_cast<const f32x8*>(vp_ + (long)row * 1024 + cg * 8); } } while (0)
#define FWRITEK(kr, b) do { _Pragma("unroll") for (int q = 0; q < 4; ++q) { const int ci = st + 256 * q, row = ci >> 4, cg = ci & 15; \
      *(bf16x8*)((char*)K_lds + (b) * SHM_K + KSWZ(row, cg * 16)) = Stage<float>::tobf(kr[q]); } } while (0)
#define FWRITEV(vr, b) do { _Pragma("unroll") for (int q = 0; q < 4; ++q) { const int ci = st + 256 * q, row = ci >> 4, cg = ci & 15; \
      *(bf16x8*)((char*)V_lds + (b) * SHM_V + v_st(row, cg * 8)) = Stage<float>::tobf(vr[q]); } } while (0)
#define FORD() asm volatile("" ::: "memory")
  FLOADK(krA, 0); FLOADV(vrA, 0); FLOADK(krB, 1); FLOADV(vrB, 1);
  FWRITEK(krA, 0); FORD(); FLOADK(krA, 2); __syncthreads();
  FWRITEK(krB, 1); FORD(); FLOADK(krB, 3); FWRITEV(vrA, 0); FORD(); FLOADV(vrA, 2); __syncthreads();
  for (int j = 1; j + 1 < NT; j += 2) {
    FWRITEK(krA, 0); FORD(); FLOADK(krA, j + 3); FWRITEV(vrB, 1); FORD(); FLOADV(vrB, j + 2); __syncthreads();
    FWRITEK(krB, 1); FORD(); FLOADK(krB, j + 4); FWRITEV(vrA, 0); FORD(); FLOADV(vrA, j + 3); __syncthreads();
  }
  FWRITEV(vrB, 1); __syncthreads();
  asm volatile("s_waitcnt vmcnt(0)" ::: "memory");
  __syncthreads();
#undef FBASE
#undef FLOADK
#undef FLOADV
#undef FWRITEK
#undef FWRITEV
#undef FORD
}
__device__ __forceinline__ void attn_barriers_only(const int NT) {
  __syncthreads(); __syncthreads();
  for (int j = 1; j + 1 < NT; j += 2) { __syncthreads(); __syncthreads(); }
  __syncthreads();
}

constexpr int B2_V = 0, B2_VBUF = KVBLK * 256 * 2  , B2_K = 2 * B2_VBUF, B2_X = B2_K + 2 * (int)SHM_K, B2_XW = 2048 + 256,
              B2_WS = B2_X + NW * (B2_XW + 64), B2_BYTES = B2_WS + NW * 64 * 4; static_assert(B2_BYTES <= 131072, "P-sharing body fits the 128 KiB phase scratch");
__device__ __forceinline__ void qkt_half(f32x16& p, const char* Ks, const bf16x8* qr, int krow, int hi) {
  p = f32x16{};
#pragma unroll
  for (int d0 = 0; d0 < 8; ++d0) { const int cb = (d0 * 16 + hi * 8) * 2;
    const bf16x8 b = *reinterpret_cast<const bf16x8*>(Ks + KSWZ(krow, cb));
    p = __builtin_amdgcn_mfma_f32_32x32x16_bf16(b, qr[d0], p, 0, 0, 0); }
}
__device__ __forceinline__ void mask_half(f32x16& p) {
#pragma unroll
  for (int r = 0; r < 16; ++r) p[r] = -1e30f;
}
__device__ __forceinline__ void partialSM_half(f32x16& p, float& m_reg, float& mn, float& alpha) {
  constexpr float C = SCALE * 1.4426950408889634f;
  float pmax = p[0];
#pragma unroll
  for (int r = 1; r < 16; ++r) pmax = fmaxf(pmax, p[r]);
  { auto rr = __builtin_amdgcn_permlane32_swap(__float_as_uint(pmax), __float_as_uint(pmax), false, false);
    pmax = fmaxf(__uint_as_float(rr[0]), __uint_as_float(rr[1])); }
  if (__builtin_expect(__all(pmax - m_reg <= THR / SCALE), 1)) { mn = m_reg; alpha = 1.f; }
  else { mn = fmaxf(m_reg, pmax); alpha = __builtin_amdgcn_exp2f((m_reg - mn) * C); m_reg = mn; }
  const float mnC = -mn * C;
#pragma unroll
  for (int r = 0; r < 16; ++r) p[r] = fmaf(p[r], C, mnC);
#pragma unroll
  for (int r = 0; r < 8; ++r) p[r] = __builtin_amdgcn_exp2f(p[r]);
}
__device__ __forceinline__ void finishSM_half(f32x16& p, float alpha, float& l_reg, bf16x8& f0, bf16x8& f1) {
#pragma unroll
  for (int r = 8; r < 16; ++r) p[r] = __builtin_amdgcn_exp2f(p[r]);
  float ps = 0;
#pragma unroll
  for (int r = 0; r < 16; ++r) ps += p[r];
  { auto rr = __builtin_amdgcn_permlane32_swap(__float_as_uint(ps), __float_as_uint(ps), false, false);
    ps = __uint_as_float(rr[0]) + __uint_as_float(rr[1]); }
  l_reg = l_reg * alpha + ps;
#define PK4(P, BASE, OUT) do { unsigned a0 = cvtpk(P[BASE + 0], P[BASE + 1]), a1 = cvtpk(P[BASE + 2], P[BASE + 3]);   \
    unsigned b0 = cvtpk(P[BASE + 4], P[BASE + 5]), b1 = cvtpk(P[BASE + 6], P[BASE + 7]);                              \
    auto r0 = __builtin_amdgcn_permlane32_swap(a0, b0, false, false); auto r1 = __builtin_amdgcn_permlane32_swap(a1, b1, false, false); \
    u32x4 w = {r0[0], r1[0], r0[1], r1[1]}; OUT = *reinterpret_cast<bf16x8*>(&w); } while (0)
  PK4(p, 0, f0); PK4(p, 8, f1);
#undef PK4
}
__device__ __forceinline__ bf16x8 scale_frag(bf16x8 v, float f) {
  u32x4 u = *reinterpret_cast<u32x4*>(&v); u32x4 o;
#pragma unroll
  for (int i = 0; i < 4; ++i) { const float lo = __uint_as_float(u[i] << 16) * f, hi = __uint_as_float(u[i] & 0xffff0000u) * f; o[i] = cvtpk(lo, hi); }
  return *reinterpret_cast<bf16x8*>(&o);
}
__device__ __forceinline__ void attn_body2(const bf16* __restrict__ Qwv, const KVSrc src, bf16* __restrict__ Owv, const int NT, const int lim, char* lds) {
  using St = Stage<bf16>;
  constexpr float C = SCALE * 1.4426950408889634f;
  int tid_ = threadIdx.x; asm volatile("" : "+v"(tid_));
  const int tid = tid_, wid = tid >> 6, lane = tid & 63, r32 = lane & 31, hi = lane >> 5, vh = wid >> 2;
  char* V_lds = lds + B2_V; char* K_lds = lds + B2_K;
  char* Xme = lds + B2_X + wid * (B2_XW + 64); const char* Xpt = lds + B2_X + (wid ^ 4) * (B2_XW + 64); int xseq = 0;
  float* ws = (float*)(lds + B2_WS) + wid * 64; float* li_l = ws; float* al_l = ws + 32;
  float m_reg = -1e30f, l_reg = 0; f32x16 o[4] = {}; bf16x8 qr[8];
  const bf16* Qw = Qwv + (long)r32 * LDQ + hi * 8;
#pragma unroll
  for (int d0 = 0; d0 < 8; ++d0) qr[d0] = St::ld8(Qw + d0 * 16);
  const int sr = tid >> 4, sc = (tid & 15) * 8, vst0 = v_st(sr, sc), vst1 = v_st(32 + sr, sc);
  const int vb0 = (int)(uintptr_t)V_lds + vh * 16384 + v_rd_base(lane);
  const int krow = vh * 32 + r32;
  struct { typename St::T va0, va1, vb0_, vb1_, ks0, ks1; } sr_;
#define SLOAD2(t) do { int tt_ = (t) < src.ntreal ? (t) : src.ntreal - 1; const bf16* kp_; const bf16* vp_; \
    if (tt_ < src.nt0) { kp_ = src.k0 + (long)tt_ * (KVBLK * LDK); vp_ = src.v0 + (long)tt_ * (KVBLK * LDK); } \
    else { kp_ = src.k1 + (long)(tt_ - src.nt0) * (KVBLK * LDK); vp_ = src.v1 + (long)(tt_ - src.nt0) * (KVBLK * LDK); } \
    sr_.va0 = St::ld8(&vp_[(long)sr * LDK + sc]); sr_.va1 = St::ld8(&vp_[(long)(32 + sr) * LDK + sc]); \
    sr_.vb0_ = St::ld8(&vp_[(long)sr * LDK + 128 + sc]); sr_.vb1_ = St::ld8(&vp_[(long)(32 + sr) * LDK + 128 + sc]); \
    sr_.ks0 = St::ld8(&kp_[(long)sr * LDK + sc]); sr_.ks1 = St::ld8(&kp_[(long)(32 + sr) * LDK + sc]); } while (0)
#define SWRITE2V(b) do { *(bf16x8*)(V_lds + (b) * B2_VBUF + vst0) = sr_.va0; *(bf16x8*)(V_lds + (b) * B2_VBUF + vst1) = sr_.va1; \
    *(bf16x8*)(V_lds + (b) * B2_VBUF + 16384 + vst0) = sr_.vb0_; *(bf16x8*)(V_lds + (b) * B2_VBUF + 16384 + vst1) = sr_.vb1_; } while (0)
#define SWRITE2K(b) do { const int kc = sc * 2; *(bf16x8*)(K_lds + (b) * SHM_K + KSWZ(sr, kc)) = sr_.ks0; *(bf16x8*)(K_lds + (b) * SHM_K + KSWZ(32 + sr, kc)) = sr_.ks1; } while (0)
#define SWRITE2(b) do { SWRITE2V(b); SWRITE2K(b); } while (0)
#define SWAIT2() asm volatile("s_waitcnt vmcnt(0)" ::: "memory")
#define RESC2(a) do { if (__any((a) < 1.f)) { if (hi == 0) al_l[r32] = (a); asm volatile("s_waitcnt lgkmcnt(0)" ::: "memory"); \
    for (int d = 0; d < 4; ++d) for (int r = 0; r < 16; ++r) o[d][r] *= al_l[crow(r, hi)]; } } while (0)
#define XPUT(f0, f1, mn) do { char* xb_ = Xme; *(bf16x8*)(xb_ + lane * 16) = (f0); *(bf16x8*)(xb_ + 1024 + lane * 16) = (f1); if (hi == 0) *(float*)(xb_ + 2048 + r32 * 4) = (mn); \
    asm volatile("s_waitcnt lgkmcnt(0)" ::: "memory"); if (lane == 0) *(volatile int*)(Xme + B2_XW) = xseq; } while (0)
#define XGET(f0, f1, mn) do { for (int sp_ = 0; *(volatile const int*)(Xpt + B2_XW) < xseq && sp_ < (1 << 22); ++sp_) __builtin_amdgcn_s_sleep(1);     asm volatile("" ::: "memory"); const char* xb_ = Xpt; \
    bf16x8 g0_ = *(const bf16x8*)(xb_ + lane * 16), g1_ = *(const bf16x8*)(xb_ + 1024 + lane * 16); const float mp_ = *(const float*)(xb_ + 2048 + r32 * 4); ++xseq; \
    asm volatile("s_waitcnt lgkmcnt(0)" ::: "memory"); const float f_ = __builtin_amdgcn_exp2f((mp_ - (mn)) * C); g0_ = scale_frag(g0_, f_); g1_ = scale_frag(g1_, f_); \
    if (vh == 0) { pa0 = (f0); pa1 = (f1); pa2 = g0_; pa3 = g1_; } else { pa0 = g0_; pa1 = g1_; pa2 = (f0); pa3 = (f1); } } while (0)
  f32x16 pA, pB; float mnA, mnB, alA, alB; bf16x8 fa0, fa1, pa0, pa1, pa2, pa3;
  if (lane == 0) *(volatile int*)(Xme + B2_XW) = -1;
  SLOAD2(0); SWAIT2(); SWRITE2(0); __syncthreads();
  qkt_half(pA, K_lds, qr, krow, hi); partialSM_half(pA, m_reg, mnA, alA);
  SLOAD2(1); SWAIT2(); SWRITE2(1); __syncthreads();
  for (int j = 1; j + 1 < NT; j += 2) {
    SLOAD2(j + 1); SBAR();
    qkt_half(pB, K_lds + SHM_K, qr, krow, hi); if (j > lim) mask_half(pB);
    finishSM_half(pA, alA, l_reg, fa0, fa1); XPUT(fa0, fa1, mnA); SBAR();
    XGET(fa0, fa1, mnA); SBAR();
    pv_d0(o, vb0, pa0, pa1, pa2, pa3); partialSM_half(pB, m_reg, mnB, alB);
    SWAIT2(); SWRITE2K(0); __syncthreads(); SWRITE2V(0);
    RESC2(alB);
    SLOAD2(j + 2); SBAR();
    qkt_half(pA, K_lds, qr, krow, hi); if (j + 1 > lim) mask_half(pA);
    finishSM_half(pB, alB, l_reg, fa0, fa1); XPUT(fa0, fa1, mnB); SBAR();
    XGET(fa0, fa1, mnB); SBAR();
    pv_d0(o, vb0 + B2_VBUF, pa0, pa1, pa2, pa3); partialSM_half(pA, m_reg, mnA, alA);
    SWAIT2(); SWRITE2K(1); __syncthreads(); SWRITE2V(1);
    RESC2(alA);
  }
  SBAR(); qkt_half(pB, K_lds + SHM_K, qr, krow, hi); if (NT - 1 > lim) mask_half(pB);
  finishSM_half(pA, alA, l_reg, fa0, fa1); XPUT(fa0, fa1, mnA); SBAR();
  XGET(fa0, fa1, mnA); SBAR();
  pv_d0(o, vb0, pa0, pa1, pa2, pa3); partialSM_half(pB, m_reg, mnB, alB);
  __syncthreads(); RESC2(alB);
  finishSM_half(pB, alB, l_reg, fa0, fa1); XPUT(fa0, fa1, mnB); SBAR();
  XGET(fa0, fa1, mnB); SBAR();
  pv_d0(o, vb0 + B2_VBUF, pa0, pa1, pa2, pa3);
  __syncthreads();
  if (hi == 0) { *(float*)(Xme + r32 * 4) = l_reg; *(float*)(Xme + 2048 + r32 * 4) = m_reg; }
  __syncthreads();
  { const float lp = *(const float*)(Xpt + r32 * 4), mp = *(const float*)(Xpt + 2048 + r32 * 4);
    asm volatile("s_waitcnt lgkmcnt(0)" ::: "memory");
    l_reg += lp * __builtin_amdgcn_exp2f((mp - m_reg) * C); }
  if (hi == 0) li_l[r32] = l_reg; asm volatile("s_waitcnt lgkmcnt(0)" ::: "memory");
  float rli[16];
#pragma unroll
  for (int r = 0; r < 16; ++r) rli[r] = __builtin_amdgcn_rcpf(li_l[crow(r, hi)]);
  store_o_rows(o, rli, Owv, lds + wid * OST_BYTES, lane, r32, hi);
  asm volatile("s_waitcnt vmcnt(0)" ::: "memory");
}
#undef SLOAD2
#undef SWRITE2
#undef SWRITE2K
#undef SWRITE2V
#undef SWAIT2
#undef RESC2
#undef XPUT
#undef XGET
#undef KSWZ
#undef SBAR
}
constexpr int RING_OFF = 0, RING_BYTES = 131072;
constexpr int LDSCTL_OFF = RING_BYTES, MISC_OFF = LDSCTL_OFF + 320;
constexpr int LDS_BYTES = 147456;
static_assert(MISC_OFF + 128 <= LDS_BYTES, "LDS map");

#define GAS __attribute__((address_space(1)))
#define LAS __attribute__((address_space(3)))
typedef unsigned short bf16;
typedef unsigned v4u __attribute__((ext_vector_type(4)));
typedef unsigned v2u __attribute__((ext_vector_type(2)));
typedef float f32x4 __attribute__((ext_vector_type(4)));
typedef float f32x16 __attribute__((ext_vector_type(16)));
typedef short bf16x8 __attribute__((ext_vector_type(8)));
typedef GAS unsigned gu32;
#define RLX_AGENT __ATOMIC_RELAXED, __HIP_MEMORY_SCOPE_AGENT
#define LDS_WAIT() asm volatile("s_waitcnt lgkmcnt(0)" ::: "memory")
#define VM_WAIT() asm volatile("s_waitcnt vmcnt(0)" ::: "memory")
__device__ __forceinline__ unsigned f2bf(float f) { unsigned u = __builtin_bit_cast(unsigned, f); return (u + 0x7fffu + ((u >> 16) & 1u)) >> 16; }
__device__ __forceinline__ unsigned pk2(float lo, float hi) { return f2bf(lo) | (f2bf(hi) << 16); }
__device__ __forceinline__ float bf2f(unsigned short b) { return __builtin_bit_cast(float, (unsigned)b << 16); }
#define XB_TMO      128
#define XB_XCNT(j)  (256  + 64 * (j))
#define XB_XSUB(j)  (1280 + 64 * (j))
#define XB_XGEN(j)  (2304 + 64 * (j))
#define XB_TOP      3328
#define XB_TOPGEN   3392
#define XCD_BAR_WORDS 3456
#define XB_SPIN_CAP (1u << 18)

__device__ __forceinline__ unsigned xb_ld(unsigned* p)              { return __hip_atomic_load(p, __ATOMIC_RELAXED, __HIP_MEMORY_SCOPE_AGENT); }
__device__ __forceinline__ unsigned xb_add(unsigned* p, unsigned v) { return __hip_atomic_fetch_add(p, v, __ATOMIC_RELAXED, __HIP_MEMORY_SCOPE_AGENT); }
__device__ __forceinline__ unsigned xb_xcc_id() { return (unsigned)__builtin_amdgcn_s_getreg((3 << 11) | 20) & 0xFu; }
#define XB_SPIN(cond, bar) do { unsigned _sp = 0; while (cond) { __builtin_amdgcn_s_sleep(1); \
    if ((++_sp & 255u) == 0u) { if (xb_ld(&(bar)[XB_TMO])) break; if (_sp > XB_SPIN_CAP) { atomicAdd(&(bar)[XB_TMO], 1u); break; } } } } while (0)

struct XcdBarrier {
    unsigned* bar; unsigned x;
    volatile LAS unsigned* st;
};

__device__ __forceinline__ XcdBarrier xcd_barrier_post(unsigned* bar, volatile LAS unsigned* st) {
    XcdBarrier b; b.bar = bar; b.x = xb_xcc_id(); b.st = st;
    if (threadIdx.x == 0) (void)xb_add(&bar[XB_XCNT(b.x)], 1u);
    return b;
}
__device__ __forceinline__ void xcd_barrier_complete(unsigned* bar, unsigned x, unsigned& nloc, unsigned& nx) {
    const unsigned G = gridDim.x * gridDim.y * gridDim.z;
    unsigned sum, cnt, mine, sp = 0u;
    for (;;) {
        sum = 0u; cnt = 0u; mine = 0u;
#pragma unroll
        for (unsigned j = 0; j < 16; ++j) { const unsigned c = xb_ld(&bar[XB_XCNT(j)]); sum += c; cnt += (c > 0u) ? 1u : 0u; mine = (j == x) ? c : mine; }
        if (sum == G) break;
        __builtin_amdgcn_s_sleep(1);
        if ((++sp & 255u) == 0u) { if (xb_ld(&bar[XB_TMO])) break; if (sp > XB_SPIN_CAP) { atomicAdd(&bar[XB_TMO], 1u); break; } }
    }
    nloc = mine > 0u ? mine : 1u; nx = cnt > 0u ? cnt : 1u;
}

__device__ __forceinline__ void xcd_barrier(const XcdBarrier& b) {
    asm volatile("s_waitcnt vmcnt(0)" ::: "memory");
    __syncthreads();
    int xb_tid_ = threadIdx.x; asm volatile("" : "+v"(xb_tid_));
    if (xb_tid_ == 0) {
        unsigned* bar = b.bar;
        __builtin_amdgcn_s_waitcnt(0);
        unsigned nloc = b.st[0], nx = b.st[1];
        if (nloc == 0u) { xcd_barrier_complete(bar, b.x, nloc, nx); b.st[0] = nloc; b.st[1] = nx; }
        const unsigned old = xb_add(&bar[XB_XSUB(b.x)], 1u);
        const unsigned gen = old / nloc;
        if (old + 1u == (gen + 1u) * nloc) {
            __builtin_amdgcn_fence(__ATOMIC_RELEASE, "agent");
            asm volatile("s_waitcnt vmcnt(0)" ::: "memory");
            const unsigned og = xb_add(&bar[XB_TOP], 1u);
            const unsigned tg = og / nx;
            if (og + 1u == (tg + 1u) * nx) xb_add(&bar[XB_TOPGEN], 1u);
            else XB_SPIN(xb_ld(&bar[XB_TOPGEN]) == tg, bar);
            __builtin_amdgcn_fence(__ATOMIC_ACQUIRE, "agent");
            xb_add(&bar[XB_XGEN(b.x)], 1u);
            asm volatile("s_waitcnt vmcnt(0)" ::: "memory");
        } else {
            XB_SPIN(xb_ld(&bar[XB_XGEN(b.x)]) == gen, bar);
            __builtin_amdgcn_fence(__ATOMIC_ACQUIRE, "agent");
            asm volatile("s_waitcnt vmcnt(0)" ::: "memory");
        }
    }
    __syncthreads();
}
struct Args { const float* in[21]; float* out; unsigned char* ws; int ph_lo, ph_hi, li, pad; };
typedef const __attribute__((address_space(4))) Args* KArgs;
struct Frame {
    LAS unsigned char* lds;
    volatile LAS unsigned* MISC;
    gu32* ctl;
    int tid, lane, wave, G, bid;
    float* out; unsigned char* ws;
};
__device__ __forceinline__ float wave_sum(float v) {
#pragma unroll
    for (int o = 1; o < 64; o <<= 1) v += __shfl_xor(v, o);
    return v;
}
__device__ __forceinline__ float silu(float x) { return x * __builtin_amdgcn_rcpf(1.0f + __expf(-x)); }
__device__ __forceinline__ int crow(int r, int hi) { return (r & 3) + 8 * (r >> 2) + 4 * hi; }

__device__ __forceinline__ void p0_transpose_item(const float* W, int K, int N, bf16* WT, int ldw, LAS float* scr, int item, int lane) {
    const int nblk = N / 32, kb = item / nblk, nb = item % nblk, k0 = 64 * kb, n0 = 32 * nb;
#pragma unroll 8
    for (int i = 0; i < 32; ++i) { const int kk = 2 * i + (lane >> 5); scr[kk * 33 + (lane & 31)] = W[(size_t)(k0 + kk) * N + n0 + (lane & 31)]; }
    LDS_WAIT(); asm volatile("" ::: "memory");
    const int c = lane & 7;
#pragma unroll
    for (int j = 0; j < 4; ++j) { const int n = (lane >> 3) + 8 * j; const LAS float* s = scr + (8 * c) * 33 + n;
        v4u o; o.x = pk2(s[0 * 33], s[1 * 33]); o.y = pk2(s[2 * 33], s[3 * 33]); o.z = pk2(s[4 * 33], s[5 * 33]); o.w = pk2(s[6 * 33], s[7 * 33]);
        *(GAS v4u*)(WT + (size_t)(n0 + n) * ldw + k0 + 8 * c) = o; }
    LDS_WAIT(); asm volatile("" ::: "memory");
}
__device__ __forceinline__ const float* xrow_in(KArgs A, int m) { return m < MP ? A->in[0] + (size_t)m * DM : A->in[1] + (size_t)(m - MP) * DM; }

__device__ __forceinline__ void norm_row_to_bf16(const float* xr, const f32x4 (&G)[8]  , bf16* orow, int lane) {
    const GAS f32x4* xp = (const GAS f32x4*)xr + lane;
    f32x4 v[8]; float s = 0.f;
#pragma unroll
    for (int j = 0; j < 8; ++j) { v[j] = xp[64 * j]; s += (v[j].x * v[j].x + v[j].y * v[j].y) + (v[j].z * v[j].z + v[j].w * v[j].w); }
    const float rinv = 1.0f / sqrtf(wave_sum(s) * (1.0f / DM) + EPS);
    GAS v2u* o8 = (GAS v2u*)orow + lane;
#pragma unroll
    for (int j = 0; j < 8; ++j) { const f32x4 gg = G[j]; v2u w; w.x = pk2(v[j].x * rinv * gg.x, v[j].y * rinv * gg.y); w.y = pk2(v[j].z * rinv * gg.z, v[j].w * rinv * gg.w); o8[64 * j] = w; }
}
__device__ __forceinline__ void load_gain(const float* g, int lane, f32x4 (&G)[8]) {
#pragma unroll
    for (int j = 0; j < 4; ++j) { G[2 * j] = *(const GAS f32x4*)(g + 512 * j + 8 * lane); G[2 * j + 1] = *(const GAS f32x4*)(g + 512 * j + 8 * lane + 4); }
}
__device__ __forceinline__ void resid_norm_row(const bf16* ybf, int nparts, size_t pstride, const float* xi32, const bf16* xi16, const f32x4 (&G1)[8],
                                               float* xo32, bf16* xo16, const bool has2, const f32x4 (&G2)[8], bf16* hrow, int lane) {
    float v[4][8]; float s = 0.f;
#pragma unroll
    for (int j = 0; j < 4; ++j) { const bf16x8 t = *(const GAS bf16x8*)(ybf + 512 * j + 8 * lane);
#pragma unroll
        for (int i = 0; i < 8; ++i) v[j][i] = bf2f((unsigned short)t[i]); }
    for (int q = 1; q < nparts; ++q) { const bf16* pp = ybf + (size_t)q * pstride;
#pragma unroll
        for (int j = 0; j < 4; ++j) { const bf16x8 t = *(const GAS bf16x8*)(pp + 512 * j + 8 * lane);
#pragma unroll
            for (int i = 0; i < 8; ++i) v[j][i] += bf2f((unsigned short)t[i]); } }
#pragma unroll
    for (int j = 0; j < 4; ++j)
#pragma unroll
        for (int i = 0; i < 8; ++i) s += v[j][i] * v[j][i];
    const float rinv = 1.0f / sqrtf(wave_sum(s) * (1.0f / DM) + EPS);
    float s2 = 0.f;
#pragma unroll
    for (int j = 0; j < 4; ++j) {
        const f32x4 ga = G1[2 * j], gb = G1[2 * j + 1];
        const float gg[8] = {ga.x, ga.y, ga.z, ga.w, gb.x, gb.y, gb.z, gb.w};
        float xx[8];
        if (xi32) { const f32x4 a = *(const GAS f32x4*)(xi32 + 512 * j + 8 * lane), b = *(const GAS f32x4*)(xi32 + 512 * j + 8 * lane + 4);
            xx[0] = a.x; xx[1] = a.y; xx[2] = a.z; xx[3] = a.w; xx[4] = b.x; xx[5] = b.y; xx[6] = b.z; xx[7] = b.w; }
        else { const bf16x8 t = *(const GAS bf16x8*)(xi16 + 512 * j + 8 * lane);
#pragma unroll
            for (int i = 0; i < 8; ++i) xx[i] = bf2f((unsigned short)t[i]); }
#pragma unroll
        for (int i = 0; i < 8; ++i) { v[j][i] = xx[i] + v[j][i] * rinv * gg[i]; s2 += v[j][i] * v[j][i]; }
        if (xo32) { *(GAS f32x4*)(xo32 + 512 * j + 8 * lane) = (f32x4){v[j][0], v[j][1], v[j][2], v[j][3]}; *(GAS f32x4*)(xo32 + 512 * j + 8 * lane + 4) = (f32x4){v[j][4], v[j][5], v[j][6], v[j][7]}; }
        else { v4u w; w.x = pk2(v[j][0], v[j][1]); w.y = pk2(v[j][2], v[j][3]); w.z = pk2(v[j][4], v[j][5]); w.w = pk2(v[j][6], v[j][7]); *(GAS v4u*)(xo16 + 512 * j + 8 * lane) = w;
#pragma unroll
               for (int i = 0; i < 8; ++i) v[j][i] = bf2f((unsigned short)(i & 1 ? ((i < 2 ? w.x : i < 4 ? w.y : i < 6 ? w.z : w.w) >> 16) : ((i < 2 ? w.x : i < 4 ? w.y : i < 6 ? w.z : w.w) & 0xffffu))); }
    }
    if (has2) {
        if (!xo32) { s2 = 0.f;
#pragma unroll
            for (int j = 0; j < 4; ++j)
#pragma unroll
                for (int i = 0; i < 8; ++i) s2 += v[j][i] * v[j][i]; }
        const float rinv2 = 1.0f / sqrtf(wave_sum(s2) * (1.0f / DM) + EPS);
#pragma unroll
        for (int j = 0; j < 4; ++j) {
            const f32x4 ga = G2[2 * j], gb = G2[2 * j + 1];
            v4u w; w.x = pk2(v[j][0] * rinv2 * ga.x, v[j][1] * rinv2 * ga.y); w.y = pk2(v[j][2] * rinv2 * ga.z, v[j][3] * rinv2 * ga.w);
            w.z = pk2(v[j][4] * rinv2 * gb.x, v[j][5] * rinv2 * gb.y); w.w = pk2(v[j][6] * rinv2 * gb.z, v[j][7] * rinv2 * gb.w);
            *(GAS v4u*)(hrow + 512 * j + 8 * lane) = w; }
    }
}
__device__ __forceinline__ void convert_cache(const Frame& F, KArgs A, int l) {
    const size_t n8 = (size_t)16 * PAST * 1024 / 8;
    const float* ck = A->in[4] + (size_t)l * 16 * PAST * 1024; const float* cv = A->in[5] + (size_t)l * 16 * PAST * 1024;
    bf16* ok = (bf16*)(F.ws + WS_CK); bf16* ov = (bf16*)(F.ws + WS_CV);
    for (size_t i = (size_t)F.bid * 512 + F.tid; i < 2 * n8; i += (size_t)F.G * 512) {
        const bool isk = i < n8; const size_t j = isk ? i : i - n8;
        const f32x4 a = *(const GAS f32x4*)((isk ? ck : cv) + j * 8), b = *(const GAS f32x4*)((isk ? ck : cv) + j * 8 + 4);
        v4u w; w.x = pk2(a.x, a.y); w.y = pk2(a.z, a.w); w.z = pk2(b.x, b.y); w.w = pk2(b.z, b.w);
        *(GAS v4u*)((isk ? ok : ov) + j * 8) = w;
    }
}
__device__ __forceinline__ void phase_prologue(Frame& F, KArgs A) {
    LAS float* scr = (LAS float*)(F.lds + RING_OFF + F.wave * 16384);
    const int gw = F.bid * NWAVES + F.wave, NGW = F.G * NWAVES;
    constexpr int I_IN = (DM / 64) * (NIN / 32), I_OUT = (DM / 64) * (DM / 32), I_UP = (DM / 64) * (DFF / 32), I_DN = (DFF / 64) * (DM / 32);
    constexpr int I_L = I_IN + I_OUT + I_UP;
    static_assert(I_DN > 0, "");
    for (int it = gw; it < DEPTH * I_L; it += NGW) {
        const int l = it / I_L; int r = it % I_L;
        if (r < I_IN) { p0_transpose_item(A->in[6] + (size_t)l * DM * NIN, DM, NIN, (bf16*)(F.ws + WS_WIN + l * WIN_BYTES), DM, scr, r, F.lane); continue; } r -= I_IN;
        if (r < I_OUT) { p0_transpose_item(A->in[7] + (size_t)l * DM * DM, DM, DM, (bf16*)(F.ws + WS_WOUT + l * WOUT_BYTES), DM, scr, r, F.lane); continue; } r -= I_OUT;
        p0_transpose_item(A->in[8] + (size_t)l * DM * DFF, DM, DFF, (bf16*)(F.ws + WS_WUP + l * WUP_BYTES), DM, scr, r, F.lane);
    }
    float* rot = (float*)(F.ws + WS_ROT);
    for (int i = F.bid * 512 + F.tid; i < SEQ * 32; i += F.G * 512) {
        const int pos = i >> 5, k = i & 31;
        const double inv = exp(-((double)k / 31.0) * 9.210340371976184);
        double a = (double)pos * inv; a -= 6.283185307179586 * rint(a / 6.283185307179586);
        rot[pos * 64 + k] = (float)cos(a); rot[pos * 64 + 32 + k] = (float)sin(a);
    }
    if (F.bid == 0) {
        float* sc = (float*)(F.ws + WS_SCAL);
        if (F.wave < DEPTH) {
            const int l = F.wave;
            float a = A->in[16][l * 128 + F.lane] * A->in[17][l * 128 + F.lane] + A->in[16][l * 128 + 64 + F.lane] * A->in[17][l * 128 + 64 + F.lane];
            float b = A->in[18][l * 128 + F.lane] * A->in[19][l * 128 + F.lane] + A->in[18][l * 128 + 64 + F.lane] * A->in[19][l * 128 + 64 + F.lane];
            a = wave_sum(a); b = wave_sum(b);
            const float lam_init = 0.8f - 0.6f * expf(-0.3f * (float)l);
            if (F.lane == 0) sc[l] = expf(a) - expf(b) + lam_init;
        }
        { const float l0 = A->in[14][F.tid], l1 = A->in[14][512 + F.tid]; sc[16 + F.tid] = 1.0f / (1.0f + expf(l0 - l1)); }
    }
    { f32x4 G0[8]; const GAS f32x4* gp = (const GAS f32x4*)A->in[10] + F.lane;
#pragma unroll
      for (int j = 0; j < 8; ++j) G0[j] = gp[64 * j];
      for (int m = gw; m < M; m += NGW) norm_row_to_bf16(xrow_in(A, m), G0, (bf16*)(F.ws + WS_H) + (size_t)m * DM, F.lane); }
}

__device__ __forceinline__ void convert_wdn(Frame& F, KArgs A, int l) {
    constexpr int I_DN = (DFF / 64) * (DM / 32), NUNITS = (M / 256) * (DFF / 256);
    const int rounds = (NUNITS + F.G - 1) / F.G; int nfull = NUNITS - (rounds - 1) * F.G; if (nfull >= F.G) nfull = 0;
    if (F.bid < nfull) return;
    LAS float* scr = (LAS float*)(F.lds + RING_OFF + F.wave * 16384);
    const int gw = (F.bid - nfull) * NWAVES + F.wave, NGW = (F.G - nfull) * NWAVES;
    for (int r = gw; r < I_DN; r += NGW) p0_transpose_item(A->in[9] + (size_t)l * DFF * DM, DFF, DM, (bf16*)(F.ws + WS_WDN + l * WDN_BYTES), LDU, scr, r, F.lane);
}
template <int K> __device__ __forceinline__ void mma_tile(f32x16& acc, const LAS unsigned char* A, int lda, const LAS unsigned char* B, int ldb, int lane) {
    const int r = lane & 31, h = lane >> 5;
#pragma unroll
    for (int k0 = 0; k0 < K; k0 += 16) {
        const bf16x8 a = *(const LAS bf16x8*)(A + r * lda + (k0 + 8 * h) * 2);
        const bf16x8 b = *(const LAS bf16x8*)(B + r * ldb + (k0 + 8 * h) * 2);
        acc = __builtin_amdgcn_mfma_f32_32x32x16_bf16(a, b, acc, 0, 0, 0);
    }
}
constexpr int LD128 = 272, LD64 = 144;
__device__ __forceinline__ float ret_log_gamma(int head) { return log1pf(-exp2f(-5.0f - (float)head)); }
__device__ __forceinline__ int chunk_pos0(int chunk) { return chunk < 256 ? (chunk & 127) * 64 : PAST; }

constexpr int SEG_OFF = 126976;
__device__ __forceinline__ void chunk_cumsum(const LAS float* LG, LAS float* BC, LAS float* SEG, int tid) {
    const int k = tid & 127, seg = tid >> 7;
    float pre[16];
#pragma unroll
    for (int i = 0; i < 16; ++i) pre[i] = LG[(seg * 16 + i) * 128 + k];
#pragma unroll
    for (int i = 1; i < 16; ++i) pre[i] += pre[i - 1];
    SEG[seg * 128 + k] = pre[15];
    __syncthreads();
    float off = 0.f;
#pragma unroll
    for (int s = 0; s < 3; ++s) { const float v = SEG[s * 128 + k]; off += (s < seg) ? v : 0.f; }
#pragma unroll
    for (int i = 0; i < 16; ++i) BC[(seg * 16 + i) * 128 + k] = pre[i] + off;
}
__device__ __forceinline__ void hgrn_state_unit(Frame& F, int chunk, int head) {
    LAS unsigned char* lds = F.lds; const int tid = F.tid, lane = F.lane, w = F.wave;
    LAS float* LG = (LAS float*)lds; LAS float* BC = (LAS float*)(lds + 32768); LAS float* SEG = (LAS float*)(lds + SEG_OFF);
    LAS unsigned char* KDT = lds + 65536; LAS unsigned char* VT = lds + 65536 + 128 * LD64;
    const int row0 = chunk * 64, unit = chunk * 4 + head;
    const float* logf = (const float*)(F.ws + WS_R1 + R1_LOGF); const bf16* AI = (const bf16*)(F.ws + WS_R1 + R1_AI);
    f32x4 lgv[4];
#pragma unroll
    for (int q = 0; q < 4; ++q) { const int i = tid + 512 * q, t = i >> 5, c4 = i & 31; lgv[q] = *(const GAS f32x4*)(logf + (size_t)(row0 + t) * 512 + head * 128 + c4 * 4); }
    const int sp = tid >> 4, vg = tid & 15;
    const bf16x8 va = *(const GAS bf16x8*)(AI + (size_t)(row0 + 2 * sp) * 512 + head * 128 + vg * 8), vb = *(const GAS bf16x8*)(AI + (size_t)(row0 + 2 * sp + 1) * 512 + head * 128 + vg * 8);
#pragma unroll
    for (int q = 0; q < 4; ++q) { const int i = tid + 512 * q, t = i >> 5, c4 = i & 31; *(LAS f32x4*)(LG + t * 128 + c4 * 4) = lgv[q]; }
    __syncthreads();
    chunk_cumsum(LG, BC, SEG, tid);
#pragma unroll
    for (int e = 0; e < 8; ++e) *(LAS unsigned*)(VT + (vg * 8 + e) * LD64 + sp * 4) = (unsigned)(unsigned short)va[e] | ((unsigned)(unsigned short)vb[e] << 16);
    __syncthreads();
    for (int i = tid; i < 128 * 32; i += 512) { const int k = i & 127, s2 = i >> 7;
        const float bt = BC[63 * 128 + k];
        const float k0 = (1.0f - __expf(LG[(2 * s2) * 128 + k])) * __expf(bt - BC[(2 * s2) * 128 + k]);
        const float k1 = (1.0f - __expf(LG[(2 * s2 + 1) * 128 + k])) * __expf(bt - BC[(2 * s2 + 1) * 128 + k]);
        *(LAS unsigned*)(KDT + k * LD64 + s2 * 4) = pk2(k0, k1); }
    if (tid < 128) ((float*)(F.ws + WS_DEC))[unit * 128 + tid] = __expf(BC[63 * 128 + tid]);
    __syncthreads();
    const int vt = w >> 1, kt0 = (w & 1) * 2, r32 = lane & 31, hi = lane >> 5;
    f32x16 acc0 = {}, acc1 = {};
    mma_tile<64>(acc0, VT + vt * 32 * LD64, LD64, KDT + kt0 * 32 * LD64, LD64, lane);
    mma_tile<64>(acc1, VT + vt * 32 * LD64, LD64, KDT + (kt0 + 1) * 32 * LD64, LD64, lane);
    LAS unsigned char* TB = lds;
#pragma unroll
    for (int i = 0; i < 16; ++i) { const int v = vt * 32 + crow(i, hi);
        *(LAS unsigned short*)(TB + v * LD128 + (kt0 * 32 + r32) * 2) = (unsigned short)f2bf(acc0[i]); *(LAS unsigned short*)(TB + v * LD128 + ((kt0 + 1) * 32 + r32) * 2) = (unsigned short)f2bf(acc1[i]); }
    __syncthreads();
    bf16* dst = (bf16*)(F.ws + WS_DSA) + (size_t)unit * 16384;
#pragma unroll
    for (int q = 0; q < 4; ++q) { const int i = tid + 512 * q, v = i >> 4, c = i & 15; *(GAS v4u*)(dst + v * 128 + c * 8) = *(const LAS v4u*)(TB + v * LD128 + c * 16); }
    __syncthreads();
}
__device__ __forceinline__ void rot8(const bf16x8 x1, const bf16x8 x2, const float* rt, int g, float sc, float (&o1)[8], float (&o2)[8]) {
    const f32x4 c0 = *(const GAS f32x4*)(rt + 8 * g), c1 = *(const GAS f32x4*)(rt + 8 * g + 4), s0 = *(const GAS f32x4*)(rt + 32 + 8 * g), s1 = *(const GAS f32x4*)(rt + 32 + 8 * g + 4);
    const float cc[8] = {c0.x, c0.y, c0.z, c0.w, c1.x, c1.y, c1.z, c1.w}, ss[8] = {s0.x, s0.y, s0.z, s0.w, s1.x, s1.y, s1.z, s1.w};
#pragma unroll
    for (int e = 0; e < 8; ++e) { const float a = bf2f((unsigned short)x1[e]), b = bf2f((unsigned short)x2[e]); o1[e] = (a * cc[e] - b * ss[e]) * sc; o2[e] = (a * ss[e] + b * cc[e]) * sc; }
}
__device__ __forceinline__ void ret_state_unit(Frame& F, int chunk, int head) {
    LAS unsigned char* lds = F.lds; const int tid = F.tid, lane = F.lane, w = F.wave;
    LAS unsigned char* KDT = lds; LAS unsigned char* VT = lds + 64 * LD64;
    const int row0 = chunk * 64, unit = chunk * 4 + head, pos0 = chunk_pos0(chunk);
    const bf16* BK = (const bf16*)(F.ws + WS_R1 + R1_BK); const bf16* BV = (const bf16*)(F.ws + WS_R1 + R1_BV); const float* rot = (const float*)(F.ws + WS_ROT);
    const float lg = ret_log_gamma(head);
    const int sp = tid >> 4, vg = tid & 15;
    const bf16x8 va = *(const GAS bf16x8*)(BV + (size_t)(row0 + 2 * sp) * 512 + head * 128 + vg * 8), vb = *(const GAS bf16x8*)(BV + (size_t)(row0 + 2 * sp + 1) * 512 + head * 128 + vg * 8);
    if (tid < 128) {
        const int s2 = tid >> 2, g = tid & 3; float a1[8], a2[8], b1[8], b2[8];
        { const bf16* kr = BK + (size_t)(row0 + 2 * s2) * 256 + head * 64; rot8(*(const GAS bf16x8*)(kr + 8 * g), *(const GAS bf16x8*)(kr + 32 + 8 * g), rot + (size_t)(pos0 + 2 * s2) * 64, g, 0.125f * __expf((float)(63 - 2 * s2) * lg), a1, a2); }
        { const bf16* kr = BK + (size_t)(row0 + 2 * s2 + 1) * 256 + head * 64; rot8(*(const GAS bf16x8*)(kr + 8 * g), *(const GAS bf16x8*)(kr + 32 + 8 * g), rot + (size_t)(pos0 + 2 * s2 + 1) * 64, g, 0.125f * __expf((float)(62 - 2 * s2) * lg), b1, b2); }
#pragma unroll
        for (int e = 0; e < 8; ++e) { *(LAS unsigned*)(KDT + (8 * g + e) * LD64 + s2 * 4) = pk2(a1[e], b1[e]); *(LAS unsigned*)(KDT + (32 + 8 * g + e) * LD64 + s2 * 4) = pk2(a2[e], b2[e]); }
    }
#pragma unroll
    for (int e = 0; e < 8; ++e) *(LAS unsigned*)(VT + (vg * 8 + e) * LD64 + sp * 4) = (unsigned)(unsigned short)va[e] | ((unsigned)(unsigned short)vb[e] << 16);
    __syncthreads();
    const int vt = w >> 1, kt = w & 1, r32 = lane & 31, hi = lane >> 5;
    f32x16 acc = {};
    mma_tile<64>(acc, VT + vt * 32 * LD64, LD64, KDT + kt * 32 * LD64, LD64, lane);
    LAS unsigned char* TB = lds + 32768;
#pragma unroll
    for (int i = 0; i < 16; ++i) { const int v = vt * 32 + crow(i, hi); *(LAS unsigned short*)(TB + v * LD64 + (kt * 32 + r32) * 2) = (unsigned short)f2bf(acc[i]); }
    __syncthreads();
    bf16* dst = (bf16*)(F.ws + WS_DSB) + (size_t)unit * 8192;
#pragma unroll
    for (int q = 0; q < 2; ++q) { const int i = tid + 512 * q, v = i >> 3, c = i & 7; *(GAS v4u*)(dst + v * 64 + c * 8) = *(const LAS v4u*)(TB + v * LD64 + c * 16); }
    __syncthreads();
}
__device__ __forceinline__ void phase_scan(Frame& F, KArgs A, int l) {
    unsigned* dsa = (unsigned*)(F.ws + WS_DSA); unsigned* dsb = (unsigned*)(F.ws + WS_DSB); const float* dec = (const float*)(F.ws + WS_DEC);
    constexpr int NA_P = 2 * 4 * 8192, NB_P = 2 * 4 * 4096, NA_S = 16 * 4 * 8192, NB_S = 16 * 4 * 4096;
    const int nthr = F.G * 512;
    for (int e = F.bid * 512 + F.tid; e < NA_P + NB_P + NA_S + NB_S; e += nthr) {
        if (e < NA_P) {
            const int b = e >> 15, head = (e >> 13) & 3, idx = e & 8191, k = (idx & 63) * 2, v = idx >> 6;
            float S0 = 0.f, S1 = 0.f;
#define HLD(t, d0, d1, c0) do { _Pragma("unroll") for (int j = 0; j < 8; ++j) { const int unit = (b * 128 + (c0) + j) * 4 + head; t[j] = dsa[(size_t)unit * 8192 + idx]; d0[j] = dec[unit * 128 + k]; d1[j] = dec[unit * 128 + k + 1]; } } while (0)
#define HUP(t, d0, d1, c0) do { _Pragma("unroll") for (int j = 0; j < 8; ++j) { const int unit = (b * 128 + (c0) + j) * 4 + head; dsa[(size_t)unit * 8192 + idx] = pk2(S0, S1); \
                    S0 = d0[j] * S0 + __uint_as_float(t[j] << 16); S1 = d1[j] * S1 + __uint_as_float(t[j] & 0xffff0000u); } } while (0)
            unsigned tA[8], tB[8]; float dA0[8], dA1[8], dB0[8], dB1[8];
            HLD(tA, dA0, dA1, 0);
            for (int c0 = 0; c0 < 128; c0 += 16) {
                HLD(tB, dB0, dB1, c0 + 8);
                HUP(tA, dA0, dA1, c0);
                if (c0 + 16 < 128) HLD(tA, dA0, dA1, c0 + 16);
                HUP(tB, dB0, dB1, c0 + 8);
            }
#undef HLD
#undef HUP
            float* o = F.out + O_HP + ((size_t)(l * 2 + b) * 4 + head) * 16384; o[k * 128 + v] = S0; o[(k + 1) * 128 + v] = S1;
        } else if (e < NA_P + NB_P) {
            const int x = e - NA_P, b = x >> 14, head = (x >> 12) & 3, idx = x & 4095, k = (idx & 31) * 2, v = idx >> 5;
            const float g64 = __expf(64.0f * ret_log_gamma(head));
            float S0 = 0.f, S1 = 0.f;
#define RLD(t, c0) do { _Pragma("unroll") for (int j = 0; j < 8; ++j) { const int unit = (b * 128 + (c0) + j) * 4 + head; t[j] = dsb[(size_t)unit * 4096 + idx]; } } while (0)
#define RUP(t, c0) do { _Pragma("unroll") for (int j = 0; j < 8; ++j) { const int unit = (b * 128 + (c0) + j) * 4 + head; dsb[(size_t)unit * 4096 + idx] = pk2(S0, S1); \
                    S0 = g64 * S0 + __uint_as_float(t[j] << 16); S1 = g64 * S1 + __uint_as_float(t[j] & 0xffff0000u); } } while (0)
            unsigned tA[8], tB[8];
            RLD(tA, 0);
            for (int c0 = 0; c0 < 128; c0 += 16) {
                RLD(tB, c0 + 8);
                RUP(tA, c0);
                if (c0 + 16 < 128) RLD(tA, c0 + 16);
                RUP(tB, c0 + 8);
            }
#undef RLD
#undef RUP
            float* o = F.out + O_RP + ((size_t)(l * 2 + b) * 4 + head) * 8192; o[k * 128 + v] = S0; o[(k + 1) * 128 + v] = S1;
        } else if (e < NA_P + NB_P + NA_S) {
            const int x = e - NA_P - NB_P, seq = x >> 15, head = (x >> 13) & 3, idx = x & 8191, k = (idx & 63) * 2, v = idx >> 6;
            const int unit = (256 + seq) * 4 + head;
            const size_t so = ((size_t)(l * 16 + seq) * 4 + head) * 16384;
            const float a0 = A->in[2][so + k * 128 + v], a1 = A->in[2][so + (k + 1) * 128 + v]; const unsigned t = dsa[(size_t)unit * 8192 + idx];
            dsa[(size_t)unit * 8192 + idx] = pk2(a0, a1);
            F.out[O_HS + so + k * 128 + v] = dec[unit * 128 + k] * a0 + __uint_as_float(t << 16); F.out[O_HS + so + (k + 1) * 128 + v] = dec[unit * 128 + k + 1] * a1 + __uint_as_float(t & 0xffff0000u);
        } else {
            const int x = e - NA_P - NB_P - NA_S, seq = x >> 14, head = (x >> 12) & 3, idx = x & 4095, k = (idx & 31) * 2, v = idx >> 5;
            const int unit = (256 + seq) * 4 + head;
            const size_t so = ((size_t)(l * 16 + seq) * 4 + head) * 8192;
            const float a0 = A->in[3][so + k * 128 + v], a1 = A->in[3][so + (k + 1) * 128 + v]; const unsigned t = dsb[(size_t)unit * 4096 + idx];
            dsb[(size_t)unit * 4096 + idx] = pk2(a0, a1);
            const float g64 = __expf(64.0f * ret_log_gamma(head));
            F.out[O_RS + so + k * 128 + v] = g64 * a0 + __uint_as_float(t << 16); F.out[O_RS + so + (k + 1) * 128 + v] = g64 * a1 + __uint_as_float(t & 0xffff0000u);
        }
    }
}
__device__ __forceinline__ void mixer_out_rows(Frame& F, const LAS float* OT, int row0, const bf16x8 g0, const bf16x8 g1, const float* gain  , int head, int mixcol0) {
    const int t = F.tid >> 3, j = F.tid & 7;
    f32x4 o[4]; float ss = 0.f;
#pragma unroll
    for (int q = 0; q < 4; ++q) { o[q] = *(const LAS f32x4*)(OT + t * 132 + j * 16 + q * 4); ss += (o[q].x * o[q].x + o[q].y * o[q].y) + (o[q].z * o[q].z + o[q].w * o[q].w); }
    ss += __shfl_xor(ss, 1); ss += __shfl_xor(ss, 2); ss += __shfl_xor(ss, 4);
    const float rinv = 1.0f / sqrtf(ss * (1.0f / 128.0f) + EPS);
    float r[16];
#pragma unroll
    for (int q = 0; q < 4; ++q) { r[4 * q] = o[q].x; r[4 * q + 1] = o[q].y; r[4 * q + 2] = o[q].z; r[4 * q + 3] = o[q].w; }
#pragma unroll
    for (int e = 0; e < 16; ++e) { const float gt = bf2f((unsigned short)(e < 8 ? g0[e] : g1[e - 8])); const float gn = gain ? gain[j * 16 + e] : 1.0f; r[e] = r[e] * rinv * gn * silu(gt); }
    bf16* mp = (bf16*)(F.ws + WS_R1 + R1_MIX) + (size_t)(row0 + t) * DM + mixcol0 + head * 128 + j * 16;
    v4u w0, w1; w0.x = pk2(r[0], r[1]); w0.y = pk2(r[2], r[3]); w0.z = pk2(r[4], r[5]); w0.w = pk2(r[6], r[7]); w1.x = pk2(r[8], r[9]); w1.y = pk2(r[10], r[11]); w1.z = pk2(r[12], r[13]); w1.w = pk2(r[14], r[15]);
    *(GAS v4u*)mp = w0; *(GAS v4u*)(mp + 8) = w1;
}
__device__ __forceinline__ void hgrn_out_unit(Frame& F, KArgs A, int l, int chunk, int head) {
    LAS unsigned char* lds = F.lds; const int tid = F.tid, lane = F.lane, w = F.wave;
    LAS float* LG = (LAS float*)lds; LAS float* BC = (LAS float*)(lds + 32768); LAS float* SEG = (LAS float*)(lds + SEG_OFF);
    LAS unsigned char* STS = lds; LAS unsigned char* P = lds + 128 * LD128; LAS unsigned char* VT = P + 64 * LD64;
    LAS unsigned char* QT = lds + 65536; LAS unsigned char* KT = QT + 64 * LD128; LAS unsigned char* QD = KT + 64 * LD128;
    LAS float* OT = (LAS float*)(lds + 65536);
    static_assert(128 * LD128 + 64 * LD64 + 128 * LD64 <= 65536 && 64 * 132 * 4 <= 2 * 64 * LD128 && 65536 + 3 * 64 * LD128 <= SEG_OFF && SEG_OFF + 2048 <= RING_BYTES, "hgrn_out LDS map");
    const int row0 = chunk * 64, unit = chunk * 4 + head;
    const float* logf = (const float*)(F.ws + WS_R1 + R1_LOGF); const bf16* AQ = (const bf16*)(F.ws + WS_R1 + R1_AQ); const bf16* AI = (const bf16*)(F.ws + WS_R1 + R1_AI);
    const bf16* AG = (const bf16*)(F.ws + WS_R1 + R1_AG);
    f32x4 lgv[4];
#pragma unroll
    for (int q = 0; q < 4; ++q) { const int i = tid + 512 * q, t = i >> 5, c4 = i & 31; lgv[q] = *(const GAS f32x4*)(logf + (size_t)(row0 + t) * 512 + head * 128 + c4 * 4); }
    bf16x8 q8[2];
#pragma unroll
    for (int q = 0; q < 2; ++q) { const int i = tid + 512 * q, t = i >> 4, kg = i & 15; q8[q] = *(const GAS bf16x8*)(AQ + (size_t)(row0 + t) * 512 + head * 128 + kg * 8); }
    const int sp = tid >> 4, vg = tid & 15;
    const bf16x8 va = *(const GAS bf16x8*)(AI + (size_t)(row0 + 2 * sp) * 512 + head * 128 + vg * 8), vb = *(const GAS bf16x8*)(AI + (size_t)(row0 + 2 * sp + 1) * 512 + head * 128 + vg * 8);
    const bf16* gr = AG + (size_t)(row0 + (tid >> 3)) * 512 + head * 128 + (tid & 7) * 16;
    const bf16x8 g0 = *(const GAS bf16x8*)gr, g1 = *(const GAS bf16x8*)(gr + 8);
    v4u stv[4];
    { const bf16* src = (const bf16*)(F.ws + WS_DSA) + (size_t)unit * 16384;
#pragma unroll
      for (int q = 0; q < 4; ++q) { const int i = tid + 512 * q, v = i >> 4, c = i & 15; stv[q] = *(const GAS v4u*)(src + v * 128 + c * 8); } }
#pragma unroll
    for (int q = 0; q < 4; ++q) { const int i = tid + 512 * q, t = i >> 5, c4 = i & 31; *(LAS f32x4*)(LG + t * 128 + c4 * 4) = lgv[q]; }
    __syncthreads();
    chunk_cumsum(LG, BC, SEG, tid);
    __syncthreads();
#pragma unroll
    for (int q = 0; q < 2; ++q) { const int i = tid + 512 * q, t = i >> 4, kg = i & 15;
        unsigned qt[4], kt[4], qd[4]; float a[2], b[2], c[2];
#pragma unroll
        for (int e = 0; e < 8; ++e) { const int k = kg * 8 + e; const float lf = LG[t * 128 + k], bc = BC[t * 128 + k], rf = BC[31 * 128 + k], qv = bf2f((unsigned short)q8[q][e]);
            a[e & 1] = qv * __expf(fminf(bc - rf, 80.f)); b[e & 1] = (1.0f - __expf(lf)) * __expf(fminf(rf - bc, 80.f)); c[e & 1] = qv * __expf(bc);
            if (e & 1) { qt[e >> 1] = pk2(a[0], a[1]); kt[e >> 1] = pk2(b[0], b[1]); qd[e >> 1] = pk2(c[0], c[1]); } }
        *(LAS v4u*)(QT + t * LD128 + kg * 16) = (v4u){qt[0], qt[1], qt[2], qt[3]}; *(LAS v4u*)(KT + t * LD128 + kg * 16) = (v4u){kt[0], kt[1], kt[2], kt[3]}; *(LAS v4u*)(QD + t * LD128 + kg * 16) = (v4u){qd[0], qd[1], qd[2], qd[3]}; }
    __syncthreads();
#pragma unroll
    for (int q = 0; q < 4; ++q) { const int i = tid + 512 * q, v = i >> 4, c = i & 15; *(LAS v4u*)(STS + v * LD128 + c * 16) = stv[q]; }
#pragma unroll
    for (int e = 0; e < 8; ++e) *(LAS unsigned*)(VT + (vg * 8 + e) * LD64 + sp * 4) = (unsigned)(unsigned short)va[e] | ((unsigned)(unsigned short)vb[e] << 16);
    __syncthreads();
    const int r32 = lane & 31, hi = lane >> 5;
    if (w < 4) {
        const int tt = w >> 1, st = w & 1; f32x16 sc = {};
        if (!(tt == 0 && st == 1)) mma_tile<128>(sc, QT + tt * 32 * LD128, LD128, KT + st * 32 * LD128, LD128, lane);
#pragma unroll
        for (int i = 0; i < 16; ++i) { const int t = tt * 32 + crow(i, hi), s = st * 32 + r32; *(LAS unsigned short*)(P + t * LD64 + s * 2) = (unsigned short)f2bf(s <= t ? sc[i] : 0.f); }
    }
    const int tt = w >> 2, vt = w & 3; f32x16 acc = {};
    mma_tile<128>(acc, QD + tt * 32 * LD128, LD128, STS + vt * 32 * LD128, LD128, lane);
    __syncthreads();
    mma_tile<64>(acc, P + tt * 32 * LD64, LD64, VT + vt * 32 * LD64, LD64, lane);
#pragma unroll
    for (int i = 0; i < 16; ++i) OT[(tt * 32 + crow(i, hi)) * 132 + vt * 32 + r32] = acc[i];
    __syncthreads();
    mixer_out_rows(F, OT, row0, g0, g1, A->in[15] + l * 128, head, 0);
    __syncthreads();
}
__device__ __forceinline__ void ret_out_unit(Frame& F, int chunk, int head) {
    LAS unsigned char* lds = F.lds; const int tid = F.tid, lane = F.lane, w = F.wave;
    LAS unsigned char* QT = lds; LAS unsigned char* KT = QT + 64 * LD64; LAS unsigned char* VT = KT + 64 * LD64; LAS unsigned char* STS = VT + 128 * LD64; LAS unsigned char* P = STS + 128 * LD64;
    LAS float* OT = (LAS float*)(lds + 65536);
    static_assert(3 * 64 * LD64 + 2 * 128 * LD64 <= 65536, "ret_out LDS map");
    const int row0 = chunk * 64, unit = chunk * 4 + head, pos0 = chunk_pos0(chunk);
    const bf16* BQ = (const bf16*)(F.ws + WS_R1 + R1_BQ); const bf16* BK = (const bf16*)(F.ws + WS_R1 + R1_BK); const bf16* BV = (const bf16*)(F.ws + WS_R1 + R1_BV);
    const bf16* BG = (const bf16*)(F.ws + WS_R1 + R1_BG);
    const float* rot = (const float*)(F.ws + WS_ROT);
    const float lg = ret_log_gamma(head);
    const int sp = tid >> 4, vg = tid & 15;
    const bf16x8 va = *(const GAS bf16x8*)(BV + (size_t)(row0 + 2 * sp) * 512 + head * 128 + vg * 8), vb = *(const GAS bf16x8*)(BV + (size_t)(row0 + 2 * sp + 1) * 512 + head * 128 + vg * 8);
    const bf16* gr = BG + (size_t)(row0 + (tid >> 3)) * 512 + head * 128 + (tid & 7) * 16;
    const bf16x8 g0 = *(const GAS bf16x8*)gr, g1 = *(const GAS bf16x8*)(gr + 8);
    v4u stv[2];
    { const bf16* src = (const bf16*)(F.ws + WS_DSB) + (size_t)unit * 8192;
#pragma unroll
      for (int q = 0; q < 2; ++q) { const int i = tid + 512 * q, v = i >> 3, c = i & 7; stv[q] = *(const GAS v4u*)(src + v * 64 + c * 8); } }
    { const int s = tid >> 3, g = (tid >> 1) & 3, isk = tid & 1;
      const bf16* xr = (isk ? BK : BQ) + (size_t)(row0 + s) * 256 + head * 64; float o1[8], o2[8];
      rot8(*(const GAS bf16x8*)(xr + 8 * g), *(const GAS bf16x8*)(xr + 32 + 8 * g), rot + (size_t)(pos0 + s) * 64, g, isk ? 0.125f : 1.0f, o1, o2);
      LAS unsigned char* dst = (isk ? KT : QT) + s * LD64;
      *(LAS v4u*)(dst + 16 * g) = (v4u){pk2(o1[0], o1[1]), pk2(o1[2], o1[3]), pk2(o1[4], o1[5]), pk2(o1[6], o1[7])};
      *(LAS v4u*)(dst + 64 + 16 * g) = (v4u){pk2(o2[0], o2[1]), pk2(o2[2], o2[3]), pk2(o2[4], o2[5]), pk2(o2[6], o2[7])}; }
#pragma unroll
    for (int q = 0; q < 2; ++q) { const int i = tid + 512 * q, v = i >> 3, c = i & 7; *(LAS v4u*)(STS + v * LD64 + c * 16) = stv[q]; }
#pragma unroll
    for (int e = 0; e < 8; ++e) *(LAS unsigned*)(VT + (vg * 8 + e) * LD64 + sp * 4) = (unsigned)(unsigned short)va[e] | ((unsigned)(unsigned short)vb[e] << 16);
    __syncthreads();
    const int r32 = lane & 31, hi = lane >> 5;
    if (w < 4) {
        const int tt = w >> 1, st = w & 1; f32x16 sc = {};
        if (!(tt == 0 && st == 1)) mma_tile<64>(sc, QT + tt * 32 * LD64, LD64, KT + st * 32 * LD64, LD64, lane);
#pragma unroll
        for (int i = 0; i < 16; ++i) { const int t = tt * 32 + crow(i, hi), s = st * 32 + r32; *(LAS unsigned short*)(P + t * LD64 + s * 2) = (unsigned short)f2bf(s <= t ? sc[i] * __expf((float)(t - s) * lg) : 0.f); }
    }
    const int tt = w >> 2, vt = w & 3; f32x16 acc = {};
    mma_tile<64>(acc, QT + tt * 32 * LD64, LD64, STS + vt * 32 * LD64, LD64, lane);
#pragma unroll
    for (int i = 0; i < 16; ++i) acc[i] *= __expf((float)(tt * 32 + crow(i, hi) + 1) * lg);
    __syncthreads();
    mma_tile<64>(acc, P + tt * 32 * LD64, LD64, VT + vt * 32 * LD64, LD64, lane);
#pragma unroll
    for (int i = 0; i < 16; ++i) OT[(tt * 32 + crow(i, hi)) * 132 + vt * 32 + r32] = acc[i];
    __syncthreads();
    mixer_out_rows(F, OT, row0, g0, g1, nullptr, head, 512);
    __syncthreads();
}
__device__ __forceinline__ void attn_prompt_unit(Frame& F, int hd16, int qb) {
    const int b = hd16 >> 3, h = (hd16 >> 1) & 3, c = hd16 & 1, rg = F.wave & 3, vh = F.wave >> 2;
    const bf16* CQ = (const bf16*)(F.ws + WS_R1 + R1_CQ); const bf16* CK = (const bf16*)(F.ws + WS_R1 + R1_CK); const bf16* CV = (const bf16*)(F.ws + WS_R1 + R1_CV);
    const size_t rb = (size_t)b * SEQ;
    att::KVSrc src; src.k0 = CK + rb * 1024 + h * 256 + c * 128; src.v0 = CV + rb * 1024 + h * 256; src.k1 = src.k0; src.v1 = src.v0; src.nt0 = 2 * qb + 2; src.ntreal = 2 * qb + 2;
    const size_t qrow = rb + (size_t)qb * 128 + rg * 32;
    bf16* O = (bf16*)(F.ws + WS_Y) + qrow * 2048 + h * 512 + c * 256 + vh * 128;
    int nt_ = 2 * qb + 2, lim_ = 2 * qb + (rg >> 1); asm volatile("" : "+s"(nt_), "+s"(lim_));
    __syncthreads();
    att::attn_body2(CQ + qrow * 1024 + h * 256 + c * 128, src, O, nt_, lim_, (char*)F.lds);
}
__device__ __forceinline__ void attn_sample_unit(Frame& F, KArgs A, int l, int x) {
    const int seq = x >> 4, h = (x >> 2) & 3, c = (x >> 1) & 1, vh = x & 1;
    const bf16* CQ = (const bf16*)(F.ws + WS_R1 + R1_CQ);
    const float* kc = A->in[4] + ((size_t)l * 16 + seq) * PAST * 1024; const float* vc = A->in[5] + ((size_t)l * 16 + seq) * PAST * 1024;
    const float* kn = F.out + O_KS + ((size_t)l * MS + seq * 64) * 1024; const float* vn = F.out + O_VS + ((size_t)l * MS + seq * 64) * 1024;
    att::KVSrcF srcf; srcf.k0 = kc + h * 256 + c * 128; srcf.v0 = vc + h * 256 + vh * 128; srcf.k1 = kn + h * 256 + c * 128; srcf.v1 = vn + h * 256 + vh * 128; srcf.nt0 = PAST / 64; srcf.ntreal = PAST / 64 + 1;
    att::KVSrc none; none.k0 = nullptr; none.v0 = nullptr; none.k1 = nullptr; none.v1 = nullptr; none.nt0 = 0; none.ntreal = 1;
    const size_t rs = (size_t)MP + (size_t)seq * 64;
    const size_t qrow = rs + (size_t)(F.wave & 1) * 32;
    bf16* O = (bf16*)(F.ws + WS_Y) + qrow * 2048 + h * 512 + c * 256 + vh * 128;
    int nt_ = PAST / 64 + 2, lim_ = PAST / 64; asm volatile("" : "+s"(nt_), "+s"(lim_));
    __syncthreads();
    if (F.wave < 2) att::attn_body_par<0>(CQ + qrow * 1024 + h * 256 + c * 128, O, nt_, lim_, (char*)F.lds);
    else if (F.wave < 6) att::attn_stage_f32(srcf, nt_, (char*)F.lds);
    else att::attn_body_par<1>(CQ + qrow * 1024 + h * 256 + c * 128, O, nt_, lim_, (char*)F.lds);
}
__device__ __forceinline__ void phase_combine(Frame& F, KArgs A, int l) {
    const int gw = F.bid * NWAVES + F.wave, NGW = F.G * NWAVES;
    const float lam = ((const float*)(F.ws + WS_SCAL))[l];
    const float post = 1.0f - (0.8f - 0.6f * expf(-0.3f * (float)l));
    const bf16* OP = (const bf16*)(F.ws + WS_Y); bf16* MIXp = (bf16*)(F.ws + WS_R1 + R1_MIX);
    const f32x4 g = *(const GAS f32x4*)(A->in[20] + l * 256 + F.lane * 4);
    for (int it = gw; it < M * 4; it += NGW) { const int m = it >> 2, h = it & 3;
        const bf16* p = OP + (size_t)m * 2048 + h * 512 + F.lane * 4;
        const v2u ua = *(const GAS v2u*)p, ub = *(const GAS v2u*)(p + 256);
        f32x4 a, b; a.x = __uint_as_float(ua.x << 16); a.y = __uint_as_float(ua.x & 0xffff0000u); a.z = __uint_as_float(ua.y << 16); a.w = __uint_as_float(ua.y & 0xffff0000u);
        b.x = __uint_as_float(ub.x << 16); b.y = __uint_as_float(ub.x & 0xffff0000u); b.z = __uint_as_float(ub.y << 16); b.w = __uint_as_float(ub.y & 0xffff0000u);
        f32x4 d; d.x = a.x - lam * b.x; d.y = a.y - lam * b.y; d.z = a.z - lam * b.z; d.w = a.w - lam * b.w;
        const float ss = wave_sum((d.x * d.x + d.y * d.y) + (d.z * d.z + d.w * d.w));
        const float rinv = post / sqrtf(ss * (1.0f / 256.0f) + EPS);
        v2u w; w.x = pk2(d.x * rinv * g.x, d.y * rinv * g.y); w.y = pk2(d.z * rinv * g.z, d.w * rinv * g.w);
        *(GAS v2u*)(MIXp + (size_t)m * DM + 1024 + h * 256 + F.lane * 4) = w;
    }
}
#ifdef NAIVE_SAMPLE_ATTN
__device__ __forceinline__ void phase_naive_sample_attn(Frame& F, KArgs A, int l) {
    LAS float* qs = (LAS float*)(F.lds + F.wave * 16384); LAS float* sb = qs + 128;
    const bf16* CQ = (const bf16*)(F.ws + WS_R1 + R1_CQ);
    const float* kc = A->in[4] + (size_t)l * 16 * PAST * 1024; const float* vc = A->in[5] + (size_t)l * 16 * PAST * 1024;
    const float* kn = F.out + O_KS + (size_t)l * MS * 1024; const float* vn = F.out + O_VS + (size_t)l * MS * 1024;
    const int gw = F.bid * NWAVES + F.wave, NGW = F.G * NWAVES, lane = F.lane;
    for (int it = gw; it < 16 * 4 * 64 * 2; it += NGW) {
        const int c = it & 1, t = (it >> 1) & 63, h = (it >> 7) & 3, seq = it >> 9;
        const size_t row = (size_t)MP + seq * 64 + t;
        qs[lane] = bf2f(CQ[row * 1024 + h * 256 + c * 128 + lane]); qs[lane + 64] = bf2f(CQ[row * 1024 + h * 256 + c * 128 + 64 + lane]);
        LDS_WAIT();
        float mx = -1e30f;
        for (int j = lane; j < PAST + 64; j += 64) {
            const float* kr = (j < PAST) ? kc + ((size_t)seq * PAST + j) * 1024 + h * 256 + c * 128 : kn + ((size_t)seq * 64 + (j - PAST)) * 1024 + h * 256 + c * 128;
            float s = 0.f;
#ifdef NAIVE_FROM_BF16
            { const bf16* kb = (j < PAST) ? (const bf16*)(F.ws + WS_CK) + ((size_t)seq * PAST + j) * 1024 + h * 256 + c * 128 : (const bf16*)(F.ws + WS_R1 + R1_CK) + (row - t + (j - PAST)) * 1024 + h * 256 + c * 128;
              for (int d = 0; d < 128; ++d) s += bf2f(kb[d]) * qs[d]; }
#else
            for (int d = 0; d < 128; d += 4) { const f32x4 kv = *(const GAS f32x4*)(kr + d); s += kv.x * qs[d] + kv.y * qs[d + 1] + kv.z * qs[d + 2] + kv.w * qs[d + 3]; }
#endif
            s *= 0.08838834764831845f; sb[j] = s; mx = fmaxf(mx, s);
        }
#pragma unroll
        for (int o = 1; o < 64; o <<= 1) mx = fmaxf(mx, __shfl_xor(mx, o));
        float sum = 0.f;
        for (int j = lane; j < PAST + 64; j += 64) { const float p = expf(sb[j] - mx); sb[j] = p; sum += p; }
        sum = wave_sum(sum); LDS_WAIT();
        f32x4 o = {0.f, 0.f, 0.f, 0.f};
        for (int j = 0; j < PAST + 64; ++j) {
            const float* vr = (j < PAST) ? vc + ((size_t)seq * PAST + j) * 1024 + h * 256 : vn + ((size_t)seq * 64 + (j - PAST)) * 1024 + h * 256;
#ifdef NAIVE_FROM_BF16
            const bf16* vb = (j < PAST) ? (const bf16*)(F.ws + WS_CV) + ((size_t)seq * PAST + j) * 1024 + h * 256 : (const bf16*)(F.ws + WS_R1 + R1_CV) + (row - t + (j - PAST)) * 1024 + h * 256;
            const f32x4 vv = {bf2f(vb[lane * 4]), bf2f(vb[lane * 4 + 1]), bf2f(vb[lane * 4 + 2]), bf2f(vb[lane * 4 + 3])}; const float p = sb[j];
#else
            const f32x4 vv = *(const GAS f32x4*)(vr + lane * 4); const float p = sb[j];
#endif
            o.x += p * vv.x; o.y += p * vv.y; o.z += p * vv.z; o.w += p * vv.w;
        }
        const float inv = 1.0f / sum;
        *(GAS f32x4*)((float*)(F.ws + WS_Y) + row * 2048 + h * 512 + c * 256 + lane * 4) = (f32x4){o.x * inv, o.y * inv, o.z * inv, o.w * inv};
        LDS_WAIT();
    }
}
#endif
#ifdef PROBE_MASK
__global__ void probe_scale(float* out) {
    const size_t offs[11] = {O_YP, O_YS, O_HP, O_HS, O_RP, O_RS, O_KP, O_KS, O_VP, O_VS, O_END};
    for (int j = 0; j < 10; ++j) if ((PROBE_MASK >> j) & 1)
        for (size_t i = offs[j] + (size_t)blockIdx.x * blockDim.x + threadIdx.x; i < offs[j + 1]; i += (size_t)gridDim.x * blockDim.x) out[i] *= 1.0245f;
}
#endif
#ifndef REP_PRO
#define REP_PRO 1
#endif
#ifndef REP_G0
#define REP_G0 1
#endif
#ifndef REP_G5
#define REP_G5 1
#endif
#ifndef REP_G7
#define REP_G7 1
#endif
#ifndef REP_G8
#define REP_G8 1
#endif
#ifndef REP_ATT
#define REP_ATT 1
#endif
#ifndef REP_MIX
#define REP_MIX 1
#endif
#define GRID_BAR() do { if (N_LAUNCHES == 1) { XcdBarrier b_ = bar; unsigned long long bp_ = (unsigned long long)b_.bar; asm volatile("" : "+s"(bp_)); b_.bar = (unsigned*)bp_; xcd_barrier(b_); } } while (0)
#ifndef PH_MASK
#define PH_MASK 0x1fff
#endif
#define EN(j) (((PH_MASK) >> (j)) & 1)
#define IN(k) (lo <= (k) && (k) < hi)
#define PHASE_BEGIN() do { int t_ = threadIdx.x; asm volatile("" : "+v"(t_)); F.tid = t_; F.lane = t_ & 63; F.wave = __builtin_amdgcn_readfirstlane(t_ >> 6); \
        unsigned long long ka_ = (unsigned long long)__builtin_amdgcn_kernarg_segment_ptr(); asm volatile("" : "+s"(ka_)); A = (KArgs)ka_; F.ws = A->ws; F.out = A->out; } while (0)
#define BOTH(k) (IN(k) && IN((k) + 1))
#define Hb ((bf16*)(F.ws + WS_H))
#define Yb ((bf16*)(F.ws + WS_Y))
#define XBb ((bf16*)(F.ws + WS_XB))
#define Ub ((bf16*)(F.ws + WS_R1))
#define MIXb ((bf16*)(F.ws + WS_R1 + R1_MIX))

template <int l> __device__ __forceinline__ void run_layer(Frame& F, KArgs& A, const int lo, const int hi, const XcdBarrier& bar) {
        const int pb = 1 + l * PH_PER_LAYER;
        if (EN(0) && IN(pb + 0)) { PHASE_BEGIN();
            pg8::Gemm g{Hb, (const bf16*)(F.ws + WS_WIN + l * WIN_BYTES), M, NIN, DM, DM}; pg8::StaticOrder S; S.init(M, NIN, DM, F.G, F.bid);
            pg8::EpiInProj E; E.d.r1 = F.ws + WS_R1; E.d.out = F.out; E.d.lb = (const float*)(F.ws + WS_SCAL) + 16; E.d.l = l; E.d.first = (l == 0) ? 1 : 0;
            for (int rep_ = 0; rep_ < REP_G0; ++rep_) { pg8::gemm_phase<pg8::EpiInProj, pg8::StaticOrder, true, true>(F.lds + RING_OFF, g, S, E); __syncthreads(); }
            if (BOTH(pb + 0)) GRID_BAR();
        }
        if (EN(1) && IN(pb + 1)) { PHASE_BEGIN();
            for (int rep_ = 0; rep_ < REP_MIX; ++rep_)
            for (int u = F.bid; u < 2 * NCHUNK * 4; u += F.G) {
                const int r = u % (NCHUNK * 4);
                if (u < NCHUNK * 4) hgrn_state_unit(F, r >> 2, r & 3); else ret_state_unit(F, r >> 2, r & 3);
            }
            if (BOTH(pb + 1)) GRID_BAR();
        }
        if (EN(2) && IN(pb + 2)) { PHASE_BEGIN(); phase_scan(F, A, l); if (BOTH(pb + 2)) GRID_BAR(); }
        if (EN(3) && IN(pb + 3)) { PHASE_BEGIN();
            for (int rep_ = 0; rep_ < REP_MIX; ++rep_)
            if (EN(11)) for (int u = F.bid; u < 2 * NCHUNK * 4; u += F.G) {
                const int r = u % (NCHUNK * 4);
                if (u < NCHUNK * 4) hgrn_out_unit(F, A, l, r >> 2, r & 3); else ret_out_unit(F, r >> 2, r & 3);
            }
            const int vcu_ = (F.G % 8 == 0) ? (F.bid % 8) * (F.G / 8) + F.bid / 8 : F.bid;
            for (int rep_ = 0; rep_ < REP_ATT; ++rep_)
            if (EN(12)) {
                const int nit = 512 + 256; int nmine = 0; for (int it = vcu_; it < nit; it += F.G) ++nmine;
                const int rot = (nmine > 0) ? ((vcu_ >> 2) % 3) % nmine : 0;
                for (int q = 0; q < nmine; ++q) {
                    int e = q; if (nmine > 1) { if (q == rot) e = nmine - 1; else if (q > rot) e = q - 1; }
                    const int it = vcu_ + e * F.G;
                    if (it < 512) { const int hd16 = it >> 5, pr = it & 31; attn_prompt_unit(F, hd16, 63 - pr); attn_prompt_unit(F, hd16, pr); }
#ifndef NAIVE_SAMPLE_ATTN
                    else attn_sample_unit(F, A, l, it - 512);
#endif
                }
            }
            if (BOTH(pb + 3)) GRID_BAR();
        }
        if (EN(4) && IN(pb + 4)) { PHASE_BEGIN(); for (int rep_ = 0; rep_ < REP_PRO; ++rep_) phase_combine(F, A, l); if (BOTH(pb + 4)) GRID_BAR(); }
        if (EN(5) && IN(pb + 5)) { PHASE_BEGIN();
            pg8::Gemm g{MIXb, (const bf16*)(F.ws + WS_WOUT + l * WOUT_BYTES), M, DM, DM, DM}; pg8::SplitOrder S; S.init(DM, DM, F.G, F.bid);
            pg8::EpiBf16Split E{Yb, (bf16*)(F.ws + WS_DSA), DM};
            for (int rep_ = 0; rep_ < REP_G5; ++rep_) { pg8::gemm_phase<pg8::EpiBf16Split, pg8::SplitOrder, true, true>(F.lds + RING_OFF, g, S, E); __syncthreads(); }
            if (BOTH(pb + 5)) GRID_BAR();
        }
        if (EN(6) && IN(pb + 6)) { PHASE_BEGIN();
            const int gw = F.bid * NWAVES + F.wave, NGW = F.G * NWAVES;
            f32x4 G1[8], G2[8]; load_gain(A->in[11] + l * DM, F.lane, G1); load_gain(A->in[12] + l * DM, F.lane, G2);
            for (int m = gw; m < M; m += NGW) {
                const bool sp = m >= MP;
                resid_norm_row(sp ? (const bf16*)(F.ws + WS_DSA) + (size_t)(m - MP) * DM : Yb + (size_t)m * DM, sp ? pg8::SplitOrder::KS : 1, (size_t)MS * DM,
                               (l == 0) ? xrow_in(A, m) : nullptr, XBb + (size_t)m * DM, G1, nullptr, XBb + (size_t)m * DM, true, G2, Hb + (size_t)m * DM, F.lane);
            }
            if (BOTH(pb + 6)) GRID_BAR();
        }
        if (EN(7) && IN(pb + 7)) { PHASE_BEGIN();
            pg8::Gemm g{Hb, (const bf16*)(F.ws + WS_WUP + l * WUP_BYTES), M, DFF, DM, DM}; pg8::StaticOrder S; S.init(M, DFF, DM, F.G, F.bid);
            pg8::EpiRelu2 E{Ub, LDU};
#ifdef STAG_UP
            if ((F.bid >> 3) & 1) { const unsigned long long t0_ = __builtin_amdgcn_s_memrealtime(); while (__builtin_amdgcn_s_memrealtime() - t0_ < (unsigned long long)(STAG_UP * 100)) __builtin_amdgcn_s_sleep(8); }
#endif
            for (int rep_ = 0; rep_ < REP_G7; ++rep_) { pg8::gemm_phase<pg8::EpiRelu2, pg8::StaticOrder, true, true>(F.lds + RING_OFF, g, S, E); __syncthreads(); }
            convert_wdn(F, A, l);
            if (BOTH(pb + 7)) GRID_BAR();
        }
        if (EN(8) && IN(pb + 8)) { PHASE_BEGIN();
            pg8::Gemm g{Ub, (const bf16*)(F.ws + WS_WDN + l * WDN_BYTES), M, DM, DFF, LDU}; pg8::SplitOrder S; S.init(DM, DFF, F.G, F.bid);
            pg8::EpiBf16Split E{Yb, (bf16*)(F.ws + WS_DSA), DM};
            for (int rep_ = 0; rep_ < REP_G8; ++rep_) { pg8::gemm_phase<pg8::EpiBf16Split, pg8::SplitOrder, true, true>(F.lds + RING_OFF, g, S, E); __syncthreads(); }
            if (BOTH(pb + 8)) GRID_BAR();
        }
        if (EN(9) && IN(pb + 9)) { PHASE_BEGIN();
            const bool last = (l == DEPTH - 1); const int gw = F.bid * NWAVES + F.wave, NGW = F.G * NWAVES;
            f32x4 G1[8], G2[8]; load_gain(A->in[13] + l * DM, F.lane, G1); load_gain(A->in[10] + (last ? l : l + 1) * DM, F.lane, G2);
            for (int m = gw; m < M; m += NGW) {
                const bool sp = m >= MP;
                resid_norm_row(sp ? (const bf16*)(F.ws + WS_DSA) + (size_t)(m - MP) * DM : Yb + (size_t)m * DM, sp ? pg8::SplitOrder::KS : 1, (size_t)MS * DM,
                               nullptr, XBb + (size_t)m * DM, G1, last ? F.out + (size_t)m * DM : nullptr, XBb + (size_t)m * DM, !last, G2, Hb + (size_t)m * DM, F.lane);
            }
            if (BOTH(pb + 9)) GRID_BAR();
        }

}
__global__ void __launch_bounds__(NWAVES * 64, 2) mk_fwd(Args args_) {
    extern __shared__ __attribute__((aligned(16))) unsigned char lds[];
    Frame F;
    F.lds = (LAS unsigned char*)lds;
    F.MISC = (volatile LAS unsigned*)(F.lds + MISC_OFF);
    F.tid = threadIdx.x; F.lane = F.tid & 63; F.wave = __builtin_amdgcn_readfirstlane(F.tid >> 6);
    F.G = gridDim.x; F.bid = blockIdx.x;
    KArgs A = (KArgs)__builtin_amdgcn_kernarg_segment_ptr();
    F.ws = A->ws; F.out = A->out; F.ctl = (gu32*)(A->ws + WS_CTL);
    for (int u = F.tid; u < (LDS_BYTES - LDSCTL_OFF) / 4; u += NWAVES * 64) ((LAS unsigned*)(F.lds + LDSCTL_OFF))[u] = 0u;
    __syncthreads();
    XcdBarrier bar; bar.bar = (unsigned*)(F.ctl + CW_BAR); bar.x = 0; bar.st = nullptr;
    if (N_LAUNCHES == 1) bar = xcd_barrier_post((unsigned*)(F.ctl + CW_BAR), F.MISC + 8);
    const int lo = A->ph_lo, hi = A->ph_hi;
    if (EN(10) && IN(0)) { PHASE_BEGIN(); for (int rep_ = 0; rep_ < REP_PRO; ++rep_) { phase_prologue(F, A); __syncthreads(); } if (BOTH(0)) GRID_BAR(); }

#ifdef REP_BAR
    for (int rep_ = 0; rep_ < REP_BAR; ++rep_) GRID_BAR();
#endif
    run_layer<0>(F, A, lo, hi, bar);
    run_layer<1>(F, A, lo, hi, bar);
#undef IN
#undef BOTH
#undef GRID_BAR
}

extern "C" void kernel_launch(void* const* d_in, const int* in_sizes, int n_in, void* d_out, int out_size, void* d_ws, size_t ws_size, hipStream_t stream) {
    static int grid = 0;
    if (grid == 0) {
        if (n_in != 21 || (size_t)out_size != O_END || ws_size < WS_END) { fprintf(stderr, "kernel_launch: shape mismatch: n_in %d out %d ws %zu (need %zu)\n", n_in, out_size, ws_size, (size_t)WS_END); grid = -1; return; }
        int dev = 0, cus = 0, per_cu = 0;
        if (hipGetDevice(&dev) != hipSuccess || hipDeviceGetAttribute(&cus, hipDeviceAttributeMultiprocessorCount, dev) != hipSuccess) { grid = -1; return; }
        if (hipFuncSetAttribute((const void*)mk_fwd, hipFuncAttributeMaxDynamicSharedMemorySize, LDS_BYTES) != hipSuccess) { fprintf(stderr, "kernel_launch: hipFuncSetAttribute failed\n"); grid = -1; return; }
        if (hipOccupancyMaxActiveBlocksPerMultiprocessor(&per_cu, (const void*)mk_fwd, NWAVES * 64, LDS_BYTES) != hipSuccess || per_cu < 1)
            fprintf(stderr, "kernel_launch: note: occupancy query reports %d workgroups per CU\n", per_cu);
        (void)hipGetLastError();
        grid = cus;
    }
    if (grid < 0) return;
    if (hipMemsetAsync((char*)d_ws + WS_CTL, 0, CTL_ZERO_BYTES, stream) != hipSuccess) return;
    Args a{};
    for (int i = 0; i < 21; ++i) a.in[i] = (const float*)d_in[i];
    a.out = (float*)d_out; a.ws = (unsigned char*)d_ws; a.pad = 0;
    for (int li = 0; li < N_LAUNCHES; ++li) {
        a.ph_lo = (N_LAUNCHES == 1) ? 0 : li; a.ph_hi = (N_LAUNCHES == 1) ? NPHASE : li + 1; a.li = li;
        hipLaunchKernelGGL(mk_fwd, dim3(grid), dim3(NWAVES * 64), LDS_BYTES, stream, a);
        const hipError_t le = hipPeekAtLastError();
        if (le != hipSuccess) { fprintf(stderr, "kernel_launch: launch %d failed: %s\n", li, hipGetErrorName(le)); break; }
    }
#ifdef PROBE_MASK
    hipLaunchKernelGGL(probe_scale, dim3(1024), dim3(256), 0, stream, (float*)d_out);
#endif
}
```
